# Optimizing an MI355X kernel written in HIP

```python
import math
import jax, jax.numpy as jnp
from jax import lax
import numpy as np

D_MODEL = 1024
BATCH = 2
SEQ = 8192
DEPTH = 2

GRID_W = 64
CTX_LEN = 256
HEAD_DIM = 64
HG_HEADS = 4
HG_DK = 64
HG_DV = 64
HG_CHUNK = 64
GQA_HEADS = 6
GQA_KV_HEADS = 2
NA_HEADS = 6
NA_KH_MAX = 8
NA_KW = 16
ATTN_BLOCK = 128
ROPE_THETA = 10000.0
NORM_EPS = 1e-6
N_MOD = 6

HG_W = HG_HEADS * HG_DV
GQA_W = GQA_HEADS * HEAD_DIM
GQA_KV_W = GQA_KV_HEADS * HEAD_DIM
NA_W = NA_HEADS * HEAD_DIM
MIX_W = HG_W + GQA_W + NA_W
IN_SIZES = (HG_W, HG_W, HG_W, HG_W, HG_W, GQA_W, GQA_KV_W, GQA_KV_W, NA_W, NA_W, NA_W)
IN_W = sum(IN_SIZES)
FFN_HIDDEN = ((8 * D_MODEL + 3 * 256 - 1) // (3 * 256)) * 256
DN_ALPHA = (2 * DEPTH) ** 0.25
DN_BETA = (8 * DEPTH) ** -0.25

kernel_name = 'hybrid_hgrn2_gqa_natten_deepnorm_dit'


def rms_norm(x, g):
    x = x.astype(jnp.float32)
    return x * lax.rsqrt(jnp.mean(x * x, -1, keepdims=True) + NORM_EPS) * g


def layer_norm(x, g, b):
    x = x.astype(jnp.float32)
    xc = x - jnp.mean(x, -1, keepdims=True)
    return xc * lax.rsqrt(jnp.mean(xc * xc, -1, keepdims=True) + NORM_EPS) * g + b


def heads(a, n):
    return a.reshape(a.shape[:-1] + (n, a.shape[-1] // n))


def adaln(cv, w, b):
    return jax.nn.silu(cv) @ w + b


def modulate(x, shift, scale):
    return x * (1.0 + scale) + shift


def axial_rope_tables(n_tokens):
    t = jnp.arange(n_tokens, dtype=jnp.int32)
    row = (t // GRID_W).astype(jnp.float32)
    col = (t % GRID_W).astype(jnp.float32)
    n_pairs = HEAD_DIM // 4
    inv_freq = jnp.exp(-math.log(ROPE_THETA) * jnp.arange(n_pairs, dtype=jnp.float32) / n_pairs)
    ang = jnp.concatenate([row[:, None] * inv_freq, col[:, None] * inv_freq], -1)
    return jnp.cos(ang)[None, :, None, :], jnp.sin(ang)[None, :, None, :]


def apply_rope(x, cos, sin):
    x1, x2 = x[..., 0::2], x[..., 1::2]
    return jnp.stack([x1 * cos - x2 * sin, x1 * sin + x2 * cos], -1).reshape(x.shape)


def hgrn_lower_bounds(logits):
    p = jax.nn.softmax(logits.astype(jnp.float32), axis=0)
    return jnp.clip(jnp.cumsum(p, axis=0) - p[0], 0.0, 1.0)


def gla_chunk_scan(q, k, logf, v, s0, with_output):
    b_, n, h, _ = q.shape
    dv = v.shape[-1]
    nc = n // HG_CHUNK

    def to_chunks(a):
        return a.reshape(b_, nc, HG_CHUNK, h, a.shape[-1]).transpose(1, 0, 3, 2, 4)

    incl = jnp.tril(jnp.ones((HG_CHUNK, HG_CHUNK), bool))[:, :, None]

    def step(s, inp):
        qc, kc, gc, vc = inp
        cum = jnp.cumsum(gc, axis=2)
        tot = cum[:, :, -1:, :]
        s_new = jnp.exp(tot)[:, :, 0, :, None] * s + jnp.einsum('bhsk,bhsv->bhkv', kc * jnp.exp(tot - cum), vc)
        if not with_output:
            return s_new, None
        diff = cum[:, :, :, None, :] - cum[:, :, None, :, :]
        pair = jnp.where(incl, jnp.exp(jnp.minimum(diff, 0.0)), 0.0)
        att = jnp.einsum('bhtk,bhsk,bhtsk->bhts', qc, kc, pair)
        o = jnp.einsum('bhts,bhsv->bhtv', att, vc) + jnp.einsum('bhtk,bhkv->bhtv', qc * jnp.exp(cum), s)
        return s_new, o

    s_fin, o = lax.scan(step, s0, (to_chunks(q), to_chunks(k), to_chunks(logf), to_chunks(v)))
    if with_output:
        o = o.transpose(1, 0, 3, 2, 4).reshape(b_, n, h, dv)
    return o, s_fin


def hgrn2_mix(p_lat, p_ctx, lb, norm_g, need_ctx):
    def prep(p):
        q, f_fwd, f_bwd, i, g = p
        logf = [heads(jnp.log(lb[d] + (1.0 - lb[d]) * jax.nn.sigmoid(f)), HG_HEADS)
                for d, f in enumerate((f_fwd, f_bwd))]
        return heads(jax.nn.silu(q), HG_HEADS), heads(i, HG_HEADS), g, logf

    q_c, i_c, g_c, lf_c = prep(p_ctx)
    q_l, i_l, g_l, lf_l = prep(p_lat)
    s0 = jnp.zeros((q_l.shape[0], HG_HEADS, HG_DK, HG_DV), jnp.float32)
    rev = lambda a: jnp.flip(a, axis=1)
    o_cf, s_cf = gla_chunk_scan(q_c, -jnp.expm1(lf_c[0]), lf_c[0], i_c, s0, need_ctx)
    o_lf, _ = gla_chunk_scan(q_l, -jnp.expm1(lf_l[0]), lf_l[0], i_l, s_cf, True)
    o_cb, s_cb = gla_chunk_scan(rev(q_c), -jnp.expm1(rev(lf_c[1])), rev(lf_c[1]), rev(i_c), s0, need_ctx)
    o_lb, _ = gla_chunk_scan(rev(q_l), -jnp.expm1(rev(lf_l[1])), rev(lf_l[1]), rev(i_l), s_cb, True)

    def readout(o, g):
        return rms_norm(o, norm_g).reshape(g.shape) * jax.nn.silu(g)

    y_lat = readout(o_lf + rev(o_lb), g_l)
    y_ctx = readout(o_cf + rev(o_cb), g_c) if need_ctx else None
    return y_lat, y_ctx


def attend(q, k, v):
    s = jnp.einsum('bqkgd,bskd->bkgqs', q, k) * (q.shape[-1] ** -0.5)
    p = jax.nn.softmax(s.astype(jnp.float32), axis=-1)
    return jnp.einsum('bkgqs,bskd->bqkgd', p, v)


def blocked_attention(q, k, v):
    b_, n, h, dh = q.shape
    hkv = k.shape[2]
    nb = n // ATTN_BLOCK
    qb = q.reshape(b_, nb, ATTN_BLOCK, hkv, h // hkv, dh).transpose(1, 0, 2, 3, 4, 5)
    o = lax.map(lambda blk: attend(blk, k, v), qb)
    return o.transpose(1, 0, 2, 3, 4, 5).reshape(b_, n, h * dh)


def dense_attention(q, k, v):
    b_, n, h, dh = q.shape
    hkv = k.shape[2]
    return attend(q.reshape(b_, n, hkv, h // hkv, dh), k, v).reshape(b_, n, h * dh)


def gqa_mix(p_lat, p_ctx, q_norm, k_norm, cos, sin, need_ctx):
    def prep(p):
        q, k, v = p
        return (rms_norm(heads(q, GQA_HEADS), q_norm), rms_norm(heads(k, GQA_KV_HEADS), k_norm),
                heads(v, GQA_KV_HEADS))

    q_l, k_l, v_l = prep(p_lat)
    q_c, k_c, v_c = prep(p_ctx)
    q_l, k_l = apply_rope(q_l, cos, sin), apply_rope(k_l, cos, sin)
    k_all = jnp.concatenate([k_l, k_c], axis=1)
    v_all = jnp.concatenate([v_l, v_c], axis=1)
    y_lat = blocked_attention(q_l, k_all, v_all)
    y_ctx = dense_attention(q_c, k_c, v_c) if need_ctx else None
    return y_lat, y_ctx


def na_mix(p_lat, p_ctx, rpb, need_ctx):
    q_l, k_l, v_l = [heads(a, NA_HEADS) for a in p_lat]
    q_c, k_c, v_c = [heads(a, NA_HEADS) for a in p_ctx]
    b_, n = q_l.shape[:2]
    rows = n // GRID_W
    kh = min(NA_KH_MAX, rows)
    scale = HEAD_DIM ** -0.5
    cols = jnp.arange(GRID_W)
    col_idx = jnp.clip(cols - NA_KW // 2, 0, GRID_W - NA_KW)[:, None] + jnp.arange(NA_KW)
    dc = col_idx - cols[:, None] + (NA_KW - 1)
    n_loc = kh * NA_KW

    def row_block(r):
        row_idx = jnp.clip(r - kh // 2, 0, rows - kh) + jnp.arange(kh)
        idx = row_idx[None, :, None] * GRID_W + col_idx[:, None, :]
        kg, vg = k_l[:, idx], v_l[:, idx]
        qr = lax.dynamic_slice_in_dim(q_l, r * GRID_W, GRID_W, axis=1) * scale
        bias = rpb[:, (row_idx - r + NA_KH_MAX - 1)[None, :, None], dc[:, None, :]]
        s_loc = jnp.einsum('bchd,bcijhd->bhcij', qr, kg) + bias
        s_ctx = jnp.einsum('bchd,blhd->bhcl', qr, k_c)
        s = jnp.concatenate([s_loc.reshape(b_, NA_HEADS, GRID_W, n_loc), s_ctx], -1)
        p = jax.nn.softmax(s.astype(jnp.float32), axis=-1)
        p_loc = p[..., :n_loc].reshape(b_, NA_HEADS, GRID_W, kh, NA_KW)
        return (jnp.einsum('bhcij,bcijhd->bchd', p_loc, vg)
                + jnp.einsum('bhcl,blhd->bchd', p[..., n_loc:], v_c))

    o = lax.map(row_block, jnp.arange(rows))
    y_lat = o.transpose(1, 0, 2, 3, 4).reshape(b_, n, NA_W)
    y_ctx = dense_attention(q_c, k_c, v_c) if need_ctx else None
    return y_lat, y_ctx


def mixing_sublayer(h_lat, h_ctx, w_in, lb, hg_norm, q_norm, k_norm, rpb, w_out, cos, sin, need_ctx):
    split_at = np.cumsum(IN_SIZES)[:-1].tolist()
    p_lat = jnp.split((h_lat @ w_in).astype(jnp.float32), split_at, axis=-1)
    p_ctx = jnp.split((h_ctx @ w_in).astype(jnp.float32), split_at, axis=-1)
    hg_l, hg_c = hgrn2_mix(p_lat[0:5], p_ctx[0:5], lb, hg_norm, need_ctx)
    gq_l, gq_c = gqa_mix(p_lat[5:8], p_ctx[5:8], q_norm, k_norm, cos, sin, need_ctx)
    na_l, na_c = na_mix(p_lat[8:11], p_ctx[8:11], rpb, need_ctx)
    y_lat = jnp.concatenate([hg_l, gq_l, na_l], axis=-1) @ w_out
    y_ctx = jnp.concatenate([hg_c, gq_c, na_c], axis=-1) @ w_out if need_ctx else None
    return y_lat, y_ctx


def swiglu(h, w1, w2):
    gate, up = jnp.split(h @ w1, 2, axis=-1)
    return (jax.nn.silu(gate) * up) @ w2


def setup_inputs(seed: int = 0) -> dict:
    key = jax.random.key(seed)
    ks = jax.random.split(key, 17)
    f32 = jnp.float32

    def nrm(k, shape, s):
        return jax.random.normal(k, shape, f32) * s

    return {
        'x': nrm(ks[0], (BATCH, SEQ, D_MODEL), 1.0),
        'c': nrm(ks[1], (BATCH, D_MODEL), 1.0),
        'ctx': nrm(ks[2], (BATCH, CTX_LEN, D_MODEL), 1.0),
        'c_ctx': nrm(ks[3], (D_MODEL,), 1.0),
        'w_ada': nrm(ks[4], (DEPTH, D_MODEL, N_MOD * D_MODEL), 0.5 * D_MODEL ** -0.5),
        'b_ada': nrm(ks[5], (DEPTH, N_MOD * D_MODEL), 0.02),
        'w_in': nrm(ks[6], (DEPTH, D_MODEL, IN_W), D_MODEL ** -0.5),
        'hgrn_lb_logits': nrm(ks[7], (DEPTH, 2, HG_W), 1.0),
        'hgrn_norm': 1.0 + nrm(ks[8], (DEPTH, HG_DV), 0.02),
        'gqa_q_norm': 1.0 + nrm(ks[9], (DEPTH, HEAD_DIM), 0.02),
        'gqa_k_norm': 1.0 + nrm(ks[10], (DEPTH, HEAD_DIM), 0.02),
        'na_rpb': nrm(ks[11], (DEPTH, NA_HEADS, 2 * NA_KH_MAX - 1, 2 * NA_KW - 1), 0.1),
        'w_out': nrm(ks[12], (DEPTH, MIX_W, D_MODEL), DN_BETA * MIX_W ** -0.5),
        'w_ffn_in': nrm(ks[13], (DEPTH, D_MODEL, 2 * FFN_HIDDEN), D_MODEL ** -0.5),
        'w_ffn_out': nrm(ks[14], (DEPTH, FFN_HIDDEN, D_MODEL), DN_BETA * FFN_HIDDEN ** -0.5),
        'ln_g': 1.0 + nrm(ks[15], (DEPTH, 2, D_MODEL), 0.02),
        'ln_b': nrm(ks[16], (DEPTH, 2, D_MODEL), 0.02),
    }


def reference(x, c, ctx, c_ctx, w_ada, b_ada, w_in, hgrn_lb_logits, hgrn_norm, gqa_q_norm, gqa_k_norm,
              na_rpb, w_out, w_ffn_in, w_ffn_out, ln_g, ln_b):
    cos, sin = axial_rope_tables(x.shape[1])
    lbs = hgrn_lower_bounds(hgrn_lb_logits)
    x_lat, x_ctx = x, ctx
    for l in range(DEPTH):
        need_ctx = l < DEPTH - 1
        m_lat = jnp.split(adaln(c, w_ada[l], b_ada[l])[:, None, :], N_MOD, axis=-1)
        m_ctx = jnp.split(adaln(c_ctx, w_ada[l], b_ada[l]), N_MOD, axis=-1)
        y_lat, y_ctx = mixing_sublayer(
            modulate(x_lat, m_lat[0], m_lat[1]), modulate(x_ctx, m_ctx[0], m_ctx[1]),
            w_in[l], lbs[l], hgrn_norm[l], gqa_q_norm[l], gqa_k_norm[l], na_rpb[l], w_out[l],
            cos, sin, need_ctx)
        x_lat = layer_norm(DN_ALPHA * x_lat + m_lat[2] * y_lat, ln_g[l, 0], ln_b[l, 0])
        f_lat = swiglu(modulate(x_lat, m_lat[3], m_lat[4]), w_ffn_in[l], w_ffn_out[l])
        x_lat = layer_norm(DN_ALPHA * x_lat + m_lat[5] * f_lat, ln_g[l, 1], ln_b[l, 1])
        if need_ctx:
            x_ctx = layer_norm(DN_ALPHA * x_ctx + m_ctx[2] * y_ctx, ln_g[l, 0], ln_b[l, 0])
            f_ctx = swiglu(modulate(x_ctx, m_ctx[3], m_ctx[4]), w_ffn_in[l], w_ffn_out[l])
            x_ctx = layer_norm(DN_ALPHA * x_ctx + m_ctx[5] * f_ctx, ln_g[l, 1], ln_b[l, 1])
    return x_lat
```

```cpp
#include <hip/hip_runtime.h>
#include <cstdio>
#include <cstdint>
namespace pg8 {
#define PG8_LAS __attribute__((address_space(3)))
typedef unsigned short bf16_t;
typedef short bf16x8 __attribute__((ext_vector_type(8)));
typedef float f32x4 __attribute__((ext_vector_type(4)));
typedef unsigned u32x4 __attribute__((ext_vector_type(4)));
constexpr int BM = 256, BK = 64, HALF = 128, HTB = HALF * BK * 2  , STAGE_BYTES = 8 * HTB, NXCD = 8, WGM = 8;

__host__ __device__ __forceinline__ int lds_byte(int r, int c) { const int st = (r >> 4) * 2 + (c >> 5), rr = r & 15, cc = c & 31, ob = rr * 64 + cc * 2; return st * 1024 + (ob ^ (((ob >> 9) & 1) << 5)); }
__host__ __device__ __forceinline__ void stage_rc(int b, int& R, int& C) { const int st = b / 1024, sb = b % 1024, swz = sb ^ (((sb >> 9) & 1) << 5); R = (st >> 1) * 16 + swz / 64; C = (st & 1) * 32 + (swz % 64) / 2; }
__host__ __device__ __forceinline__ int perm32(int rho) { const int n = rho >> 4, i = rho & 15; return 8 * (i >> 2) + 4 * n + (i & 3); }

struct Unit { int pm, pn; };
struct Gemm { const bf16_t* A; const bf16_t* Bt; int M, N, K; };

struct StaticOrder {
    int nM, nN, nwg, G, c;
    __host__ __device__ void init(int M, int N, int G_, int c_) { nM = M / BM; nN = N / BM; nwg = nM * nN; G = G_; c = c_; }
    __host__ __device__ bool next(int i, Unit& u) const {
        const long L = (long)i * G + c; if (L >= nwg) return false;
        int wgid = (int)L; { const int q = nwg / NXCD, r = nwg % NXCD, xcd = wgid % NXCD, off = wgid / NXCD; wgid = (xcd < r ? xcd * (q + 1) : r * (q + 1) + (xcd - r) * q) + off; }
        const int nig = WGM * nN, gid = wgid / nig, fm = gid * WGM, gsz = (nM - fm) < WGM ? (nM - fm) : WGM;
        u.pm = fm + ((wgid % nig) % gsz); u.pn = (wgid % nig) / gsz; return true;
    }
    __device__ __forceinline__ void a_ready(const Unit&) const {}
    __device__ __forceinline__ void done(const Unit&) const {}
};

__device__ __forceinline__ unsigned cvt_pk_bf16(float lo, float hi) { unsigned r; asm volatile("v_cvt_pk_bf16_f32 %0, %1, %2" : "=v"(r) : "v"(lo), "v"(hi)); return r; }
typedef float f32x2 __attribute__((ext_vector_type(2)));
__device__ __forceinline__ f32x2 gelu_pk(f32x2 v) {
    const f32x2 av = __builtin_elementwise_abs(v), d = av * 0.2316418882f + 1.0f;
    f32x2 t; t.x = __builtin_amdgcn_rcpf(d.x); t.y = __builtin_amdgcn_rcpf(d.y);
    f32x2 q = t * 0.5307027145f + (-0.7265760135f); q = q * t + 0.7107068705f; q = q * t + (-0.142248368f); q = q * t + 0.127414796f; q = q * t;
    const f32x2 s = (v * v) * (-0.72134752044f);
    f32x2 e; e.x = __builtin_amdgcn_exp2f(s.x); e.y = __builtin_amdgcn_exp2f(s.y);
    const f32x2 m = v * (q * e), r = v - m;
    f32x2 o; o.x = v.x < 0.f ? m.x : r.x; o.y = v.y < 0.f ? m.y : r.y; return o;
}

template <int ACT  > struct EpiBf16 {
    static constexpr bool PERM = true, AFTER_DRAIN = false; static_assert(ACT == 0 || ACT == 1, "EpiBf16: ACT is 0 (none) or 1 (gelu_pk)");
    bf16_t* O; int ldc; const float* bias; int split_cols; size_t split_stride; float scale0;
    __device__ __forceinline__ void operator()(const f32x4 (&acc)[2][2][4][2], const Unit& u, int wr, int wc, int fr, int fq) const {
        const int row0 = u.pm * BM + wr * 64 + fr; int colt = u.pn * BM; bf16_t* base = O;
        float sc = 1.f; if (split_cols) { const int t = colt / split_cols; base += (size_t)t * split_stride; colt -= t * split_cols; if (t == 0) sc = scale0; }
        const int col0 = colt + wc * 32 + 8 * fq, bcol0 = u.pn * BM + wc * 32 + 8 * fq;
        f32x4 bv[2][2];
#pragma unroll
        for (int bj = 0; bj < 2; ++bj)
#pragma unroll
            for (int n = 0; n < 2; ++n) bv[bj][n] = bias ? *(const f32x4*)(bias + bcol0 + bj * HALF + 4 * n) : (f32x4){0.f, 0.f, 0.f, 0.f};
#pragma unroll
        for (int ai = 0; ai < 2; ++ai)
#pragma unroll
            for (int m = 0; m < 4; ++m) { bf16_t* rowp = base + (size_t)(row0 + ai * HALF + m * 16) * ldc + col0;
#pragma unroll
                for (int bj = 0; bj < 2; ++bj) { f32x4 v0 = acc[ai][bj][m][0] + bv[bj][0], v1 = acc[ai][bj][m][1] + bv[bj][1];
                    if (ACT == 1) { f32x2 a = gelu_pk((f32x2){v0[0], v0[1]}), b = gelu_pk((f32x2){v0[2], v0[3]}), c = gelu_pk((f32x2){v1[0], v1[1]}), d = gelu_pk((f32x2){v1[2], v1[3]});
                        v0 = (f32x4){a.x, a.y, b.x, b.y}; v1 = (f32x4){c.x, c.y, d.x, d.y}; }
                    v0 = v0 * sc; v1 = v1 * sc; u32x4 w; w.x = cvt_pk_bf16(v0[0], v0[1]); w.y = cvt_pk_bf16(v0[2], v0[3]); w.z = cvt_pk_bf16(v1[0], v1[1]); w.w = cvt_pk_bf16(v1[2], v1[3]);
                    *(u32x4*)(rowp + bj * HALF) = w; } }
    }
};

struct PanelStats {
    unsigned* xbuf;
    unsigned* cnt;
    unsigned* tmo;
    int ntn; float eps;
    unsigned code;
    __device__ __forceinline__ bool run(const f32x4 (&v)[2][2][4][2], const Unit& u, int wr, int wc, int fr, int fq, PG8_LAS unsigned char* lds, int wid, int lane) const {
        typedef float f32x2v __attribute__((ext_vector_type(2)));
        PG8_LAS f32x2v* P = (PG8_LAS f32x2v*)lds;
        PG8_LAS f32x2v* S = (PG8_LAS f32x2v*)(lds + 8192);
        PG8_LAS unsigned* flag = (PG8_LAS unsigned*)(lds + 8192 + 2048);
#pragma unroll
        for (int ai = 0; ai < 2; ++ai)
#pragma unroll
            for (int m = 0; m < 4; ++m) {
                float s = 0.f;
#pragma unroll
                for (int bj = 0; bj < 2; ++bj)
#pragma unroll
                    for (int n = 0; n < 2; ++n) { const f32x4 x = v[ai][bj][m][n]; s += (x[0] + x[1]) + (x[2] + x[3]); }
                s += __shfl_xor(s, 16); s += __shfl_xor(s, 32);
                const float mw = s * (1.0f / 64.0f); float q = 0.f;
#pragma unroll
                for (int bj = 0; bj < 2; ++bj)
#pragma unroll
                    for (int n = 0; n < 2; ++n) { const f32x4 d = v[ai][bj][m][n] - mw; q += (d[0] * d[0] + d[1] * d[1]) + (d[2] * d[2] + d[3] * d[3]); }
                q += __shfl_xor(q, 16); q += __shfl_xor(q, 32);
                if (fq == 0) P[(ai * HALF + wr * 64 + m * 16 + fr) * 4 + wc] = (f32x2v){mw, q};
            }
        asm volatile("s_waitcnt lgkmcnt(0)" ::: "memory"); __builtin_amdgcn_s_barrier(); asm volatile("" ::: "memory");
#if defined(BROKEN_EXCHANGE_NO_WAIT)
#warning BROKEN CONTROL BUILD: the row-statistics exchange does not wait; results are wrong by design
        if (blockIdx.x >= 64) { const long long t0_ = clock64(); while (clock64() - t0_ < 60000) __builtin_amdgcn_s_sleep(8); }
#endif
        const int row = wid * 32 + (lane & 31);
        if (lane < 32) {
            const f32x2v a = P[row * 4 + 0], b = P[row * 4 + 1], c = P[row * 4 + 2], d = P[row * 4 + 3];
            const float mt = (a.x + b.x + c.x + d.x) * 0.25f;
            const float da = a.x - mt, db = b.x - mt, dc = c.x - mt, dd = d.x - mt;
            const float m2 = (a.y + b.y) + (c.y + d.y) + 64.0f * ((da * da + db * db) + (dc * dc + dd * dd));
            unsigned long long* slot = (unsigned long long*)xbuf + ((size_t)(u.pm * BM + row) * 4 + u.pn);
            __hip_atomic_store(slot, ((unsigned long long)__float_as_uint(m2) << 32) | __float_as_uint(mt), __ATOMIC_RELAXED, __HIP_MEMORY_SCOPE_AGENT);
        }
        asm volatile("s_waitcnt vmcnt(0)" ::: "memory");
        if (lane == 0) __hip_atomic_fetch_add(cnt + 64 * u.pm, 1u, __ATOMIC_RELAXED, __HIP_MEMORY_SCOPE_AGENT);
        if (wid == 0) {
            bool dead = false; const unsigned long long t0 = __builtin_amdgcn_s_memrealtime(); const unsigned want = 8u * (unsigned)ntn;
            for (;;) {
#if defined(BROKEN_EXCHANGE_NO_WAIT)
                break;
#endif
                if ((unsigned)__builtin_amdgcn_readfirstlane(__hip_atomic_load(cnt + 64 * u.pm, __ATOMIC_RELAXED, __HIP_MEMORY_SCOPE_AGENT)) >= want) break;
                if (__builtin_amdgcn_s_memrealtime() - t0 > 2000000ull) {
                    if (lane == 0) { unsigned expect = 0u; __hip_atomic_compare_exchange_strong(tmo + 1, &expect, code | (unsigned)(u.pm & 0xff), __ATOMIC_RELAXED, __ATOMIC_RELAXED, __HIP_MEMORY_SCOPE_AGENT);
                                     __hip_atomic_store(tmo, 1u, __ATOMIC_RELAXED, __HIP_MEMORY_SCOPE_AGENT); }
                    dead = true; break; }
                __builtin_amdgcn_s_sleep(2);
            }
            __builtin_amdgcn_fence(__ATOMIC_ACQUIRE, "agent");
            if (lane == 0) flag[0] = dead ? 1u : 0u;
        }
        asm volatile("s_waitcnt vmcnt(0) lgkmcnt(0)" ::: "memory"); __builtin_amdgcn_s_barrier(); asm volatile("" ::: "memory");
        const bool bad = flag[0] != 0u;
        if (lane < 32) {
            const unsigned long long* slot = (const unsigned long long*)xbuf + (size_t)(u.pm * BM + row) * 4; float mt[4], m2[4]; float ms = 0.f;
#pragma unroll
            for (int t = 0; t < 4; ++t) { if (t < ntn) { const unsigned long long w = __hip_atomic_load(slot + t, __ATOMIC_RELAXED, __HIP_MEMORY_SCOPE_AGENT); mt[t] = __uint_as_float((unsigned)w); m2[t] = __uint_as_float((unsigned)(w >> 32)); } else { mt[t] = 0.f; m2[t] = 0.f; } ms += mt[t]; }
            const float mean = ms / (float)ntn; float q = 0.f;
#pragma unroll
            for (int t = 0; t < 4; ++t) if (t < ntn) { const float dm = mt[t] - mean; q += m2[t] + 256.0f * dm * dm; }
            S[row] = (f32x2v){mean, 1.0f / sqrtf(q / (256.0f * (float)ntn) + eps)};
        }
        asm volatile("s_waitcnt lgkmcnt(0)" ::: "memory"); __builtin_amdgcn_s_barrier(); asm volatile("" ::: "memory");
        return bad;
    }
};
struct EpiLnRes {
    static constexpr bool PERM = false, AFTER_DRAIN = true;
    const float* base; float* out; int ldc; const float* bias; PanelStats st; unsigned poison;
    __device__ __forceinline__ void fused(f32x4 (&acc)[2][2][4][2], const Unit& u, int wr, int wc, int fr, int fq, PG8_LAS unsigned char* lds, int wid, int lane) const {
        typedef float f32x2v __attribute__((ext_vector_type(2)));
        const PG8_LAS f32x2v* S = (const PG8_LAS f32x2v*)(lds + 8192);
        const int col0 = u.pn * BM + wc * 32 + 4 * fq;
#pragma unroll
        for (int bj = 0; bj < 2; ++bj)
#pragma unroll
            for (int n = 0; n < 2; ++n) { const f32x4 bv = bias ? *(const f32x4*)(bias + col0 + bj * HALF + n * 16) : (f32x4){0.f, 0.f, 0.f, 0.f};
#pragma unroll
                for (int ai = 0; ai < 2; ++ai)
#pragma unroll
                    for (int m = 0; m < 4; ++m) acc[ai][bj][m][n] += bv; }
        f32x4 pre[4][2][2];
#pragma unroll
        for (int m = 0; m < 4; ++m) { const size_t off = (size_t)(u.pm * BM + wr * 64 + m * 16 + fr) * ldc + col0;
#pragma unroll
            for (int bj = 0; bj < 2; ++bj)
#pragma unroll
                for (int n = 0; n < 2; ++n) pre[m][bj][n] = *(const f32x4*)(base + off + bj * HALF + n * 16); }
        const bool bad = st.run(acc, u, wr, wc, fr, fq, lds, wid, lane) || poison != 0u;
        const float qnan = __builtin_nanf("");
#pragma unroll
        for (int ai = 0; ai < 2; ++ai)
#pragma unroll
            for (int m = 0; m < 4; ++m) { const int r = ai * HALF + wr * 64 + m * 16 + fr; const f32x2v sr = S[r]; const size_t off = (size_t)(u.pm * BM + r) * ldc + col0;
#pragma unroll
                for (int bj = 0; bj < 2; ++bj)
#pragma unroll
                    for (int n = 0; n < 2; ++n) { const f32x4 bs = ai == 0 ? pre[m][bj][n] : *(const f32x4*)(base + off + bj * HALF + n * 16); f32x4 o = bs + (acc[ai][bj][m][n] - sr.x) * sr.y;
                        if (bad) o = (f32x4){qnan, qnan, qnan, qnan}; *(f32x4*)(out + off + bj * HALF + n * 16) = o; }
                if (m & 1) asm volatile("" ::: "memory"); }
    }
};
struct EpiLnResLn {
    static constexpr bool PERM = false, AFTER_DRAIN = true;
    const float* base; float* out; bf16_t* xn; int ldc; const float* bias; PanelStats st1, st2; unsigned poison;
    __device__ __forceinline__ void fused(f32x4 (&acc)[2][2][4][2], const Unit& u, int wr, int wc, int fr, int fq, PG8_LAS unsigned char* lds, int wid, int lane) const {
        typedef float f32x2v __attribute__((ext_vector_type(2))); typedef unsigned u32x2v __attribute__((ext_vector_type(2)));
        const PG8_LAS f32x2v* S = (const PG8_LAS f32x2v*)(lds + 8192);
        const int col0 = u.pn * BM + wc * 32 + 4 * fq;
#pragma unroll
        for (int bj = 0; bj < 2; ++bj)
#pragma unroll
            for (int n = 0; n < 2; ++n) { const f32x4 bv = bias ? *(const f32x4*)(bias + col0 + bj * HALF + n * 16) : (f32x4){0.f, 0.f, 0.f, 0.f};
#pragma unroll
                for (int ai = 0; ai < 2; ++ai)
#pragma unroll
                    for (int m = 0; m < 4; ++m) acc[ai][bj][m][n] += bv; }
        bool bad = st1.run(acc, u, wr, wc, fr, fq, lds, wid, lane) || poison != 0u;
        const float qnan = __builtin_nanf("");
#pragma unroll
        for (int ai = 0; ai < 2; ++ai)
#pragma unroll
            for (int m = 0; m < 4; ++m) { const int r = ai * HALF + wr * 64 + m * 16 + fr; const f32x2v sr = S[r]; const size_t off = (size_t)(u.pm * BM + r) * ldc + col0;
#pragma unroll
                for (int bj = 0; bj < 2; ++bj)
#pragma unroll
                    for (int n = 0; n < 2; ++n) { const f32x4 bs = *(const f32x4*)(base + off + bj * HALF + n * 16); acc[ai][bj][m][n] = bs + (acc[ai][bj][m][n] - sr.x) * sr.y; }
                asm volatile("" : "+v"(acc[ai][0][m][0]), "+v"(acc[ai][0][m][1]), "+v"(acc[ai][1][m][0]), "+v"(acc[ai][1][m][1]));
                if (m & 1) asm volatile("" ::: "memory"); }
        const bool bad1 = bad;
        bad = st2.run(acc, u, wr, wc, fr, fq, lds, wid, lane) || bad;
#pragma unroll
        for (int ai = 0; ai < 2; ++ai)
#pragma unroll
            for (int m = 0; m < 4; ++m) { const int r = ai * HALF + wr * 64 + m * 16 + fr; const f32x2v sr = S[r]; const size_t off = (size_t)(u.pm * BM + r) * ldc + col0;
#pragma unroll
                for (int bj = 0; bj < 2; ++bj)
#pragma unroll
                    for (int n = 0; n < 2; ++n) { const f32x4 x1 = acc[ai][bj][m][n]; *(f32x4*)(out + off + bj * HALF + n * 16) = bad1 ? (f32x4){qnan, qnan, qnan, qnan} : x1;
                        const f32x4 o = (x1 - sr.x) * sr.y; u32x2v w; w.x = cvt_pk_bf16(o[0], o[1]); w.y = cvt_pk_bf16(o[2], o[3]);
                        if (bad) { w.x = 0x7fc07fc0u; w.y = 0x7fc07fc0u; } *(u32x2v*)(xn + off + bj * HALF + n * 16) = w; }
                asm volatile("" ::: "memory"); }
    }
};

template <class Epi, class Sched, bool ALIGN_EPI = false, bool SP2 = false>
__device__ __forceinline__ void gemm_phase(PG8_LAS unsigned char* lds, const Gemm g, const Sched& S, const Epi& E) {
    int tid_l = threadIdx.x; asm volatile("" : "+v"(tid_l));
    const int tid = tid_l, wid = __builtin_amdgcn_readfirstlane(tid >> 6), lane = tid & 63, wr = wid >> 2, wc = wid & 3, fr = lane & 15, fq = lane >> 4;
    const int K = g.K, nt = K / BK;
    unsigned voffA[2], voffB[2];
#pragma unroll
    for (int i = 0; i < 2; ++i) { int R, C; stage_rc(tid * 16 + i * 8192, R, C); const int Rb = Epi::PERM ? ((R & ~31) + perm32(R & 31)) : R;
        voffA[i] = (unsigned)(R * K + C) * 2u; voffB[i] = (unsigned)(Rb * K + C) * 2u; }
    const size_t kstep = (size_t)(BK * 2);
    const size_t hstep = (size_t)HALF * K * 2;
    const size_t tstep = 2 * hstep;
    const unsigned ldsw = (unsigned)wid * 1024u;
    const int aoff = lds_byte(wr * 64 + fr, fq * 8), boff = lds_byte(wc * 32 + fr, fq * 8);
#define PG8_SA(b, h) (((b) * 2 + (h)) * HTB)
#define PG8_SB(b, h) ((4 + (b) * 2 + (h)) * HTB)
#define PG8_STAGE(bufoff, gbase, voff) do { _Pragma("unroll") for (int _i = 0; _i < 2; ++_i) \
        __builtin_amdgcn_global_load_lds((const unsigned*)((const char*)(gbase) + (voff)[_i]), (PG8_LAS unsigned*)(lds + (bufoff) + ldsw + _i * 8192), 16, 0, 0); } while (0)
#define PG8_LDA(dst, b, h) do { _Pragma("unroll") for (int m = 0; m < 4; ++m) _Pragma("unroll") for (int k = 0; k < 2; ++k) dst[m][k] = *(const PG8_LAS bf16x8*)(lds + PG8_SA(b, h) + aoff + m * 2048 + k * 1024); } while (0)
#define PG8_LDB(dst, b, h) do { _Pragma("unroll") for (int n = 0; n < 2; ++n) _Pragma("unroll") for (int k = 0; k < 2; ++k) dst[n][k] = *(const PG8_LAS bf16x8*)(lds + PG8_SB(b, h) + boff + n * 2048 + k * 1024); } while (0)
#define PG8_MMA(ai, bj, At, Bt) do { __builtin_amdgcn_s_setprio(1); _Pragma("unroll") for (int m = 0; m < 4; ++m) _Pragma("unroll") for (int n = 0; n < 2; ++n) _Pragma("unroll") for (int k = 0; k < 2; ++k) \
        acc[ai][bj][m][n] = __builtin_amdgcn_mfma_f32_16x16x32_bf16(Bt[n][k], At[m][k], acc[ai][bj][m][n], 0, 0, 0); __builtin_amdgcn_s_setprio(0); } while (0)
#define PG8_WAIT_V(n) asm volatile("s_waitcnt vmcnt(" #n ")" ::: "memory")
#define PG8_WAIT_L(n) asm volatile("s_waitcnt lgkmcnt(" #n ")" ::: "memory")
#define PG8_BAR __builtin_amdgcn_s_barrier()
#define PG8_SCHED __builtin_amdgcn_sched_barrier(0)
    Unit cur, nxt; int ui = 0;
    if (!S.next(0, cur)) return;
    f32x4 acc[2][2][4][2];
#pragma unroll
    for (int a = 0; a < 2; ++a)
#pragma unroll
        for (int b = 0; b < 2; ++b)
#pragma unroll
            for (int m = 0; m < 4; ++m)
#pragma unroll
                for (int n = 0; n < 2; ++n) acc[a][b][m][n] = (f32x4){0.f, 0.f, 0.f, 0.f};
    bf16x8 At[4][2], B0[2][2], B1[2][2];
    const char* cA = (const char*)g.A + (size_t)cur.pm * tstep; const char* cB = (const char*)g.Bt + (size_t)cur.pn * tstep;
    S.a_ready(cur);
    if constexpr (SP2) {
        PG8_STAGE(PG8_SB(0, 0), cB, voffB); PG8_STAGE(PG8_SB(0, 1), cB + hstep, voffB); PG8_STAGE(PG8_SA(0, 0), cA, voffA); PG8_STAGE(PG8_SA(0, 1), cA + hstep, voffA);
        if (wr == 1) PG8_BAR;
        PG8_WAIT_V(2); PG8_BAR;
        PG8_STAGE(PG8_SB(1, 0), cB + kstep, voffB); PG8_STAGE(PG8_SA(1, 0), cA + kstep, voffA); PG8_STAGE(PG8_SB(1, 1), cB + hstep + kstep, voffB);
        PG8_WAIT_V(6); PG8_BAR;
    } else {
        PG8_STAGE(PG8_SB(0, 0), cB, voffB); PG8_STAGE(PG8_SA(0, 0), cA, voffA); PG8_STAGE(PG8_SB(0, 1), cB + hstep, voffB); PG8_STAGE(PG8_SA(0, 1), cA + hstep, voffA);
        if (wr == 1) PG8_BAR;
        PG8_WAIT_V(4); PG8_BAR;
        PG8_STAGE(PG8_SB(1, 0), cB + kstep, voffB); PG8_STAGE(PG8_SA(1, 0), cA + kstep, voffA); PG8_STAGE(PG8_SB(1, 1), cB + hstep + kstep, voffB);
        PG8_WAIT_V(6); PG8_BAR;
    }
    for (;;) {
        const bool has_next = S.next(ui + 1, nxt);
        const char* nA = has_next ? (const char*)g.A + (size_t)nxt.pm * tstep : cA; const char* nB = has_next ? (const char*)g.Bt + (size_t)nxt.pn * tstep : cB;
        for (int t = 0; t < nt; t += 2) {
            const bool last = (t == nt - 2);
            const char* a1 = cA + (size_t)(t + 1) * kstep;
            const char* a2 = last ? nA : cA + (size_t)(t + 2) * kstep; const char* b2 = last ? nB : cB + (size_t)(t + 2) * kstep;
            const char* a3 = a2 + kstep; const char* b3 = b2 + kstep;
            if (last && has_next) S.a_ready(nxt);
            if constexpr (SP2) {
            PG8_LDB(B0, 0, 0); PG8_LDB(B1, 0, 1); PG8_SCHED; PG8_LDA(At, 0, 0); PG8_STAGE(PG8_SA(1, 1), a1 + hstep, voffA);
            PG8_WAIT_V(8); PG8_WAIT_L(0); PG8_BAR; PG8_MMA(0, 0, At, B0); PG8_MMA(0, 1, At, B1); PG8_BAR; PG8_SCHED;
            PG8_LDA(At, 0, 1); PG8_STAGE(PG8_SB(0, 0), b2, voffB); PG8_STAGE(PG8_SB(0, 1), b2 + hstep, voffB); PG8_STAGE(PG8_SA(0, 0), a2, voffA);
            PG8_WAIT_V(8); PG8_WAIT_L(0); PG8_BAR; PG8_MMA(1, 0, At, B0); PG8_MMA(1, 1, At, B1); PG8_BAR; PG8_SCHED;
            PG8_LDB(B0, 1, 0); PG8_LDB(B1, 1, 1); PG8_SCHED; PG8_LDA(At, 1, 0); PG8_STAGE(PG8_SA(0, 1), a2 + hstep, voffA);
            PG8_WAIT_V(8); PG8_WAIT_L(0); PG8_BAR; PG8_MMA(0, 0, At, B0); PG8_MMA(0, 1, At, B1); PG8_BAR; PG8_SCHED;
            PG8_LDA(At, 1, 1); PG8_STAGE(PG8_SB(1, 0), b3, voffB); PG8_STAGE(PG8_SB(1, 1), b3 + hstep, voffB); PG8_STAGE(PG8_SA(1, 0), a3, voffA);
            PG8_WAIT_V(8); PG8_WAIT_L(0); PG8_BAR; PG8_MMA(1, 0, At, B0); PG8_MMA(1, 1, At, B1); PG8_BAR; PG8_SCHED;
            } else {
            PG8_LDB(B0, 0, 0); PG8_SCHED; PG8_LDA(At, 0, 0); PG8_STAGE(PG8_SA(1, 1), a1 + hstep, voffA);
            PG8_WAIT_L(8); PG8_BAR; PG8_WAIT_L(0); PG8_MMA(0, 0, At, B0); PG8_BAR; PG8_SCHED;
            PG8_LDB(B1, 0, 1); PG8_STAGE(PG8_SB(0, 0), b2, voffB);
            PG8_BAR; PG8_WAIT_L(0); PG8_MMA(0, 1, At, B1); PG8_BAR;
            PG8_LDA(At, 0, 1); PG8_STAGE(PG8_SA(0, 0), a2, voffA);
            PG8_BAR; PG8_WAIT_L(0); PG8_MMA(1, 0, At, B0); PG8_BAR; PG8_SCHED;
            PG8_STAGE(PG8_SB(0, 1), b2 + hstep, voffB);
            PG8_WAIT_V(6); PG8_BAR; PG8_MMA(1, 1, At, B1); PG8_BAR;
            PG8_LDB(B0, 1, 0); PG8_SCHED; PG8_LDA(At, 1, 0); PG8_STAGE(PG8_SA(0, 1), a2 + hstep, voffA);
            PG8_WAIT_L(8); PG8_BAR; PG8_WAIT_L(0); PG8_MMA(0, 0, At, B0); PG8_BAR; PG8_SCHED;
            PG8_LDB(B1, 1, 1); PG8_STAGE(PG8_SB(1, 0), b3, voffB);
            PG8_BAR; PG8_WAIT_L(0); PG8_MMA(0, 1, At, B1); PG8_BAR;
            PG8_LDA(At, 1, 1); PG8_STAGE(PG8_SA(1, 0), a3, voffA);
            PG8_BAR; PG8_WAIT_L(0); PG8_MMA(1, 0, At, B0); PG8_BAR; PG8_SCHED;
            PG8_STAGE(PG8_SB(1, 1), b3 + hstep, voffB);
            PG8_WAIT_V(6); PG8_BAR; PG8_MMA(1, 1, At, B1); PG8_BAR;
            }
        }
        if constexpr (ALIGN_EPI) { if (wr == 0) PG8_BAR; }
        if constexpr (!Epi::AFTER_DRAIN) { E(acc, cur, wr, wc, fr, fq); S.done(cur); }
        if (!has_next) break;
#pragma unroll
        for (int a = 0; a < 2; ++a)
#pragma unroll
            for (int b = 0; b < 2; ++b)
#pragma unroll
                for (int m = 0; m < 4; ++m)
#pragma unroll
                    for (int n = 0; n < 2; ++n) acc[a][b][m][n] = (f32x4){0.f, 0.f, 0.f, 0.f};
        cur = nxt; cA = nA; cB = nB; ++ui;
        if constexpr (ALIGN_EPI) { if (wr == 1) PG8_BAR; }
    }
    PG8_WAIT_V(0);
    if constexpr (!ALIGN_EPI) { if (wr == 0) PG8_BAR; }
    PG8_BAR;
    if constexpr (Epi::AFTER_DRAIN) { E.fused(acc, cur, wr, wc, fr, fq, lds, wid, lane); S.done(cur); }
#undef PG8_SA
#undef PG8_SB
#undef PG8_STAGE
#undef PG8_LDA
#undef PG8_LDB
#undef PG8_MMA
#undef PG8_WAIT_V
#undef PG8_WAIT_L
#undef PG8_BAR
#undef PG8_SCHED
}
}

#include <hip/hip_bf16.h>
#include <cmath>
namespace attn_body {
using bf16=__hip_bfloat16;
using bf16x8=__attribute__((ext_vector_type(8)))short;
using s16x4=__attribute__((ext_vector_type(4)))short;
using f32x16=__attribute__((ext_vector_type(16)))float;
using u32x4=__attribute__((ext_vector_type(4)))unsigned;
constexpr int D=64;
constexpr int NW=8,QBLK=32,QB=QBLK*NW,KVBLK=64;
__device__ __forceinline__ int crow(int r,int hi){return (r&3)+8*(r>>2)+4*hi;}
#define SBAR() __builtin_amdgcn_sched_barrier(0)

__device__ __forceinline__ void na_mask(f32x16&p0,f32x16&p1,int krow,int gr,int c,int hi,const __attribute__((address_space(3))) float* tab,float mhat){
  const float NEG=-INFINITY;
  asm volatile("":"+v"(hi),"+v"(c));
  int rs=gr-4; rs=rs<0?0:(rs>120?120:rs);
  const bool rowok=(unsigned)(krow-rs)<8u;
  if(!rowok){
    #pragma unroll
    for(int r=0;r<16;++r){p0[r]=NEG;p1[r]=NEG;}
  } else {
    int cs=c-8; cs=cs<0?0:(cs>48?48:cs);
    const int tb=(krow-gr+7)*31-c+15;
    #pragma unroll
    for(int r=0;r<16;++r){
      const int kv=crow(r,hi);
      const bool ok0=(unsigned)(kv-cs)<16u, ok1=(unsigned)(kv+32-cs)<16u;
      const float b0=tab[ok0?(tb+kv):0], b1=tab[ok1?(tb+kv+32):0];
      p0[r]=ok0?(b0-mhat):NEG; p1[r]=ok1?(b1-mhat):NEG;
    }
  }
}
constexpr int NSLOT=3, SLOTB=8192;
constexpr int LDS_K=0, LDS_V=NSLOT*SLOTB, LDS_WS=2*NSLOT*SLOTB, LDS_OST=LDS_WS+NW*64*4, LDS_BYTES=LDS_OST+NW*4096;
constexpr float C2=0.125f*1.4426950408889634f;
__device__ __forceinline__ void glds16(const void*gsrc,unsigned lds_dst){unsigned keep;
  asm volatile("s_mov_b32 %0, m0\n\ts_mov_b32 m0, %2\n\ts_nop 0\n\tglobal_load_lds_dwordx4 %1, off\n\ts_mov_b32 m0, %0":"=&s"(keep):"v"(gsrc),"s"(lds_dst):"memory");}
__device__ __forceinline__ float max3f(float a,float b,float c){float r;asm("v_max3_f32 %0, %1, %2, %3":"=v"(r):"v"(a),"v"(b),"v"(c));return r;}
__device__ __forceinline__ float max2f(float a,float b){float r;asm("v_max_f32_e32 %0, %1, %2":"=v"(r):"v"(a),"v"(b));return r;}
__device__ __forceinline__ float fadd_s(float a,float b){float r;asm("v_add_f32_e32 %0, %1, %2":"=v"(r):"v"(a),"v"(b));return r;}
__device__ __forceinline__ float fsub_s(float a,float b){float r;asm("v_sub_f32_e32 %0, %1, %2":"=v"(r):"v"(a),"v"(b));return r;}
typedef float f32x2_t __attribute__((ext_vector_type(2))); typedef __bf16 bf16x2_t __attribute__((ext_vector_type(2)));
__device__ __forceinline__ unsigned cvtpk_s(float lo,float hi){f32x2_t v={lo,hi};bf16x2_t b=__builtin_convertvector(v,bf16x2_t);return __builtin_bit_cast(unsigned,b);}
#define WAIT_BAR(N) asm volatile("s_waitcnt vmcnt(" #N ") lgkmcnt(0)\n\ts_barrier":::"memory")

__device__ __forceinline__ void qkt(f32x16&p0,f32x16&p1,const char*Kslot,const bf16x8*qr,const f32x16&negm,int r32,int hi){
  const char*kb=Kslot+hi*1024+r32*16;
  #pragma unroll
  for(int d0=0;d0<4;++d0){
    const bf16x8 b0=*reinterpret_cast<const bf16x8*>(kb+d0*2048);
    const bf16x8 b1=*reinterpret_cast<const bf16x8*>(kb+d0*2048+512);
    if(d0==0){p0=__builtin_amdgcn_mfma_f32_32x32x16_bf16(b0,qr[0],negm,0,0,0);p1=__builtin_amdgcn_mfma_f32_32x32x16_bf16(b1,qr[0],negm,0,0,0);}
    else{p0=__builtin_amdgcn_mfma_f32_32x32x16_bf16(b0,qr[d0],p0,0,0,0);p1=__builtin_amdgcn_mfma_f32_32x32x16_bf16(b1,qr[d0],p1,0,0,0);}}
}
typedef __attribute__((address_space(3))) const char* lds_cptr;
typedef short v4i16_t __attribute__((ext_vector_type(4)));
__device__ __forceinline__ void kload8(bf16x8*kf,lds_cptr kp){
  kf[0]=*(const __attribute__((address_space(3))) bf16x8*)(kp);      kf[1]=*(const __attribute__((address_space(3))) bf16x8*)(kp+512);
  kf[2]=*(const __attribute__((address_space(3))) bf16x8*)(kp+2048); kf[3]=*(const __attribute__((address_space(3))) bf16x8*)(kp+2560);
  kf[4]=*(const __attribute__((address_space(3))) bf16x8*)(kp+4096); kf[5]=*(const __attribute__((address_space(3))) bf16x8*)(kp+4608);
  kf[6]=*(const __attribute__((address_space(3))) bf16x8*)(kp+6144); kf[7]=*(const __attribute__((address_space(3))) bf16x8*)(kp+6656);
}
__device__ __forceinline__ void kload2(bf16x8*kf,lds_cptr kp,int j){ kf[2*j]=*(const __attribute__((address_space(3))) bf16x8*)(kp+j*2048); kf[2*j+1]=*(const __attribute__((address_space(3))) bf16x8*)(kp+j*2048+512); }
__device__ __forceinline__ s16x4 vtr(lds_cptr p){ return __builtin_bit_cast(s16x4,__builtin_amdgcn_ds_read_tr16_b64_v4i16((__attribute__((address_space(3))) v4i16_t*)p)); }
__device__ __forceinline__ float rowmax(const f32x16&p0,const f32x16&p1){
  float a=max3f(p0[0],p0[1],p1[0]),b=max3f(p0[2],p0[3],p1[1]);a=max3f(a,p1[2],p1[3]);
  #pragma unroll
  for(int r=4;r<16;r+=4){a=max3f(a,p0[r],p0[r+1]);b=max3f(b,p0[r+2],p0[r+3]);a=max3f(a,p1[r],p1[r+1]);b=max3f(b,p1[r+2],p1[r+3]);}
  const float m=max2f(a,b);
  auto rr=__builtin_amdgcn_permlane32_swap(__float_as_uint(m),__float_as_uint(m),false,false);
  return max2f(__uint_as_float(rr[0]),__uint_as_float(rr[1]));
}
__device__ __forceinline__ void pv(f32x16*o,int vb,bf16x8 pa0,bf16x8 pa1,bf16x8 pa2,bf16x8 pa3){
  #pragma unroll
  for(int d0=0;d0<2;++d0){s16x4 lo[4],hi[4];
    #pragma unroll
    for(int ks=0;ks<4;++ks){
      asm volatile("ds_read_b64_tr_b16 %0,%1 offset:%c2":"=&v"(lo[ks]):"v"(vb),"i"(d0*4096+ks*1024):"memory");
      asm volatile("ds_read_b64_tr_b16 %0,%1 offset:%c2":"=&v"(hi[ks]):"v"(vb),"i"(d0*4096+ks*1024+512):"memory");}
    asm volatile("s_waitcnt lgkmcnt(0)":::"memory");SBAR();
    #define PK(k) (bf16x8){lo[k][0],lo[k][1],lo[k][2],lo[k][3],hi[k][0],hi[k][1],hi[k][2],hi[k][3]}
    o[d0]=__builtin_amdgcn_mfma_f32_32x32x16_bf16(pa0,PK(0),o[d0],0,0,0);
    o[d0]=__builtin_amdgcn_mfma_f32_32x32x16_bf16(pa1,PK(1),o[d0],0,0,0);
    o[d0]=__builtin_amdgcn_mfma_f32_32x32x16_bf16(pa2,PK(2),o[d0],0,0,0);
    o[d0]=__builtin_amdgcn_mfma_f32_32x32x16_bf16(pa3,PK(3),o[d0],0,0,0);
    #undef PK
  }
}

#ifndef ATTN_STORE16
#define ATTN_STORE16(p,v) (*(u32x4*)(p)=(v))
#endif
struct NaP { int gr0; int r_lo; const __attribute__((address_space(3))) float* tab; };
template<int THRL,bool NA> __device__ __forceinline__ void attn_unit(const bf16*Qb,const bf16*Kc,const bf16*Vc,bf16*Ob,int kr0,int T0,int kr1,int NT,NaP nap,char*shm){
  constexpr int QP=1792,KP=1792,VP=1792,OP=1024;
  int tid_l=threadIdx.x; asm volatile("":"+v"(tid_l));
  const int tid=tid_l,lane=tid&63,r32=lane&31,hi=lane>>5; const int wid=__builtin_amdgcn_readfirstlane(tid>>6);
  const bf16*Qw=Qb+(long)(wid*QBLK)*QP;
  const unsigned lds0=(unsigned)(uintptr_t)shm;
  float*wsf=(float*)(shm+LDS_WS)+wid*64;
  const bf16*ksrc=Kc+(long)lane*KP+wid*8;
  const bf16*vsrc=Vc+(long)(16*(wid&3)+(lane>>2))*VP+(wid>>2)*32+(lane&3)*8;
  const unsigned kdst=lds0+LDS_K+wid*1024, vdst=lds0+LDS_V+wid*1024;
  #define KROW(t) ((long)(((t)<T0)?(kr0+(t)*KVBLK):(kr1+((t)-T0)*KVBLK)))
  #define DMA_K(t,slot) glds16(ksrc+KROW(t)*KP,(unsigned)__builtin_amdgcn_readfirstlane(kdst+(slot)))
  #define DMA_V(t,slot) glds16(vsrc+KROW(t)*VP,(unsigned)__builtin_amdgcn_readfirstlane(vdst+(slot)))
  const int vb0=(int)(lds0+LDS_V)+((lane>>4)&1)*32+(lane&3)*8+(4*hi+((lane&15)>>2))*64;
  const char*Kbase=shm+LDS_K; bf16x8 kf[8];
  const lds_cptr shm3=(lds_cptr)shm; const lds_cptr kp0=shm3+LDS_K+hi*1024+r32*16; const lds_cptr vp0=shm3+LDS_V+((lane>>4)&1)*32+(lane&3)*8+(4*hi+((lane&15)>>2))*64;
  DMA_K(0,0);DMA_V(0,0);DMA_K(1,SLOTB);
  bf16x8 qr[4];
  #pragma unroll
  for(int d0=0;d0<4;++d0)qr[d0]=*reinterpret_cast<const bf16x8*>(&Qw[(long)r32*QP+d0*16+hi*8]);
  float mhat=0.f,l_reg=0.f;f32x16 o[2];o[0]=f32x16{};o[1]=f32x16{};f32x16 negm=f32x16{};if(!NA)asm volatile("":"+v"(negm));
  #define CMASK(P0,P1,t) do{}while(0)
  #define NAFILL(C0,C1,t) do{ if(NA){ if((t)>=T0) na_mask(C0,C1,nap.r_lo+((t)-T0),nap.gr0+(wid>>1),(wid&1)*32+r32,hi,nap.tab,mhat); else { _Pragma("unroll") for(int r_=0;r_<16;++r_){C0[r_]=-mhat;C1[r_]=-mhat;} } } }while(0)
  bool resc=false;
  #define START(P0,P1) do{ const float rm=rowmax(P0,P1); resc=false; \
    { const float dl=rm; mhat=fadd_s(mhat,dl); \
      _Pragma("unroll") for(int r=0;r<16;++r){P0[r]=fsub_s(P0[r],dl);P1[r]=fsub_s(P1[r],dl);} \
      if(!NA){ _Pragma("unroll") for(int r=0;r<16;++r)negm[r]=-mhat; asm volatile("":"+v"(negm)); } } \
    _Pragma("unroll") for(int r=0;r<16;++r)P0[r]=__builtin_amdgcn_exp2f(P0[r]); }while(0)
  #define RESC() do{ if(resc){ asm volatile("s_waitcnt lgkmcnt(0)":::"memory"); \
      _Pragma("unroll") for(int d_=0;d_<2;++d_) _Pragma("unroll") for(int r=0;r<16;++r)o[d_][r]*=wsf[crow(r,hi)]; } }while(0)
  f32x16 pA0,pA1,pB0,pB1;
  int sl_prev=0,sl_cur=0,sl_next=SLOTB;
  #define ROT() do{sl_prev=sl_cur;sl_cur=sl_next;sl_next=(sl_next==(NSLOT-1)*SLOTB)?0:sl_next+SLOTB;}while(0)
  DMA_K(2,2*SLOTB);
  WAIT_BAR(3);
  qkt(pA0,pA1,Kbase,qr,negm,r32,hi);asm volatile("s_nop 15\n\ts_nop 7":"+v"(pA0),"+v"(pA1));CMASK(pA0,pA1,0);
  START(pA0,pA1);
  _Pragma("unroll") for(int r=0;r<16;++r)pA1[r]=__builtin_amdgcn_exp2f(pA1[r]);
  WAIT_BAR(0);
  DMA_K(3,0);DMA_V(1,SLOTB);
  ROT();
  kload8(kf,kp0+sl_cur);
  WAIT_BAR(2);
  s16x4 vlo[8],vhi[8]; u32x4 pw0,pw1,pw2,pw3;
  #define PKW(P,B) cvtpk_s(P[B],P[B+1])
  #define PAF(k) __builtin_bit_cast(bf16x8,pw##k)
  #define VFR(i) (bf16x8){vlo[i][0],vlo[i][1],vlo[i][2],vlo[i][3],vhi[i][0],vhi[i][1],vhi[i][2],vhi[i][3]}
  #define PIN(x) asm volatile("":"+v"(x))
  #define MX3(a,b,c) __builtin_fmaxf(__builtin_fmaxf((a),(b)),(c))
  #define GAPA(MF,A0,A1,A2,A3,W0,W1,PW) do{ MF; sacc+=A0; sacc+=A1; sacc+=A2; sacc+=A3; PIN(sacc); W0; W1; PIN(PW); SBAR(); }while(0)
  #define EX(v) __builtin_amdgcn_exp2f(v)
  #define GAPB(MF,X,B) do{ MF; X[B]=EX(X[B]); X[B+1]=EX(X[B+1]); X[B+2]=EX(X[B+2]); X[B+3]=EX(X[B+3]); PIN(X); SBAR(); }while(0)
  #define VRD(i) do{ vlo[i]=vtr(vp_+(((i)>>2)*4096+((i)&3)*1024)); vhi[i]=vtr(vp_+(((i)>>2)*4096+((i)&3)*1024+512)); }while(0)
  #define KRD(G,j) do{ if(G){ kload2(kf,kp0+sl_next,j); SBAR(); } }while(0)
  #define STEP(C0,C1,P0,P1,t,GK,GV,GL) do{ SBAR(); NAFILL(C0,C1,t); SBAR(); \
    const lds_cptr vp_=vp0+sl_prev; \
    VRD(0); SBAR(); float sacc=(P0[0]+P0[1]); \
    GAPA(C0=__builtin_amdgcn_mfma_f32_32x32x16_bf16(kf[0],qr[0],(NA?C0:negm),0,0,0), P0[2],P0[3],P0[4],P0[5],     pw0[0]=PKW(P0,0), pw0[1]=PKW(P0,2), pw0); \
    VRD(4); SBAR(); GAPA(C1=__builtin_amdgcn_mfma_f32_32x32x16_bf16(kf[1],qr[0],(NA?C1:negm),0,0,0), P0[6],P0[7],P0[8],P0[9],     pw0[2]=PKW(P0,4), pw0[3]=PKW(P0,6), pw0); \
    VRD(1); SBAR(); GAPA(C0=__builtin_amdgcn_mfma_f32_32x32x16_bf16(kf[2],qr[1],C0,0,0,0),   P0[10],P0[11],P0[12],P0[13], pw1[0]=PKW(P0,8), pw1[1]=PKW(P0,10), pw1); \
    VRD(5); SBAR(); GAPA(C1=__builtin_amdgcn_mfma_f32_32x32x16_bf16(kf[3],qr[1],C1,0,0,0),   P0[14],P0[15],P1[0],P1[1],   pw1[2]=PKW(P0,12),pw1[3]=PKW(P0,14), pw1); \
    VRD(2); SBAR(); GAPA(C0=__builtin_amdgcn_mfma_f32_32x32x16_bf16(kf[4],qr[2],C0,0,0,0),   P1[2],P1[3],P1[4],P1[5],     pw2[0]=PKW(P1,0), pw2[1]=PKW(P1,2), pw2); \
    VRD(6); SBAR(); GAPA(C1=__builtin_amdgcn_mfma_f32_32x32x16_bf16(kf[5],qr[2],C1,0,0,0),   P1[6],P1[7],P1[8],P1[9],     pw2[2]=PKW(P1,4), pw2[3]=PKW(P1,6), pw2); \
    VRD(3); SBAR(); GAPA(C0=__builtin_amdgcn_mfma_f32_32x32x16_bf16(kf[6],qr[3],C0,0,0,0),   P1[10],P1[11],P1[12],P1[13], pw3[0]=PKW(P1,8), pw3[1]=PKW(P1,10), pw3); \
    VRD(7); SBAR(); GAPA(C1=__builtin_amdgcn_mfma_f32_32x32x16_bf16(kf[7],qr[3],C1,0,0,0),   P1[14],P1[15],0.f,0.f,       pw3[2]=PKW(P1,12),pw3[3]=PKW(P1,14), pw3); \
    l_reg+=sacc; \
    if(GK){DMA_K((t)+3,sl_cur);} if(GV){DMA_V((t)+1,sl_next);} \
    CMASK(C0,C1,t); \
    { float a=MX3(C0[0],C0[1],C1[0]),b=MX3(C0[2],C0[3],C1[1]); a=MX3(a,C1[2],C1[3]); \
      _Pragma("unroll") for(int r=4;r<16;r+=4){a=MX3(a,C0[r],C0[r+1]);b=MX3(b,C0[r+2],C0[r+3]);a=MX3(a,C1[r],C1[r+1]);b=MX3(b,C1[r+2],C1[r+3]);} \
      float rm=__builtin_fmaxf(a,b); { auto rr=__builtin_amdgcn_permlane32_swap(__float_as_uint(rm),__float_as_uint(rm),false,false); rm=__builtin_fmaxf(__uint_as_float(rr[0]),__uint_as_float(rr[1])); } \
      resc=false; \
      if(__builtin_expect(__any(rm>(float)THRL),0)){ const float dl=__builtin_fmaxf(rm,0.f); mhat+=dl; \
        _Pragma("unroll") for(int r=0;r<16;++r){C0[r]-=dl;C1[r]-=dl;} \
        if(!NA){ _Pragma("unroll") for(int r=0;r<16;++r)negm[r]=-mhat; asm volatile("":"+v"(negm)); } \
        const float f=__builtin_amdgcn_exp2f(-dl); l_reg*=f; if(hi==0)wsf[r32]=f; resc=true; } } \
    SBAR(); \
    GAPB(o[0]=__builtin_amdgcn_mfma_f32_32x32x16_bf16(PAF(0),VFR(0),o[0],0,0,0), C0,0); \
    GAPB(o[1]=__builtin_amdgcn_mfma_f32_32x32x16_bf16(PAF(0),VFR(4),o[1],0,0,0), C0,4); \
    KRD(GL,0); GAPB(o[0]=__builtin_amdgcn_mfma_f32_32x32x16_bf16(PAF(1),VFR(1),o[0],0,0,0), C0,8); \
    KRD(GL,1); GAPB(o[1]=__builtin_amdgcn_mfma_f32_32x32x16_bf16(PAF(1),VFR(5),o[1],0,0,0), C0,12); \
    KRD(GL,2); GAPB(o[0]=__builtin_amdgcn_mfma_f32_32x32x16_bf16(PAF(2),VFR(2),o[0],0,0,0), C1,0); \
    KRD(GL,3); GAPB(o[1]=__builtin_amdgcn_mfma_f32_32x32x16_bf16(PAF(2),VFR(6),o[1],0,0,0), C1,4); \
    GAPB(o[0]=__builtin_amdgcn_mfma_f32_32x32x16_bf16(PAF(3),VFR(3),o[0],0,0,0), C1,8); \
    GAPB(o[1]=__builtin_amdgcn_mfma_f32_32x32x16_bf16(PAF(3),VFR(7),o[1],0,0,0), C1,12); \
    }while(0)
  int t=1;
  for(;t+5<NT;t+=2){
    STEP(pB0,pB1,pA0,pA1,t,true,true,true);     WAIT_BAR(2); RESC(); ROT();
    STEP(pA0,pA1,pB0,pB1,t+1,true,true,true);   WAIT_BAR(2); RESC(); ROT();
  }
  #define ENDW(tt) do{ if((tt)+3<NT){WAIT_BAR(2);} else if((tt)+2<NT){WAIT_BAR(1);} else {WAIT_BAR(0);} }while(0)
  for(;t+1<NT;t+=2){
    STEP(pB0,pB1,pA0,pA1,t,(t+3<NT),(t+1<NT),(t+1<NT));       ENDW(t);   RESC(); ROT();
    STEP(pA0,pA1,pB0,pB1,t+1,(t+4<NT),(t+2<NT),(t+2<NT));     ENDW(t+1); RESC(); ROT();
  }
  STEP(pB0,pB1,pA0,pA1,NT-1,false,false,false); RESC();
  { float sacc=pB0[0]+pB0[1]; _Pragma("unroll") for(int r=2;r<16;++r)sacc+=pB0[r]; _Pragma("unroll") for(int r=0;r<16;++r)sacc+=pB1[r]; l_reg+=sacc;
    pw0=(u32x4){PKW(pB0,0),PKW(pB0,2),PKW(pB0,4),PKW(pB0,6)};pw1=(u32x4){PKW(pB0,8),PKW(pB0,10),PKW(pB0,12),PKW(pB0,14)};pw2=(u32x4){PKW(pB1,0),PKW(pB1,2),PKW(pB1,4),PKW(pB1,6)};pw3=(u32x4){PKW(pB1,8),PKW(pB1,10),PKW(pB1,12),PKW(pB1,14)};
    SBAR(); pv(o,vb0+sl_cur,PAF(0),PAF(1),PAF(2),PAF(3)); }
  #undef PKW
  #undef PAF
  #undef VFR
  #undef PIN
  #undef MX3
  #undef GAPA
  #undef GAPB
  #undef EX
  #undef VRD
  #undef KRD
  #undef STEP
  #undef ENDW
  {auto rr=__builtin_amdgcn_permlane32_swap(__float_as_uint(l_reg),__float_as_uint(l_reg),false,false);l_reg=__uint_as_float(rr[0])+__uint_as_float(rr[1]);}
  if(hi==0)wsf[32+r32]=l_reg;asm volatile("s_waitcnt lgkmcnt(0)":::"memory");
  float rli[16];
  #pragma unroll
  for(int r=0;r<16;++r)rli[r]=__builtin_amdgcn_rcpf(wsf[32+crow(r,hi)]);
  bf16*Ow=Ob+(long)(wid*QBLK)*OP;
  { bf16*stg=(bf16*)(shm+LDS_OST)+wid*2048;
    #pragma unroll
    for(int r=0;r<16;++r){const int orow=crow(r,hi);
      #pragma unroll
      for(int d0=0;d0<2;++d0)stg[orow*64+d0*32+r32]=__float2bfloat16(o[d0][r]*rli[r]);}
    asm volatile("s_waitcnt lgkmcnt(0)":::"memory");
    #pragma unroll
    for(int i=0;i<4;++i){const int row=i*8+(lane>>3),ch=lane&7; const u32x4 v=*(const u32x4*)(stg+row*64+ch*8); ATTN_STORE16(Ow+(long)row*OP+ch*8,v);} }
  asm volatile("s_waitcnt lgkmcnt(0)\n\ts_barrier":::"memory");
  #undef DMA_K
  #undef KROW
  #undef DMA_V
  #undef CMASK
  #undef NAFILL
  #undef START
  #undef RESC
  #undef ROT
}
constexpr int ATTN_LDS_BYTES=LDS_BYTES;
#undef SBAR
#undef WAIT_BAR
}

#include <hip/hip_cooperative_groups.h>
namespace cg = cooperative_groups;

#ifndef PHMASK
#define PHMASK 0xffff
#endif
#ifndef MK_N_LAUNCHES
#define MK_N_LAUNCHES 1
#endif

#define GAS __attribute__((address_space(1)))
#define LAS __attribute__((address_space(3)))
typedef unsigned short bf16r;
typedef float f32x4 __attribute__((ext_vector_type(4)));
typedef float f32x2 __attribute__((ext_vector_type(2)));
typedef unsigned u32x2 __attribute__((ext_vector_type(2)));
typedef unsigned u32x4 __attribute__((ext_vector_type(4)));

constexpr int DM = 1024, NB = 2, SEQ = 8192, CTXL = 256, DEPTH = 2;
constexpr int ML = NB * SEQ;
constexpr int MC = NB * CTXL;
constexpr int MT = ML + MC;
constexpr int INW = 3072, FFH = 2816, FF2 = 5632, NMOD = 6 * DM;
constexpr float LN_EPS = 1e-6f, DN_ALPHA = 1.4142135623730951f;
constexpr float LOG2E = 1.4426950408889634f, QSCALE = 0.125f * LOG2E;
constexpr int NCHUNK = 132, NCHAIN = 16, NHU = NCHAIN * NCHUNK;

constexpr size_t MiB = 1u << 20;
constexpr size_t WS_MODS = 1 * MiB;
constexpr size_t WS_LB = WS_MODS + 160 * 1024;
constexpr size_t WS_ROPE = WS_LB + 8 * 1024;
constexpr size_t WS_WIN = 2 * MiB;
constexpr size_t WS_WOUT = 14 * MiB;
constexpr size_t WS_WF1 = 18 * MiB;
constexpr size_t WS_WF2 = 40 * MiB;
constexpr size_t WS_XCTX = 51 * MiB;
constexpr size_t WS_H = 53 * MiB;
constexpr size_t WS_P = 86 * MiB;
constexpr size_t ROWS2 = (size_t)MT * 2;
constexpr int QKVP = 1792;
constexpr int CGQ = 0, CGK = 384, CGV = 512, CNQ = 640, CNK = 1024, CNV = 1408;
constexpr size_t WS_QKV = WS_P;
constexpr size_t WS_NV_END = WS_QKV + ROWS2 * QKVP;
constexpr size_t WS_HQ = WS_NV_END;
constexpr size_t WS_HI = WS_HQ + ROWS2 * 256;
constexpr size_t WS_HG = WS_HI + ROWS2 * 256;
constexpr size_t WS_HF = WS_HG + ROWS2 * 256;
constexpr size_t WS_HB = WS_HF + ROWS2 * 512;
constexpr size_t WS_PEND = WS_HB + ROWS2 * 512;
constexpr size_t WS_HH = WS_P;
constexpr size_t WS_SST = 202 * MiB;
constexpr size_t WS_ADEC = 235 * MiB;
constexpr size_t WS_END = 236 * MiB;
static_assert(WS_PEND <= WS_SST && WS_HH + ROWS2 * FFH <= WS_SST && WS_SST + (size_t)NHU * 4096 * 4 <= WS_ADEC, "ws map");

constexpr int LDS_BYTES = 147456;
constexpr int NA_TAB_OFF = 90112;

struct Args { const float* in[17]; float* out; unsigned char* ws; int ph_lo, ph_hi; };

__device__ __forceinline__ unsigned pk_bf16(float lo, float hi) { f32x2 v = {lo, hi}; typedef __bf16 bf2 __attribute__((ext_vector_type(2))); bf2 b = __builtin_convertvector(v, bf2); return __builtin_bit_cast(unsigned, b); }
__device__ __forceinline__ float bf2f(bf16r v) { return __builtin_bit_cast(float, (unsigned)v << 16); }
__device__ __forceinline__ float silu_f(float x) { return x / (1.f + __expf(-x)); }
__device__ __forceinline__ float wave_sum(float v) {
#pragma unroll
    for (int o = 1; o < 64; o <<= 1) v += __shfl_xor(v, o);
    return v;
}
__device__ __forceinline__ int seg_of_row(int r) { return r < SEQ ? 0 : (r < ML ? 1 : 2); }
__device__ __forceinline__ float* xrow_ptr(float* out, float* xctx, int r) { return r < ML ? out + (size_t)r * DM : xctx + (size_t)(r - ML) * DM; }

struct EpiIn {
    static constexpr bool PERM = false, AFTER_DRAIN = false;
    bf16r *HQ, *HI, *HG, *QKV; float *HF, *HB;
    const float *lb, *qn, *kn; const f32x2* rope;
    __device__ __forceinline__ static void st_bf16(bf16r* p, const f32x4 v) { u32x2 w; w.x = pk_bf16(v[0], v[1]); w.y = pk_bf16(v[2], v[3]); *(u32x2*)p = w; }
    __device__ __forceinline__ void operator()(const pg8::f32x4 (&acc)[2][2][4][2], const pg8::Unit& u, int wr, int wc, int fr, int fq) const {
        const int grp = 4 * u.pn + wc;
#pragma unroll
        for (int ai = 0; ai < 2; ++ai)
#pragma unroll
            for (int m = 0; m < 4; ++m) {
                const int r = u.pm * 256 + ai * 128 + wr * 64 + m * 16 + fr;
                f32x4 v[2][2];
#pragma unroll
                for (int bj = 0; bj < 2; ++bj)
#pragma unroll
                    for (int n = 0; n < 2; ++n) { v[bj][n][0] = acc[ai][bj][m][n][0]; v[bj][n][1] = acc[ai][bj][m][n][1]; v[bj][n][2] = acc[ai][bj][m][n][2]; v[bj][n][3] = acc[ai][bj][m][n][3]; }
                if (grp < 20) {
                    const int part = grp >> 2, hc = (grp & 3) * 64;
                    if (part == 1 || part == 2) {
                        float* dst = (part == 1 ? HF : HB) + (size_t)r * 256 + hc;
                        const float* lbp = lb + (part - 1) * 256 + hc;
#pragma unroll
                        for (int bj = 0; bj < 2; ++bj)
#pragma unroll
                            for (int n = 0; n < 2; ++n) { const int d = 32 * bj + 16 * n + 4 * fq; const f32x4 l4 = *(const f32x4*)(lbp + d); f32x4 o;
#pragma unroll
                                for (int e = 0; e < 4; ++e) { const float sg = 1.f / (1.f + expf(-v[bj][n][e])); o[e] = l4[e] + (1.f - l4[e]) * sg; }
                                *(f32x4*)(dst + d) = o; }
                    } else {
                        bf16r* dst = (part == 0 ? HQ : (part == 3 ? HI : HG)) + (size_t)r * 256 + hc;
#pragma unroll
                        for (int bj = 0; bj < 2; ++bj)
#pragma unroll
                            for (int n = 0; n < 2; ++n) { const int d = 32 * bj + 16 * n + 4 * fq; f32x4 o = v[bj][n];
                                if (part != 3) {
#pragma unroll
                                    for (int e = 0; e < 4; ++e) o[e] = silu_f(o[e]); }
                                st_bf16(dst + d, o); }
                    }
                } else if (grp < 28) {
                    const bool isq = grp < 26; const int hh = isq ? grp - 20 : grp - 26;
                    const float* gn = isq ? qn : kn;
                    float ss = 0.f;
#pragma unroll
                    for (int bj = 0; bj < 2; ++bj)
#pragma unroll
                        for (int n = 0; n < 2; ++n)
#pragma unroll
                            for (int e = 0; e < 4; ++e) ss += v[bj][n][e] * v[bj][n][e];
                    ss += __shfl_xor(ss, 16); ss += __shfl_xor(ss, 32);
                    const float rn = 1.f / sqrtf(ss * (1.f / 64.f) + LN_EPS);
                    const float osc = isq ? QSCALE : 1.f;
                    bf16r* dst = QKV + (size_t)r * QKVP + (isq ? CGQ : CGK) + hh * 64;
                    const bool lat = r < ML; const int t = r & (SEQ - 1);
#pragma unroll
                    for (int bj = 0; bj < 2; ++bj) {
                        const int pos = bj ? (t & 63) : (t >> 6);
#pragma unroll
                        for (int n = 0; n < 2; ++n) { const int d = 32 * bj + 16 * n + 4 * fq; const f32x4 g4 = *(const f32x4*)(gn + d); f32x4 o;
#pragma unroll
                            for (int e = 0; e < 4; ++e) o[e] = v[bj][n][e] * rn * g4[e];
                            if (lat) {
#pragma unroll
                                for (int pp = 0; pp < 2; ++pp) { const f32x2 cs = rope[pos * 16 + 8 * n + 2 * fq + pp]; const float x1 = o[2 * pp], x2 = o[2 * pp + 1];
                                    o[2 * pp] = x1 * cs.x - x2 * cs.y; o[2 * pp + 1] = x1 * cs.y + x2 * cs.x; } }
                            o = o * osc; st_bf16(dst + d, o); }
                    }
                } else {
                    bf16r* dst; float osc = 1.f;
                    if (grp < 30) dst = QKV + (size_t)r * QKVP + CGV + (grp - 28) * 64;
                    else if (grp < 36) { dst = QKV + (size_t)r * QKVP + CNQ + (grp - 30) * 64; osc = QSCALE; }
                    else if (grp < 42) dst = QKV + (size_t)r * QKVP + CNK + (grp - 36) * 64;
                    else dst = QKV + (size_t)r * QKVP + CNV + (grp - 42) * 64;
#pragma unroll
                    for (int bj = 0; bj < 2; ++bj)
#pragma unroll
                        for (int n = 0; n < 2; ++n) { const int d = 32 * bj + 16 * n + 4 * fq; st_bf16(dst + d, v[bj][n] * osc); }
                }
            }
    }
};
struct EpiRes {
    static constexpr bool PERM = false, AFTER_DRAIN = false;
    float* out; float* xctx; const float* gate;
    __device__ __forceinline__ void operator()(const pg8::f32x4 (&acc)[2][2][4][2], const pg8::Unit& u, int wr, int wc, int fr, int fq) const {
        const int sg = seg_of_row(u.pm * 256);
        const float* gp = gate + sg * NMOD + u.pn * 256 + wc * 32 + 4 * fq;
        f32x4 g4[2][2];
#pragma unroll
        for (int bj = 0; bj < 2; ++bj)
#pragma unroll
            for (int n = 0; n < 2; ++n) g4[bj][n] = *(const f32x4*)(gp + bj * 128 + n * 16);
#pragma unroll
        for (int ai = 0; ai < 2; ++ai)
#pragma unroll
            for (int m = 0; m < 4; ++m) {
                const int r = u.pm * 256 + ai * 128 + wr * 64 + m * 16 + fr;
                float* xp = xrow_ptr(out, xctx, r) + u.pn * 256 + wc * 32 + 4 * fq;
#pragma unroll
                for (int bj = 0; bj < 2; ++bj)
#pragma unroll
                    for (int n = 0; n < 2; ++n) { float* p = xp + bj * 128 + n * 16; const f32x4 x4 = *(const f32x4*)p; f32x4 a; a[0] = acc[ai][bj][m][n][0]; a[1] = acc[ai][bj][m][n][1]; a[2] = acc[ai][bj][m][n][2]; a[3] = acc[ai][bj][m][n][3];
                        *(f32x4*)p = x4 * DN_ALPHA + g4[bj][n] * a; }
            }
    }
};
struct EpiSwiglu {
    static constexpr bool PERM = false, AFTER_DRAIN = false;
    bf16r* HH;
    __device__ __forceinline__ void operator()(const pg8::f32x4 (&acc)[2][2][4][2], const pg8::Unit& u, int wr, int wc, int fr, int fq) const {
#pragma unroll
        for (int ai = 0; ai < 2; ++ai)
#pragma unroll
            for (int m = 0; m < 4; ++m) {
                const int r = u.pm * 256 + ai * 128 + wr * 64 + m * 16 + fr;
                bf16r* hp = HH + (size_t)r * FFH + u.pn * 128 + wc * 32 + 4 * fq;
#pragma unroll
                for (int n = 0; n < 2; ++n) { f32x4 o;
#pragma unroll
                    for (int e = 0; e < 4; ++e) o[e] = silu_f(acc[ai][0][m][n][e]) * acc[ai][1][m][n][e];
                    u32x2 w; w.x = pk_bf16(o[0], o[1]); w.y = pk_bf16(o[2], o[3]); *(u32x2*)(hp + n * 16) = w; }
            }
    }
};

__device__ __forceinline__ void transpose_item(const float* W, int K, int N, bf16r* WT, int mode, LAS float* scr, int item, int lane) {
    const int nblk = N / 32, kb = item / nblk, nb = item % nblk, k0 = 64 * kb, n0 = 32 * nb;
#pragma unroll 8
    for (int i = 0; i < 32; ++i) { const int kk = 2 * i + (lane >> 5); scr[kk * 33 + (lane & 31)] = W[(size_t)(k0 + kk) * N + n0 + (lane & 31)]; }
    asm volatile("s_waitcnt lgkmcnt(0)" ::: "memory");
    int ro = n0;
    if (mode == 1) ro = (n0 & ~255) + 128 * ((n0 & 63) >> 5) + 32 * ((n0 & 255) >> 6);
    else if (mode == 2) { const int up = n0 >= FFH, j = up ? n0 - FFH : n0; ro = 256 * (j >> 7) + 128 * up + (j & 127); }
    const int c = lane & 7;
#pragma unroll
    for (int j = 0; j < 4; ++j) { const int n = (lane >> 3) + 8 * j; const LAS float* s = scr + (8 * c) * 33 + n;
        u32x4 o; o.x = pk_bf16(s[0 * 33], s[1 * 33]); o.y = pk_bf16(s[2 * 33], s[3 * 33]); o.z = pk_bf16(s[4 * 33], s[5 * 33]); o.w = pk_bf16(s[6 * 33], s[7 * 33]);
        *(u32x4*)(WT + (size_t)(ro + n) * K + k0 + 8 * c) = o; }
    asm volatile("s_waitcnt lgkmcnt(0)" ::: "memory");
}

__global__ void __launch_bounds__(512) hybrid_fwd(Args args) {
    extern __shared__ __attribute__((aligned(16))) unsigned char lds[];
    LAS unsigned char* L = (LAS unsigned char*)lds;
    const int G = gridDim.x, bx = blockIdx.x, NGW = G * 8;
    unsigned char* ws = args.ws;
    float* out = args.out;
    float* xctx = (float*)(ws + WS_XCTX);
    float* MODS = (float*)(ws + WS_MODS);
    float* LBT = (float*)(ws + WS_LB);
    f32x2* ROPE = (f32x2*)(ws + WS_ROPE);
    bf16r* Hb = (bf16r*)(ws + WS_H);
    bf16r* QKV = (bf16r*)(ws + WS_QKV);
    bf16r *HQ = (bf16r*)(ws + WS_HQ), *HI = (bf16r*)(ws + WS_HI), *HG = (bf16r*)(ws + WS_HG);
    float *HF = (float*)(ws + WS_HF), *HB = (float*)(ws + WS_HB);
    bf16r* HH = (bf16r*)(ws + WS_HH);
    float* SST = (float*)(ws + WS_SST); float* ADEC = (float*)(ws + WS_ADEC);
    cg::grid_group grid = cg::this_grid();

    for (int ph = args.ph_lo; ph < args.ph_hi; ++ph) {
        int tid_l = threadIdx.x; asm volatile("" : "+v"(tid_l));
        const int tid = tid_l, lane = tid & 63, wave = __builtin_amdgcn_readfirstlane(tid >> 6), gw = bx * 8 + wave;
        if (ph == 0 && (PHMASK & 1)) {
            LAS float* scr = (LAS float*)(L + wave * 16384);
            constexpr int I_IN = 16 * (INW / 32), I_OUT = 16 * (DM / 32), I_F1 = 16 * (FF2 / 32), I_F2 = (FFH / 64) * (DM / 32), I_L = I_IN + I_OUT + I_F1 + I_F2;
            for (int it = gw; it < DEPTH * I_L; it += NGW) {
                const int l = it / I_L; int r = it % I_L;
                if (r < I_IN) { transpose_item(args.in[6] + (size_t)l * DM * INW, DM, INW, (bf16r*)(ws + WS_WIN) + (size_t)l * INW * DM, 1, scr, r, lane); continue; } r -= I_IN;
                if (r < I_OUT) { transpose_item(args.in[12] + (size_t)l * DM * DM, DM, DM, (bf16r*)(ws + WS_WOUT) + (size_t)l * DM * DM, 0, scr, r, lane); continue; } r -= I_OUT;
                if (r < I_F1) { transpose_item(args.in[13] + (size_t)l * DM * FF2, DM, FF2, (bf16r*)(ws + WS_WF1) + (size_t)l * FF2 * DM, 2, scr, r, lane); continue; } r -= I_F1;
                transpose_item(args.in[14] + (size_t)l * FFH * DM, FFH, DM, (bf16r*)(ws + WS_WF2) + (size_t)l * DM * FFH, 0, scr, r, lane);
            }
            __syncthreads();
            if (bx < 192) {
                LAS float* sc = (LAS float*)L;
                LAS float* red = (LAS float*)(L + 16384);
                for (int i = tid; i < 3 * DM; i += 512) { const int s = i >> 10, k = i & 1023; const float cv = s < 2 ? args.in[1][s * DM + k] : args.in[3][k]; sc[i] = silu_f(cv); }
                __syncthreads();
                for (int it = bx; it < 192; it += G) {
                    const int l = it / 96, n0 = (it % 96) * 64;
                    const float* wa = args.in[4] + (size_t)l * DM * NMOD + n0 + lane;
                    float a0 = 0.f, a1 = 0.f, a2 = 0.f;
#pragma unroll 8
                    for (int k = wave * 128; k < wave * 128 + 128; ++k) { const float w = wa[(size_t)k * NMOD]; a0 += sc[k] * w; a1 += sc[DM + k] * w; a2 += sc[2 * DM + k] * w; }
                    red[(wave * 3 + 0) * 64 + lane] = a0; red[(wave * 3 + 1) * 64 + lane] = a1; red[(wave * 3 + 2) * 64 + lane] = a2;
                    __syncthreads();
                    if (tid < 192) { const int s = tid >> 6; float sum = 0.f;
#pragma unroll
                        for (int w = 0; w < 8; ++w) sum += red[(w * 3 + s) * 64 + lane];
                        MODS[(l * 3 + s) * NMOD + n0 + lane] = sum + args.in[5][l * NMOD + n0 + lane]; }
                    __syncthreads();
                }
            }
            if (bx == G - 1) {
                for (int i = tid; i < 128 * 16; i += 512) { const int pos = i >> 4, j = i & 15; const float invf = expf((-9.210340371976184f * (float)j) / 16.0f); const float ang = (float)pos * invf; ROPE[i] = (f32x2){cosf(ang), sinf(ang)}; }
                { const int d = tid >> 8, k = tid & 255; const float a0 = args.in[7][d * 256 + k], a1 = args.in[7][512 + d * 256 + k]; const float mx = fmaxf(a0, a1); const float e0 = expf(a0 - mx), e1 = expf(a1 - mx);
                  const float p1 = e1 / (e0 + e1); LBT[d * 256 + k] = 0.f; LBT[512 + d * 256 + k] = fminf(fmaxf(p1, 0.f), 1.f); }
            }
        } else if (ph == 1 && (PHMASK & 2)) {
            for (int r = gw; r < MT; r += NGW) {
                const float* src = r < ML ? args.in[0] + (size_t)r * DM : args.in[2] + (size_t)(r - ML) * DM;
                float* xp = xrow_ptr(out, xctx, r); const float* md = MODS + seg_of_row(r) * NMOD;
#pragma unroll
                for (int j = 0; j < 4; ++j) { const int c = 4 * lane + 256 * j; const f32x4 v = *(const f32x4*)(src + c); *(f32x4*)(xp + c) = v;
                    const f32x4 sh = *(const f32x4*)(md + c), scv = *(const f32x4*)(md + DM + c); const f32x4 h = v * (scv + 1.f) + sh;
                    u32x2 w; w.x = pk_bf16(h[0], h[1]); w.y = pk_bf16(h[2], h[3]); *(u32x2*)(Hb + (size_t)r * DM + c) = w; }
            }
        } else {
            const int l = (ph - 2) / 9, sub = (ph - 2) % 9;
            const bool need_ctx = l < DEPTH - 1;
            const float* modl = MODS + (size_t)l * 3 * NMOD;
            if (sub == 0 && (PHMASK & 4)) {
                pg8::Gemm g{Hb, (const bf16r*)(ws + WS_WIN) + (size_t)l * INW * DM, MT, INW, DM}; pg8::StaticOrder S; S.init(MT, INW, G, bx);
                EpiIn E{HQ, HI, HG, QKV, HF, HB, LBT + l * 512, args.in[9] + l * 64, args.in[10] + l * 64, ROPE};
                pg8::gemm_phase<EpiIn, pg8::StaticOrder, true, true>(L, g, S, E);
            } else if (sub == 1 && (PHMASK & 8)) {
                LAS float* stf = (LAS float*)(L + wave * 2048);
                for (int u = gw; u < NHU; u += NGW) {
                    const int chain = u / NCHUNK, c = u % NCHUNK, b = chain >> 3, h = (chain >> 1) & 3, dir = chain & 1;
                    int base, sgn;
                    if (dir == 0) { base = c < 4 ? ML + b * CTXL + 64 * c : b * SEQ + 64 * (c - 4); sgn = 1; }
                    else { base = c < 4 ? ML + b * CTXL + 255 - 64 * c : b * SEQ + SEQ - 1 - 64 * (c - 4); sgn = -1; }
                    const float* F = (dir ? HB : HF) + h * 64;
                    float s[64]; float a = 1.f;
#pragma unroll
                    for (int k = 0; k < 64; ++k) s[k] = 0.f;
#pragma unroll 1
                    for (int t0 = 0; t0 < 64; t0 += 8) {
                        float vv[8];
#pragma unroll
                        for (int j = 0; j < 2; ++j) { const int idx = lane + 64 * j, tk = idx >> 4, k4 = (idx & 15) * 4; const int row = base + sgn * (t0 + tk);
                            *(LAS f32x4*)(stf + tk * 64 + k4) = *(const f32x4*)(F + (size_t)row * 256 + k4); }
#pragma unroll
                        for (int i = 0; i < 8; ++i) { const int row = base + sgn * (t0 + i); vv[i] = bf2f(HI[(size_t)row * 256 + h * 64 + lane]); }
                        asm volatile("s_waitcnt lgkmcnt(0)" ::: "memory");
#pragma unroll 1
                        for (int i = 0; i < 8; ++i) {
                            float v = vv[0];
#pragma unroll
                            for (int q = 1; q < 8; ++q) v = (i == q) ? vv[q] : v;
                            a *= stf[i * 64 + lane];
#pragma unroll
                            for (int k4 = 0; k4 < 16; ++k4) { const f32x4 f4 = *(const LAS f32x4*)(stf + i * 64 + 4 * k4);
#pragma unroll
                                for (int e = 0; e < 4; ++e) { const int k = 4 * k4 + e; s[k] = __builtin_fmaf(f4[e], s[k] - v, v); } }
                        }
                        asm volatile("s_waitcnt lgkmcnt(0)" ::: "memory");
                    }
                    float* so = SST + (size_t)u * 4096 + lane;
#pragma unroll
                    for (int k = 0; k < 64; ++k) so[k * 64] = s[k];
                    ADEC[(size_t)u * 64 + lane] = a;
                }
            } else if (sub == 2 && (PHMASK & 16)) {
                const int gt = bx * 512 + tid;
                if (gt < NCHAIN * 4096) {
                    const int chain = gt >> 12, e = gt & 4095, k = e >> 6;
                    float* sp = SST + (size_t)chain * NCHUNK * 4096 + e; const float* ap = ADEC + (size_t)chain * NCHUNK * 64 + k;
                    float s = 0.f;
#pragma unroll 6
                    for (int c = 0; c < NCHUNK; ++c) { const float loc = sp[(size_t)c * 4096], a = ap[c * 64]; sp[(size_t)c * 4096] = s; s = a * s + loc; }
                }
            } else if (sub == 3 && (PHMASK & 32)) {
                using attn_body::bf16;
                bf16* MIX = (bf16*)Hb; const bf16* QK = (const bf16*)QKV;
                const attn_body::NaP nap0{0, 0, (const LAS float*)(L + NA_TAB_OFF)};
                for (int id = bx; id < 384; id += G) {
                    const int b = id / 192, rem = id % 192, h = rem >> 5, qb = rem & 31, kvh = h / 3; const long q0 = (long)b * SEQ + 256 * qb;
                    attn_body::attn_unit<8, false>(QK + q0 * QKVP + CGQ + h * 64, QK + CGK + kvh * 64, QK + CGV + kvh * 64, MIX + q0 * DM + 256 + h * 64,
                                                   b * SEQ, 128, ML + b * CTXL, 132, nap0, (char*)lds);
                }
                const int hl = G >> 1, li = bx - hl, nl = G - hl;
                if (li >= 0) {
                    for (int id = li; id < 384; id += nl) {
                        const int b = id / 192, rem = id % 192, h = rem >> 5, qb = rem & 31; const long q0 = (long)b * SEQ + 256 * qb;
                        const int gr0 = 4 * qb, lo = gr0 - 4 < 0 ? 0 : gr0 - 4; int rs3 = gr0 - 1; rs3 = rs3 < 0 ? 0 : (rs3 > 120 ? 120 : rs3);
                        const int cnt = rs3 + 7 - lo + 1, ntl = cnt == 8 ? 8 : 12;
                        __syncthreads();
                        { int t_ = tid; asm volatile("" : "+v"(t_)); if (t_ < 465) ((LAS float*)(L + NA_TAB_OFF))[t_] = args.in[11][(size_t)(l * 6 + h) * 465 + t_] * LOG2E; }
                        __syncthreads();
                        const attn_body::NaP nap{gr0, lo, (const LAS float*)(L + NA_TAB_OFF)};
                        attn_body::attn_unit<8, true>(QK + q0 * QKVP + CNQ + h * 64, QK + CNK + h * 64, QK + CNV + h * 64, MIX + q0 * DM + 640 + h * 64,
                                                      ML + b * CTXL, 4, b * SEQ + 64 * lo, 4 + ntl, nap, (char*)lds);
                    }
                    if (need_ctx) {
                        for (int id = li; id < 24; id += nl) {
                            const int na = id / 12, rem = id % 12, b = rem / 6, h = rem % 6; const long q0 = (long)ML + b * CTXL;
                            const int cq = na ? CNQ + h * 64 : CGQ + h * 64, ck = na ? CNK + h * 64 : CGK + (h / 3) * 64, cv = na ? CNV + h * 64 : CGV + (h / 3) * 64, co = (na ? 640 : 256) + h * 64;
                            attn_body::attn_unit<8, false>(QK + q0 * QKVP + cq, QK + ck, QK + cv, MIX + q0 * DM + co, (int)q0, 4, (int)q0, 4, nap0, (char*)lds);
                        }
                    }
                    __syncthreads();
                    LAS float* stf = (LAS float*)(L + wave * 2048);
                    LAS float* stq = stf + 256;
                    LAS float* ob = (LAS float*)(L + 16384 + wave * 16384);
                    const int nblk = need_ctx ? 132 : 128, NU2 = NB * 4 * nblk;
                    const float gnorm = args.in[8][l * 64 + lane];
                    for (int u = li * 8 + wave; u < NU2; u += nl * 8) {
                        const int j = u % nblk, bh = u / nblk, b = bh >> 2, h = bh & 3;
                        const int rbase = j < 128 ? b * SEQ + 64 * j : ML + b * CTXL + 64 * (j - 128);
#pragma unroll 1
                        for (int dir = 1; dir >= 0; --dir) {
                            const int chain = bh * 2 + dir;
                            const int c = dir ? (j < 128 ? 4 + (127 - j) : 3 - (j - 128)) : (j < 128 ? 4 + j : j - 128);
                            const float* F = (dir ? HB : HF) + h * 64;
                            const float* sp = SST + ((size_t)chain * NCHUNK + c) * 4096 + lane;
                            float s[64];
#pragma unroll
                            for (int k = 0; k < 64; ++k) s[k] = sp[k * 64];
#pragma unroll 1
                            for (int t0 = 0; t0 < 64; t0 += 4) {
                                float vv[4];
                                { const int tk = lane >> 4, k4 = (lane & 15) * 4; const int ro = dir ? 63 - (t0 + tk) : t0 + tk; const size_t row = (size_t)(rbase + ro);
                                  *(LAS f32x4*)(stf + tk * 64 + k4) = *(const f32x4*)(F + row * 256 + k4);
                                  const u32x2 qw = *(const u32x2*)(HQ + row * 256 + h * 64 + k4);
                                  f32x4 q4; q4[0] = __builtin_bit_cast(float, qw.x << 16); q4[1] = __builtin_bit_cast(float, qw.x & 0xffff0000u); q4[2] = __builtin_bit_cast(float, qw.y << 16); q4[3] = __builtin_bit_cast(float, qw.y & 0xffff0000u);
                                  *(LAS f32x4*)(stq + tk * 64 + k4) = q4; }
#pragma unroll
                                for (int i = 0; i < 4; ++i) { const int ro = dir ? 63 - (t0 + i) : t0 + i; vv[i] = bf2f(HI[(size_t)(rbase + ro) * 256 + h * 64 + lane]); }
                                asm volatile("s_waitcnt lgkmcnt(0)" ::: "memory");
#pragma unroll 1
                                for (int i = 0; i < 4; ++i) {
                                    const float v = (i == 0) ? vv[0] : (i == 1) ? vv[1] : (i == 2) ? vv[2] : vv[3];
                                    float o0 = 0.f, o1 = 0.f;
#pragma unroll
                                    for (int k4 = 0; k4 < 16; ++k4) { const f32x4 f4 = *(const LAS f32x4*)(stf + i * 64 + 4 * k4), q4 = *(const LAS f32x4*)(stq + i * 64 + 4 * k4);
#pragma unroll
                                        for (int e = 0; e < 4; ++e) { const int k = 4 * k4 + e; s[k] = __builtin_fmaf(f4[e], s[k] - v, v); if (e & 1) o1 = __builtin_fmaf(s[k], q4[e], o1); else o0 = __builtin_fmaf(s[k], q4[e], o0); } }
                                    const float o = o0 + o1; const int ro = dir ? 63 - (t0 + i) : t0 + i;
                                    if (dir) ob[ro * 64 + lane] = o;
                                    else {
                                        const float ot = o + ob[ro * 64 + lane];
                                        const float ms = wave_sum(ot * ot) * (1.f / 64.f);
                                        const size_t row = (size_t)(rbase + ro);
                                        const float y = ot * (1.f / sqrtf(ms + LN_EPS)) * gnorm * bf2f(HG[row * 256 + h * 64 + lane]);
                                        ((bf16r*)MIX)[row * DM + h * 64 + lane] = (bf16r)(pk_bf16(y, 0.f) & 0xffffu);
                                    }
                                }
                                asm volatile("s_waitcnt lgkmcnt(0)" ::: "memory");
                            }
                        }
                    }
                }
            } else if ((sub == 4 || sub == 7) && (PHMASK & 64)) {
                const int Mr = need_ctx ? MT : ML;
                if (sub == 4) { pg8::Gemm g{Hb, (const bf16r*)(ws + WS_WOUT) + (size_t)l * DM * DM, Mr, DM, DM}; pg8::StaticOrder S; S.init(Mr, DM, G, bx);
                    EpiRes E{out, xctx, modl + 2 * DM}; pg8::gemm_phase<EpiRes, pg8::StaticOrder, true, true>(L, g, S, E); }
                else { pg8::Gemm g{HH, (const bf16r*)(ws + WS_WF2) + (size_t)l * DM * FFH, Mr, DM, FFH}; pg8::StaticOrder S; S.init(Mr, DM, G, bx);
                    EpiRes E{out, xctx, modl + 5 * DM}; pg8::gemm_phase<EpiRes, pg8::StaticOrder, true, true>(L, g, S, E); }
            } else if ((sub == 5 || sub == 8) && (PHMASK & 128)) {
                const int which = sub == 5 ? 0 : 1; const int Mr = need_ctx ? MT : ML;
                const float* lg = args.in[15] + (size_t)(l * 2 + which) * DM; const float* lbv = args.in[16] + (size_t)(l * 2 + which) * DM;
                const bool wantH = (which == 0) || (l + 1 < DEPTH);
                const float* mdn = which == 0 ? modl + 3 * DM : MODS + (size_t)(l + 1) * 3 * NMOD;
                for (int r = gw; r < Mr; r += NGW) {
                    float* xp = xrow_ptr(out, xctx, r); f32x4 v[4]; float sm = 0.f;
#pragma unroll
                    for (int j = 0; j < 4; ++j) { v[j] = *(const f32x4*)(xp + 4 * lane + 256 * j); sm += (v[j][0] + v[j][1]) + (v[j][2] + v[j][3]); }
                    const float mean = wave_sum(sm) * (1.f / DM); float s2 = 0.f;
#pragma unroll
                    for (int j = 0; j < 4; ++j) { v[j] = v[j] - mean; s2 += (v[j][0] * v[j][0] + v[j][1] * v[j][1]) + (v[j][2] * v[j][2] + v[j][3] * v[j][3]); }
                    const float rstd = 1.f / sqrtf(wave_sum(s2) * (1.f / DM) + LN_EPS);
                    const float* md = mdn + seg_of_row(r) * NMOD;
#pragma unroll
                    for (int j = 0; j < 4; ++j) { const int c = 4 * lane + 256 * j; const f32x4 y = v[j] * rstd * *(const f32x4*)(lg + c) + *(const f32x4*)(lbv + c); *(f32x4*)(xp + c) = y;
                        if (wantH) { const f32x4 sh = *(const f32x4*)(md + c), scv = *(const f32x4*)(md + DM + c); const f32x4 h = y * (scv + 1.f) + sh;
                            u32x2 w; w.x = pk_bf16(h[0], h[1]); w.y = pk_bf16(h[2], h[3]); *(u32x2*)(Hb + (size_t)r * DM + c) = w; } }
                }
            } else if (sub == 6 && (PHMASK & 256)) {
                const int Mr = need_ctx ? MT : ML;
                pg8::Gemm g{Hb, (const bf16r*)(ws + WS_WF1) + (size_t)l * FF2 * DM, Mr, FF2, DM}; pg8::StaticOrder S; S.init(Mr, FF2, G, bx);
                EpiSwiglu E{HH}; pg8::gemm_phase<EpiSwiglu, pg8::StaticOrder, true, true>(L, g, S, E);
            }
        }
        if (ph + 1 < args.ph_hi) { __syncthreads(); grid.sync(); }
    }
}

constexpr int N_PHASES = 2 + 9 * DEPTH;
extern "C" void kernel_launch(void* const* d_in, const int* in_sizes, int n_in, void* d_out, int out_size, void* d_ws, size_t ws_size, hipStream_t stream) {
    static int grid = 0;
    if (grid == 0) {
        if (n_in != 17 || out_size != ML * DM || ws_size < WS_END) { fprintf(stderr, "kernel_launch: unexpected shapes (n_in %d out %d ws %zu)\n", n_in, out_size, ws_size); grid = -1; return; }
        int dev = 0, cus = 0, per_cu = 0;
        hipGetDevice(&dev); hipDeviceGetAttribute(&cus, hipDeviceAttributeMultiprocessorCount, dev);
        if (hipFuncSetAttribute((const void*)hybrid_fwd, hipFuncAttributeMaxDynamicSharedMemorySize, LDS_BYTES) != hipSuccess) { fprintf(stderr, "kernel_launch: hipFuncSetAttribute failed\n"); grid = -1; return; }
        if (hipOccupancyMaxActiveBlocksPerMultiprocessor(&per_cu, (const void*)hybrid_fwd, 512, LDS_BYTES) != hipSuccess || per_cu < 1) { fprintf(stderr, "kernel_launch: occupancy query says %d\n", per_cu); (void)hipGetLastError(); grid = -1; return; }
        grid = cus;
    }
    if (grid < 0) return;
    Args a{};
    for (int i = 0; i < 17; ++i) a.in[i] = (const float*)d_in[i];
    a.out = (float*)d_out; a.ws = (unsigned char*)d_ws;
#if MK_N_LAUNCHES == 1
    a.ph_lo = 0; a.ph_hi = N_PHASES;
    void* kargs[] = {&a};
    hipError_t e = hipLaunchCooperativeKernel((const void*)hybrid_fwd, dim3(grid), dim3(512), kargs, LDS_BYTES, stream);
    if (e != hipSuccess) fprintf(stderr, "cooperative launch failed: %s (grid %d)\n", hipGetErrorString(e), grid);
#else
    for (int p = 0; p < N_PHASES; ++p) { a.ph_lo = p; a.ph_hi = p + 1; hipLaunchKernelGGL(hybrid_fwd, dim3(grid), dim3(512), LDS_BYTES, stream, a); }
#endif
}
```

```cpp
#include <hip/hip_runtime.h>
#include <cstdio>
#include <cstdint>
namespace pg8 {
#define PG8_LAS __attribute__((address_space(3)))
typedef unsigned short bf16_t;
typedef short bf16x8 __attribute__((ext_vector_type(8)));
typedef float f32x4 __attribute__((ext_vector_type(4)));
typedef unsigned u32x4 __attribute__((ext_vector_type(4)));
constexpr int BM = 256, BK = 64, HALF = 128, HTB = HALF * BK * 2  , STAGE_BYTES = 8 * HTB, NXCD = 8, WGM = 8;

__host__ __device__ __forceinline__ int lds_byte(int r, int c) { const int st = (r >> 4) * 2 + (c >> 5), rr = r & 15, cc = c & 31, ob = rr * 64 + cc * 2; return st * 1024 + (ob ^ (((ob >> 9) & 1) << 5)); }
__host__ __device__ __forceinline__ void stage_rc(int b, int& R, int& C) { const int st = b / 1024, sb = b % 1024, swz = sb ^ (((sb >> 9) & 1) << 5); R = (st >> 1) * 16 + swz / 64; C = (st & 1) * 32 + (swz % 64) / 2; }
__host__ __device__ __forceinline__ int perm32(int rho) { const int n = rho >> 4, i = rho & 15; return 8 * (i >> 2) + 4 * n + (i & 3); }

struct Unit { int pm, pn; };
struct Gemm { const bf16_t* A; const bf16_t* Bt; int M, N, K; };

struct StaticOrder {
    int nM, nN, nwg, G, c;
    __host__ __device__ void init(int M, int N, int G_, int c_) { nM = M / BM; nN = N / BM; nwg = nM * nN; G = G_; c = c_; }
    __host__ __device__ bool next(int i, Unit& u) const {
        const long L = (long)i * G + c; if (L >= nwg) return false;
        int wgid = (int)L; { const int q = nwg / NXCD, r = nwg % NXCD, xcd = wgid % NXCD, off = wgid / NXCD; wgid = (xcd < r ? xcd * (q + 1) : r * (q + 1) + (xcd - r) * q) + off; }
        const int nig = WGM * nN, gid = wgid / nig, fm = gid * WGM, gsz = (nM - fm) < WGM ? (nM - fm) : WGM;
        u.pm = fm + ((wgid % nig) % gsz); u.pn = (wgid % nig) / gsz; return true;
    }
    __device__ __forceinline__ void a_ready(const Unit&) const {}
    __device__ __forceinline__ void done(const Unit&) const {}
};

__device__ __forceinline__ unsigned cvt_pk_bf16(float lo, float hi) { unsigned r; asm volatile("v_cvt_pk_bf16_f32 %0, %1, %2" : "=v"(r) : "v"(lo), "v"(hi)); return r; }
typedef float f32x2 __attribute__((ext_vector_type(2)));
__device__ __forceinline__ f32x2 gelu_pk(f32x2 v) {
    const f32x2 av = __builtin_elementwise_abs(v), d = av * 0.2316418882f + 1.0f;
    f32x2 t; t.x = __builtin_amdgcn_rcpf(d.x); t.y = __builtin_amdgcn_rcpf(d.y);
    f32x2 q = t * 0.5307027145f + (-0.7265760135f); q = q * t + 0.7107068705f; q = q * t + (-0.142248368f); q = q * t + 0.127414796f; q = q * t;
    const f32x2 s = (v * v) * (-0.72134752044f);
    f32x2 e; e.x = __builtin_amdgcn_exp2f(s.x); e.y = __builtin_amdgcn_exp2f(s.y);
    const f32x2 m = v * (q * e), r = v - m;
    f32x2 o; o.x = v.x < 0.f ? m.x : r.x; o.y = v.y < 0.f ? m.y : r.y; return o;
}

template <int ACT  > struct EpiBf16 {
    static constexpr bool PERM = true, AFTER_DRAIN = false; static_assert(ACT == 0 || ACT == 1, "EpiBf16: ACT is 0 (none) or 1 (gelu_pk)");
    bf16_t* O; int ldc; const float* bias; int split_cols; size_t split_stride; float scale0;
    __device__ __forceinline__ void operator()(const f32x4 (&acc)[2][2][4][2], const Unit& u, int wr, int wc, int fr, int fq) const {
        const int row0 = u.pm * BM + wr * 64 + fr; int colt = u.pn * BM; bf16_t* base = O;
        float sc = 1.f; if (split_cols) { const int t = colt / split_cols; base += (size_t)t * split_stride; colt -= t * split_cols; if (t == 0) sc = scale0; }
        const int col0 = colt + wc * 32 + 8 * fq, bcol0 = u.pn * BM + wc * 32 + 8 * fq;
        f32x4 bv[2][2];
#pragma unroll
        for (int bj = 0; bj < 2; ++bj)
#pragma unroll
            for (int n = 0; n < 2; ++n) bv[bj][n] = bias ? *(const f32x4*)(bias + bcol0 + bj * HALF + 4 * n) : (f32x4){0.f, 0.f, 0.f, 0.f};
#pragma unroll
        for (int ai = 0; ai < 2; ++ai)
#pragma unroll
            for (int m = 0; m < 4; ++m) { bf16_t* rowp = base + (size_t)(row0 + ai * HALF + m * 16) * ldc + col0;
#pragma unroll
                for (int bj = 0; bj < 2; ++bj) { f32x4 v0 = acc[ai][bj][m][0] + bv[bj][0], v1 = acc[ai][bj][m][1] + bv[bj][1];
                    if (ACT == 1) { f32x2 a = gelu_pk((f32x2){v0[0], v0[1]}), b = gelu_pk((f32x2){v0[2], v0[3]}), c = gelu_pk((f32x2){v1[0], v1[1]}), d = gelu_pk((f32x2){v1[2], v1[3]});
                        v0 = (f32x4){a.x, a.y, b.x, b.y}; v1 = (f32x4){c.x, c.y, d.x, d.y}; }
                    v0 = v0 * sc; v1 = v1 * sc; u32x4 w; w.x = cvt_pk_bf16(v0[0], v0[1]); w.y = cvt_pk_bf16(v0[2], v0[3]); w.z = cvt_pk_bf16(v1[0], v1[1]); w.w = cvt_pk_bf16(v1[2], v1[3]);
                    *(u32x4*)(rowp + bj * HALF) = w; } }
    }
};

struct PanelStats {
    unsigned* xbuf;
    unsigned* cnt;
    unsigned* tmo;
    int ntn; float eps;
    unsigned code;
    __device__ __forceinline__ bool run(const f32x4 (&v)[2][2][4][2], const Unit& u, int wr, int wc, int fr, int fq, PG8_LAS unsigned char* lds, int wid, int lane) const {
        typedef float f32x2v __attribute__((ext_vector_type(2)));
        PG8_LAS f32x2v* P = (PG8_LAS f32x2v*)lds;
        PG8_LAS f32x2v* S = (PG8_LAS f32x2v*)(lds + 8192);
        PG8_LAS unsigned* flag = (PG8_LAS unsigned*)(lds + 8192 + 2048);
#pragma unroll
        for (int ai = 0; ai < 2; ++ai)
#pragma unroll
            for (int m = 0; m < 4; ++m) {
                float s = 0.f;
#pragma unroll
                for (int bj = 0; bj < 2; ++bj)
#pragma unroll
                    for (int n = 0; n < 2; ++n) { const f32x4 x = v[ai][bj][m][n]; s += (x[0] + x[1]) + (x[2] + x[3]); }
                s += __shfl_xor(s, 16); s += __shfl_xor(s, 32);
                const float mw = s * (1.0f / 64.0f); float q = 0.f;
#pragma unroll
                for (int bj = 0; bj < 2; ++bj)
#pragma unroll
                    for (int n = 0; n < 2; ++n) { const f32x4 d = v[ai][bj][m][n] - mw; q += (d[0] * d[0] + d[1] * d[1]) + (d[2] * d[2] + d[3] * d[3]); }
                q += __shfl_xor(q, 16); q += __shfl_xor(q, 32);
                if (fq == 0) P[(ai * HALF + wr * 64 + m * 16 + fr) * 4 + wc] = (f32x2v){mw, q};
            }
        asm volatile("s_waitcnt lgkmcnt(0)" ::: "memory"); __builtin_amdgcn_s_barrier(); asm volatile("" ::: "memory");
#if defined(BROKEN_EXCHANGE_NO_WAIT)
#warning BROKEN CONTROL BUILD: the row-statistics exchange does not wait; results are wrong by design
        if (blockIdx.x >= 64) { const long long t0_ = clock64(); while (clock64() - t0_ < 60000) __builtin_amdgcn_s_sleep(8); }
#endif
        const int row = wid * 32 + (lane & 31);
        if (lane < 32) {
            const f32x2v a = P[row * 4 + 0], b = P[row * 4 + 1], c = P[row * 4 + 2], d = P[row * 4 + 3];
            const float mt = (a.x + b.x + c.x + d.x) * 0.25f;
            const float da = a.x - mt, db = b.x - mt, dc = c.x - mt, dd = d.x - mt;
            const float m2 = (a.y + b.y) + (c.y + d.y) + 64.0f * ((da * da + db * db) + (dc * dc + dd * dd));
            unsigned long long* slot = (unsigned long long*)xbuf + ((size_t)(u.pm * BM + row) * 4 + u.pn);
            __hip_atomic_store(slot, ((unsigned long long)__float_as_uint(m2) << 32) | __float_as_uint(mt), __ATOMIC_RELAXED, __HIP_MEMORY_SCOPE_AGENT);
        }
        asm volatile("s_waitcnt vmcnt(0)" ::: "memory");
        if (lane == 0) __hip_atomic_fetch_add(cnt + 64 * u.pm, 1u, __ATOMIC_RELAXED, __HIP_MEMORY_SCOPE_AGENT);
        if (wid == 0) {
            bool dead = false; const unsigned long long t0 = __builtin_amdgcn_s_memrealtime(); const unsigned want = 8u * (unsigned)ntn;
            for (;;) {
#if defined(BROKEN_EXCHANGE_NO_WAIT)
                break;
#endif
                if ((unsigned)__builtin_amdgcn_readfirstlane(__hip_atomic_load(cnt + 64 * u.pm, __ATOMIC_RELAXED, __HIP_MEMORY_SCOPE_AGENT)) >= want) break;
                if (__builtin_amdgcn_s_memrealtime() - t0 > 2000000ull) {
                    if (lane == 0) { unsigned expect = 0u; __hip_atomic_compare_exchange_strong(tmo + 1, &expect, code | (unsigned)(u.pm & 0xff), __ATOMIC_RELAXED, __ATOMIC_RELAXED, __HIP_MEMORY_SCOPE_AGENT);
                                     __hip_atomic_store(tmo, 1u, __ATOMIC_RELAXED, __HIP_MEMORY_SCOPE_AGENT); }
                    dead = true; break; }
                __builtin_amdgcn_s_sleep(2);
            }
            __builtin_amdgcn_fence(__ATOMIC_ACQUIRE, "agent");
            if (lane == 0) flag[0] = dead ? 1u : 0u;
        }
        asm volatile("s_waitcnt vmcnt(0) lgkmcnt(0)" ::: "memory"); __builtin_amdgcn_s_barrier(); asm volatile("" ::: "memory");
        const bool bad = flag[0] != 0u;
        if (lane < 32) {
            const unsigned long long* slot = (const unsigned long long*)xbuf + (size_t)(u.pm * BM + row) * 4; float mt[4], m2[4]; float ms = 0.f;
#pragma unroll
            for (int t = 0; t < 4; ++t) { if (t < ntn) { const unsigned long long w = __hip_atomic_load(slot + t, __ATOMIC_RELAXED, __HIP_MEMORY_SCOPE_AGENT); mt[t] = __uint_as_float((unsigned)w); m2[t] = __uint_as_float((unsigned)(w >> 32)); } else { mt[t] = 0.f; m2[t] = 0.f; } ms += mt[t]; }
            const float mean = ms / (float)ntn; float q = 0.f;
#pragma unroll
            for (int t = 0; t < 4; ++t) if (t < ntn) { const float dm = mt[t] - mean; q += m2[t] + 256.0f * dm * dm; }
            S[row] = (f32x2v){mean, 1.0f / sqrtf(q / (256.0f * (float)ntn) + eps)};
        }
        asm volatile("s_waitcnt lgkmcnt(0)" ::: "memory"); __builtin_amdgcn_s_barrier(); asm volatile("" ::: "memory");
        return bad;
    }
};
struct EpiLnRes {
    static constexpr bool PERM = false, AFTER_DRAIN = true;
    const float* base; float* out; int ldc; const float* bias; PanelStats st; unsigned poison;
    __device__ __forceinline__ void fused(f32x4 (&acc)[2][2][4][2], const Unit& u, int wr, int wc, int fr, int fq, PG8_LAS unsigned char* lds, int wid, int lane) const {
        typedef float f32x2v __attribute__((ext_vector_type(2)));
        const PG8_LAS f32x2v* S = (const PG8_LAS f32x2v*)(lds + 8192);
        const int col0 = u.pn * BM + wc * 32 + 4 * fq;
#pragma unroll
        for (int bj = 0; bj < 2; ++bj)
#pragma unroll
            for (int n = 0; n < 2; ++n) { const f32x4 bv = bias ? *(const f32x4*)(bias + col0 + bj * HALF + n * 16) : (f32x4){0.f, 0.f, 0.f, 0.f};
#pragma unroll
                for (int ai = 0; ai < 2; ++ai)
#pragma unroll
                    for (int m = 0; m < 4; ++m) acc[ai][bj][m][n] += bv; }
        f32x4 pre[4][2][2];
#pragma unroll
        for (int m = 0; m < 4; ++m) { const size_t off = (size_t)(u.pm * BM + wr * 64 + m * 16 + fr) * ldc + col0;
#pragma unroll
            for (int bj = 0; bj < 2; ++bj)
#pragma unroll
                for (int n = 0; n < 2; ++n) pre[m][bj][n] = *(const f32x4*)(base + off + bj * HALF + n * 16); }
        const bool bad = st.run(acc, u, wr, wc, fr, fq, lds, wid, lane) || poison != 0u;
        const float qnan = __builtin_nanf("");
#pragma unroll
        for (int ai = 0; ai < 2; ++ai)
#pragma unroll
            for (int m = 0; m < 4; ++m) { const int r = ai * HALF + wr * 64 + m * 16 + fr; const f32x2v sr = S[r]; const size_t off = (size_t)(u.pm * BM + r) * ldc + col0;
#pragma unroll
                for (int bj = 0; bj < 2; ++bj)
#pragma unroll
                    for (int n = 0; n < 2; ++n) { const f32x4 bs = ai == 0 ? pre[m][bj][n] : *(const f32x4*)(base + off + bj * HALF + n * 16); f32x4 o = bs + (acc[ai][bj][m][n] - sr.x) * sr.y;
                        if (bad) o = (f32x4){qnan, qnan, qnan, qnan}; *(f32x4*)(out + off + bj * HALF + n * 16) = o; }
                if (m & 1) asm volatile("" ::: "memory"); }
    }
};
struct EpiLnResLn {
    static constexpr bool PERM = false, AFTER_DRAIN = true;
    const float* base; float* out; bf16_t* xn; int ldc; const float* bias; PanelStats st1, st2; unsigned poison;
    __device__ __forceinline__ void fused(f32x4 (&acc)[2][2][4][2], const Unit& u, int wr, int wc, int fr, int fq, PG8_LAS unsigned char* lds, int wid, int lane) const {
        typedef float f32x2v __attribute__((ext_vector_type(2))); typedef unsigned u32x2v __attribute__((ext_vector_type(2)));
        const PG8_LAS f32x2v* S = (const PG8_LAS f32x2v*)(lds + 8192);
        const int col0 = u.pn * BM + wc * 32 + 4 * fq;
#pragma unroll
        for (int bj = 0; bj < 2; ++bj)
#pragma unroll
            for (int n = 0; n < 2; ++n) { const f32x4 bv = bias ? *(const f32x4*)(bias + col0 + bj * HALF + n * 16) : (f32x4){0.f, 0.f, 0.f, 0.f};
#pragma unroll
                for (int ai = 0; ai < 2; ++ai)
#pragma unroll
                    for (int m = 0; m < 4; ++m) acc[ai][bj][m][n] += bv; }
        bool bad = st1.run(acc, u, wr, wc, fr, fq, lds, wid, lane) || poison != 0u;
        const float qnan = __builtin_nanf("");
#pragma unroll
        for (int ai = 0; ai < 2; ++ai)
#pragma unroll
            for (int m = 0; m < 4; ++m) { const int r = ai * HALF + wr * 64 + m * 16 + fr; const f32x2v sr = S[r]; const size_t off = (size_t)(u.pm * BM + r) * ldc + col0;
#pragma unroll
                for (int bj = 0; bj < 2; ++bj)
#pragma unroll
                    for (int n = 0; n < 2; ++n) { const f32x4 bs = *(const f32x4*)(base + off + bj * HALF + n * 16); acc[ai][bj][m][n] = bs + (acc[ai][bj][m][n] - sr.x) * sr.y; }
                asm volatile("" : "+v"(acc[ai][0][m][0]), "+v"(acc[ai][0][m][1]), "+v"(acc[ai][1][m][0]), "+v"(acc[ai][1][m][1]));
                if (m & 1) asm volatile("" ::: "memory"); }
        const bool bad1 = bad;
        bad = st2.run(acc, u, wr, wc, fr, fq, lds, wid, lane) || bad;
#pragma unroll
        for (int ai = 0; ai < 2; ++ai)
#pragma unroll
            for (int m = 0; m < 4; ++m) { const int r = ai * HALF + wr * 64 + m * 16 + fr; const f32x2v sr = S[r]; const size_t off = (size_t)(u.pm * BM + r) * ldc + col0;
#pragma unroll
                for (int bj = 0; bj < 2; ++bj)
#pragma unroll
                    for (int n = 0; n < 2; ++n) { const f32x4 x1 = acc[ai][bj][m][n]; *(f32x4*)(out + off + bj * HALF + n * 16) = bad1 ? (f32x4){qnan, qnan, qnan, qnan} : x1;
                        const f32x4 o = (x1 - sr.x) * sr.y; u32x2v w; w.x = cvt_pk_bf16(o[0], o[1]); w.y = cvt_pk_bf16(o[2], o[3]);
                        if (bad) { w.x = 0x7fc07fc0u; w.y = 0x7fc07fc0u; } *(u32x2v*)(xn + off + bj * HALF + n * 16) = w; }
                asm volatile("" ::: "memory"); }
    }
};

template <class Epi, class Sched, bool ALIGN_EPI = false, bool SP2 = false>
__device__ __forceinline__ void gemm_phase(PG8_LAS unsigned char* lds, const Gemm g, const Sched& S, const Epi& E) {
    int tid_l = threadIdx.x; asm volatile("" : "+v"(tid_l));
    const int tid = tid_l, wid = __builtin_amdgcn_readfirstlane(tid >> 6), lane = tid & 63, wr = wid >> 2, wc = wid & 3, fr = lane & 15, fq = lane >> 4;
    const int K = g.K, nt = K / BK;
    unsigned voffA[2], voffB[2];
#pragma unroll
    for (int i = 0; i < 2; ++i) { int R, C; stage_rc(tid * 16 + i * 8192, R, C); const int Rb = Epi::PERM ? ((R & ~31) + perm32(R & 31)) : R;
        voffA[i] = (unsigned)(R * K + C) * 2u; voffB[i] = (unsigned)(Rb * K + C) * 2u; }
    const size_t kstep = (size_t)(BK * 2);
    const size_t hstep = (size_t)HALF * K * 2;
    const size_t tstep = 2 * hstep;
    const unsigned ldsw = (unsigned)wid * 1024u;
    const int aoff = lds_byte(wr * 64 + fr, fq * 8), boff = lds_byte(wc * 32 + fr, fq * 8);
#define PG8_SA(b, h) (((b) * 2 + (h)) * HTB)
#define PG8_SB(b, h) ((4 + (b) * 2 + (h)) * HTB)
#define PG8_STAGE(bufoff, gbase, voff) do { _Pragma("unroll") for (int _i = 0; _i < 2; ++_i) \
        __builtin_amdgcn_global_load_lds((const unsigned*)((const char*)(gbase) + (voff)[_i]), (PG8_LAS unsigned*)(lds + (bufoff) + ldsw + _i * 8192), 16, 0, 0); } while (0)
#define PG8_LDA(dst, b, h) do { _Pragma("unroll") for (int m = 0; m < 4; ++m) _Pragma("unroll") for (int k = 0; k < 2; ++k) dst[m][k] = *(const PG8_LAS bf16x8*)(lds + PG8_SA(b, h) + aoff + m * 2048 + k * 1024); } while (0)
#define PG8_LDB(dst, b, h) do { _Pragma("unroll") for (int n = 0; n < 2; ++n) _Pragma("unroll") for (int k = 0; k < 2; ++k) dst[n][k] = *(const PG8_LAS bf16x8*)(lds + PG8_SB(b, h) + boff + n * 2048 + k * 1024); } while (0)
#define PG8_MMA(ai, bj, At, Bt) do { __builtin_amdgcn_s_setprio(1); _Pragma("unroll") for (int m = 0; m < 4; ++m) _Pragma("unroll") for (int n = 0; n < 2; ++n) _Pragma("unroll") for (int k = 0; k < 2; ++k) \
        acc[ai][bj][m][n] = __builtin_amdgcn_mfma_f32_16x16x32_bf16(Bt[n][k], At[m][k], acc[ai][bj][m][n], 0, 0, 0); __builtin_amdgcn_s_setprio(0); } while (0)
#define PG8_WAIT_V(n) asm volatile("s_waitcnt vmcnt(" #n ")" ::: "memory")
#define PG8_WAIT_L(n) asm volatile("s_waitcnt lgkmcnt(" #n ")" ::: "memory")
#define PG8_BAR __builtin_amdgcn_s_barrier()
#define PG8_SCHED __builtin_amdgcn_sched_barrier(0)
    Unit cur, nxt; int ui = 0;
    if (!S.next(0, cur)) return;
    f32x4 acc[2][2][4][2];
#pragma unroll
    for (int a = 0; a < 2; ++a)
#pragma unroll
        for (int b = 0; b < 2; ++b)
#pragma unroll
            for (int m = 0; m < 4; ++m)
#pragma unroll
                for (int n = 0; n < 2; ++n) acc[a][b][m][n] = (f32x4){0.f, 0.f, 0.f, 0.f};
    bf16x8 At[4][2], B0[2][2], B1[2][2];
    const char* cA = (const char*)g.A + (size_t)cur.pm * tstep; const char* cB = (const char*)g.Bt + (size_t)cur.pn * tstep;
    S.a_ready(cur);
    if constexpr (SP2) {
        PG8_STAGE(PG8_SB(0, 0), cB, voffB); PG8_STAGE(PG8_SB(0, 1), cB + hstep, voffB); PG8_STAGE(PG8_SA(0, 0), cA, voffA); PG8_STAGE(PG8_SA(0, 1), cA + hstep, voffA);
        if (wr == 1) PG8_BAR;
        PG8_WAIT_V(2); PG8_BAR;
        PG8_STAGE(PG8_SB(1, 0), cB + kstep, voffB); PG8_STAGE(PG8_SA(1, 0), cA + kstep, voffA); PG8_STAGE(PG8_SB(1, 1), cB + hstep + kstep, voffB);
        PG8_WAIT_V(6); PG8_BAR;
    } else {
        PG8_STAGE(PG8_SB(0, 0), cB, voffB); PG8_STAGE(PG8_SA(0, 0), cA, voffA); PG8_STAGE(PG8_SB(0, 1), cB + hstep, voffB); PG8_STAGE(PG8_SA(0, 1), cA + hstep, voffA);
        if (wr == 1) PG8_BAR;
        PG8_WAIT_V(4); PG8_BAR;
        PG8_STAGE(PG8_SB(1, 0), cB + kstep, voffB); PG8_STAGE(PG8_SA(1, 0), cA + kstep, voffA); PG8_STAGE(PG8_SB(1, 1), cB + hstep + kstep, voffB);
        PG8_WAIT_V(6); PG8_BAR;
    }
    for (;;) {
        const bool has_next = S.next(ui + 1, nxt);
        const char* nA = has_next ? (const char*)g.A + (size_t)nxt.pm * tstep : cA; const char* nB = has_next ? (const char*)g.Bt + (size_t)nxt.pn * tstep : cB;
        for (int t = 0; t < nt; t += 2) {
            const bool last = (t == nt - 2);
            const char* a1 = cA + (size_t)(t + 1) * kstep;
            const char* a2 = last ? nA : cA + (size_t)(t + 2) * kstep; const char* b2 = last ? nB : cB + (size_t)(t + 2) * kstep;
            const char* a3 = a2 + kstep; const char* b3 = b2 + kstep;
            if (last && has_next) S.a_ready(nxt);
            if constexpr (SP2) {
            PG8_LDB(B0, 0, 0); PG8_LDB(B1, 0, 1); PG8_SCHED; PG8_LDA(At, 0, 0); PG8_STAGE(PG8_SA(1, 1), a1 + hstep, voffA);
            PG8_WAIT_V(8); PG8_WAIT_L(0); PG8_BAR; PG8_MMA(0, 0, At, B0); PG8_MMA(0, 1, At, B1); PG8_BAR; PG8_SCHED;
            PG8_LDA(At, 0, 1); PG8_STAGE(PG8_SB(0, 0), b2, voffB); PG8_STAGE(PG8_SB(0, 1), b2 + hstep, voffB); PG8_STAGE(PG8_SA(0, 0), a2, voffA);
            PG8_WAIT_V(8); PG8_WAIT_L(0); PG8_BAR; PG8_MMA(1, 0, At, B0); PG8_MMA(1, 1, At, B1); PG8_BAR; PG8_SCHED;
            PG8_LDB(B0, 1, 0); PG8_LDB(B1, 1, 1); PG8_SCHED; PG8_LDA(At, 1, 0); PG8_STAGE(PG8_SA(0, 1), a2 + hstep, voffA);
            PG8_WAIT_V(8); PG8_WAIT_L(0); PG8_BAR; PG8_MMA(0, 0, At, B0); PG8_MMA(0, 1, At, B1); PG8_BAR; PG8_SCHED;
            PG8_LDA(At, 1, 1); PG8_STAGE(PG8_SB(1, 0), b3, voffB); PG8_STAGE(PG8_SB(1, 1), b3 + hstep, voffB); PG8_STAGE(PG8_SA(1, 0), a3, voffA);
            PG8_WAIT_V(8); PG8_WAIT_L(0); PG8_BAR; PG8_MMA(1, 0, At, B0); PG8_MMA(1, 1, At, B1); PG8_BAR; PG8_SCHED;
            } else {
            PG8_LDB(B0, 0, 0); PG8_SCHED; PG8_LDA(At, 0, 0); PG8_STAGE(PG8_SA(1, 1), a1 + hstep, voffA);
            PG8_WAIT_L(8); PG8_BAR; PG8_WAIT_L(0); PG8_MMA(0, 0, At, B0); PG8_BAR; PG8_SCHED;
            PG8_LDB(B1, 0, 1); PG8_STAGE(PG8_SB(0, 0), b2, voffB);
            PG8_BAR; PG8_WAIT_L(0); PG8_MMA(0, 1, At, B1); PG8_BAR;
            PG8_LDA(At, 0, 1); PG8_STAGE(PG8_SA(0, 0), a2, voffA);
            PG8_BAR; PG8_WAIT_L(0); PG8_MMA(1, 0, At, B0); PG8_BAR; PG8_SCHED;
            PG8_STAGE(PG8_SB(0, 1), b2 + hstep, voffB);
            PG8_WAIT_V(6); PG8_BAR; PG8_MMA(1, 1, At, B1); PG8_BAR;
            PG8_LDB(B0, 1, 0); PG8_SCHED; PG8_LDA(At, 1, 0); PG8_STAGE(PG8_SA(0, 1), a2 + hstep, voffA);
            PG8_WAIT_L(8); PG8_BAR; PG8_WAIT_L(0); PG8_MMA(0, 0, At, B0); PG8_BAR; PG8_SCHED;
            PG8_LDB(B1, 1, 1); PG8_STAGE(PG8_SB(1, 0), b3, voffB);
            PG8_BAR; PG8_WAIT_L(0); PG8_MMA(0, 1, At, B1); PG8_BAR;
            PG8_LDA(At, 1, 1); PG8_STAGE(PG8_SA(1, 0), a3, voffA);
            PG8_BAR; PG8_WAIT_L(0); PG8_MMA(1, 0, At, B0); PG8_BAR; PG8_SCHED;
            PG8_STAGE(PG8_SB(1, 1), b3 + hstep, voffB);
            PG8_WAIT_V(6); PG8_BAR; PG8_MMA(1, 1, At, B1); PG8_BAR;
            }
        }
        if constexpr (ALIGN_EPI) { if (wr == 0) PG8_BAR; }
        if constexpr (!Epi::AFTER_DRAIN) { E(acc, cur, wr, wc, fr, fq); S.done(cur); }
        if (!has_next) break;
#pragma unroll
        for (int a = 0; a < 2; ++a)
#pragma unroll
            for (int b = 0; b < 2; ++b)
#pragma unroll
                for (int m = 0; m < 4; ++m)
#pragma unroll
                    for (int n = 0; n < 2; ++n) acc[a][b][m][n] = (f32x4){0.f, 0.f, 0.f, 0.f};
        cur = nxt; cA = nA; cB = nB; ++ui;
        if constexpr (ALIGN_EPI) { if (wr == 1) PG8_BAR; }
    }
    PG8_WAIT_V(0);
    if constexpr (!ALIGN_EPI) { if (wr == 0) PG8_BAR; }
    PG8_BAR;
    if constexpr (Epi::AFTER_DRAIN) { E.fused(acc, cur, wr, wc, fr, fq, lds, wid, lane); S.done(cur); }
#undef PG8_SA
#undef PG8_SB
#undef PG8_STAGE
#undef PG8_LDA
#undef PG8_LDB
#undef PG8_MMA
#undef PG8_WAIT_V
#undef PG8_WAIT_L
#undef PG8_BAR
#undef PG8_SCHED
}
}

#include <hip/hip_bf16.h>
#include <cmath>
namespace attn_body {
using bf16=__hip_bfloat16;
using bf16x8=__attribute__((ext_vector_type(8)))short;
using s16x4=__attribute__((ext_vector_type(4)))short;
using f32x16=__attribute__((ext_vector_type(16)))float;
using u32x4=__attribute__((ext_vector_type(4)))unsigned;
constexpr int D=64;
constexpr int NW=8,QBLK=32,QB=QBLK*NW,KVBLK=64;
__device__ __forceinline__ int crow(int r,int hi){return (r&3)+8*(r>>2)+4*hi;}
#define SBAR() __builtin_amdgcn_sched_barrier(0)

__device__ __forceinline__ void na_mask(f32x16&p0,f32x16&p1,int krow,int gr,int c,int hi,const __attribute__((address_space(3))) float* tab,float mhat){
  const float NEG=-INFINITY;
  asm volatile("":"+v"(hi),"+v"(c));
  int rs=gr-4; rs=rs<0?0:(rs>120?120:rs);
  const bool rowok=(unsigned)(krow-rs)<8u;
  if(!rowok){
    #pragma unroll
    for(int r=0;r<16;++r){p0[r]=NEG;p1[r]=NEG;}
  } else {
    int cs=c-8; cs=cs<0?0:(cs>48?48:cs);
    const int tb=(krow-gr+7)*31-c+15;
    #pragma unroll
    for(int r=0;r<16;++r){
      const int kv=crow(r,hi);
      const bool ok0=(unsigned)(kv-cs)<16u, ok1=(unsigned)(kv+32-cs)<16u;
      const float b0=tab[ok0?(tb+kv):0], b1=tab[ok1?(tb+kv+32):0];
      p0[r]=ok0?(b0-mhat):NEG; p1[r]=ok1?(b1-mhat):NEG;
    }
  }
}
constexpr int NSLOT=3, SLOTB=8192;
constexpr int LDS_K=0, LDS_V=NSLOT*SLOTB, LDS_WS=2*NSLOT*SLOTB, LDS_OST=LDS_WS+NW*64*4, LDS_BYTES=LDS_OST+NW*4096;
constexpr float C2=0.125f*1.4426950408889634f;
__device__ __forceinline__ void glds16(const void*gsrc,unsigned lds_dst){unsigned keep;
  asm volatile("s_mov_b32 %0, m0\n\ts_mov_b32 m0, %2\n\ts_nop 0\n\tglobal_load_lds_dwordx4 %1, off\n\ts_mov_b32 m0, %0":"=&s"(keep):"v"(gsrc),"s"(lds_dst):"memory");}
__device__ __forceinline__ float max3f(float a,float b,float c){float r;asm("v_max3_f32 %0, %1, %2, %3":"=v"(r):"v"(a),"v"(b),"v"(c));return r;}
__device__ __forceinline__ float max2f(float a,float b){float r;asm("v_max_f32_e32 %0, %1, %2":"=v"(r):"v"(a),"v"(b));return r;}
__device__ __forceinline__ float fadd_s(float a,float b){float r;asm("v_add_f32_e32 %0, %1, %2":"=v"(r):"v"(a),"v"(b));return r;}
__device__ __forceinline__ float fsub_s(float a,float b){float r;asm("v_sub_f32_e32 %0, %1, %2":"=v"(r):"v"(a),"v"(b));return r;}
typedef float f32x2_t __attribute__((ext_vector_type(2))); typedef __bf16 bf16x2_t __attribute__((ext_vector_type(2)));
__device__ __forceinline__ unsigned cvtpk_s(float lo,float hi){f32x2_t v={lo,hi};bf16x2_t b=__builtin_convertvector(v,bf16x2_t);return __builtin_bit_cast(unsigned,b);}
#define WAIT_BAR(N) asm volatile("s_waitcnt vmcnt(" #N ") lgkmcnt(0)\n\ts_barrier":::"memory")

__device__ __forceinline__ void qkt(f32x16&p0,f32x16&p1,const char*Kslot,const bf16x8*qr,const f32x16&negm,int r32,int hi){
  const char*kb=Kslot+hi*1024+r32*16;
  #pragma unroll
  for(int d0=0;d0<4;++d0){
    const bf16x8 b0=*reinterpret_cast<const bf16x8*>(kb+d0*2048);
    const bf16x8 b1=*reinterpret_cast<const bf16x8*>(kb+d0*2048+512);
    if(d0==0){p0=__builtin_amdgcn_mfma_f32_32x32x16_bf16(b0,qr[0],negm,0,0,0);p1=__builtin_amdgcn_mfma_f32_32x32x16_bf16(b1,qr[0],negm,0,0,0);}
    else{p0=__builtin_amdgcn_mfma_f32_32x32x16_bf16(b0,qr[d0],p0,0,0,0);p1=__builtin_amdgcn_mfma_f32_32x32x16_bf16(b1,qr[d0],p1,0,0,0);}}
}
typedef __attribute__((address_space(3))) const char* lds_cptr;
typedef short v4i16_t __attribute__((ext_vector_type(4)));
__device__ __forceinline__ void kload8(bf16x8*kf,lds_cptr kp){
  kf[0]=*(const __attribute__((address_space(3))) bf16x8*)(kp);      kf[1]=*(const __attribute__((address_space(3))) bf16x8*)(kp+512);
  kf[2]=*(const __attribute__((address_space(3))) bf16x8*)(kp+2048); kf[3]=*(const __attribute__((address_space(3))) bf16x8*)(kp+2560);
  kf[4]=*(const __attribute__((address_space(3))) bf16x8*)(kp+4096); kf[5]=*(const __attribute__((address_space(3))) bf16x8*)(kp+4608);
  kf[6]=*(const __attribute__((address_space(3))) bf16x8*)(kp+6144); kf[7]=*(const __attribute__((address_space(3))) bf16x8*)(kp+6656);
}
__device__ __forceinline__ void kload2(bf16x8*kf,lds_cptr kp,int j){ kf[2*j]=*(const __attribute__((address_space(3))) bf16x8*)(kp+j*2048); kf[2*j+1]=*(const __attribute__((address_space(3))) bf16x8*)(kp+j*2048+512); }
__device__ __forceinline__ s16x4 vtr(lds_cptr p){ return __builtin_bit_cast(s16x4,__builtin_amdgcn_ds_read_tr16_b64_v4i16((__attribute__((address_space(3))) v4i16_t*)p)); }
__device__ __forceinline__ float rowmax(const f32x16&p0,const f32x16&p1){
  float a=max3f(p0[0],p0[1],p1[0]),b=max3f(p0[2],p0[3],p1[1]);a=max3f(a,p1[2],p1[3]);
  #pragma unroll
  for(int r=4;r<16;r+=4){a=max3f(a,p0[r],p0[r+1]);b=max3f(b,p0[r+2],p0[r+3]);a=max3f(a,p1[r],p1[r+1]);b=max3f(b,p1[r+2],p1[r+3]);}
  const float m=max2f(a,b);
  auto rr=__builtin_amdgcn_permlane32_swap(__float_as_uint(m),__float_as_uint(m),false,false);
  return max2f(__uint_as_float(rr[0]),__uint_as_float(rr[1]));
}
__device__ __forceinline__ void pv(f32x16*o,int vb,bf16x8 pa0,bf16x8 pa1,bf16x8 pa2,bf16x8 pa3){
  #pragma unroll
  for(int d0=0;d0<2;++d0){s16x4 lo[4],hi[4];
    #pragma unroll
    for(int ks=0;ks<4;++ks){
      asm volatile("ds_read_b64_tr_b16 %0,%1 offset:%c2":"=&v"(lo[ks]):"v"(vb),"i"(d0*4096+ks*1024):"memory");
      asm volatile("ds_read_b64_tr_b16 %0,%1 offset:%c2":"=&v"(hi[ks]):"v"(vb),"i"(d0*4096+ks*1024+512):"memory");}
    asm volatile("s_waitcnt lgkmcnt(0)":::"memory");SBAR();
    #define PK(k) (bf16x8){lo[k][0],lo[k][1],lo[k][2],lo[k][3],hi[k][0],hi[k][1],hi[k][2],hi[k][3]}
    o[d0]=__builtin_amdgcn_mfma_f32_32x32x16_bf16(pa0,PK(0),o[d0],0,0,0);
    o[d0]=__builtin_amdgcn_mfma_f32_32x32x16_bf16(pa1,PK(1),o[d0],0,0,0);
    o[d0]=__builtin_amdgcn_mfma_f32_32x32x16_bf16(pa2,PK(2),o[d0],0,0,0);
    o[d0]=__builtin_amdgcn_mfma_f32_32x32x16_bf16(pa3,PK(3),o[d0],0,0,0);
    #undef PK
  }
}

#ifndef ATTN_STORE16
#define ATTN_STORE16(p,v) (*(u32x4*)(p)=(v))
#endif
struct NaP { int gr0; int r_lo; const __attribute__((address_space(3))) float* tab; };
template<int THRL,bool NA> __device__ __forceinline__ void attn_unit(const bf16*Qb,const bf16*Kc,const bf16*Vc,bf16*Ob,int kr0,int T0,int kr1,int NT,NaP nap,char*shm){
  constexpr int QP=1792,KP=1792,VP=1792,OP=1024;
  int tid_l=threadIdx.x; asm volatile("":"+v"(tid_l));
  const int tid=tid_l,lane=tid&63,r32=lane&31,hi=lane>>5; const int wid=__builtin_amdgcn_readfirstlane(tid>>6);
  const bf16*Qw=Qb+(long)(wid*QBLK)*QP;
  const unsigned lds0=(unsigned)(uintptr_t)shm;
  float*wsf=(float*)(shm+LDS_WS)+wid*64;
  const bf16*ksrc=Kc+(long)lane*KP+wid*8;
  const bf16*vsrc=Vc+(long)(16*(wid&3)+(lane>>2))*VP+(wid>>2)*32+(lane&3)*8;
  const unsigned kdst=lds0+LDS_K+wid*1024, vdst=lds0+LDS_V+wid*1024;
  #define KROW(t) ((long)(((t)<T0)?(kr0+(t)*KVBLK):(kr1+((t)-T0)*KVBLK)))
  #define DMA_K(t,slot) glds16(ksrc+KROW(t)*KP,(unsigned)__builtin_amdgcn_readfirstlane(kdst+(slot)))
  #define DMA_V(t,slot) glds16(vsrc+KROW(t)*VP,(unsigned)__builtin_amdgcn_readfirstlane(vdst+(slot)))
  const int vb0=(int)(lds0+LDS_V)+((lane>>4)&1)*32+(lane&3)*8+(4*hi+((lane&15)>>2))*64;
  const char*Kbase=shm+LDS_K; bf16x8 kf[8];
  const lds_cptr shm3=(lds_cptr)shm; const lds_cptr kp0=shm3+LDS_K+hi*1024+r32*16; const lds_cptr vp0=shm3+LDS_V+((lane>>4)&1)*32+(lane&3)*8+(4*hi+((lane&15)>>2))*64;
  DMA_K(0,0);DMA_V(0,0);DMA_K(1,SLOTB);
  bf16x8 qr[4];
  #pragma unroll
  for(int d0=0;d0<4;++d0)qr[d0]=*reinterpret_cast<const bf16x8*>(&Qw[(long)r32*QP+d0*16+hi*8]);
  float mhat=0.f,l_reg=0.f;f32x16 o[2];o[0]=f32x16{};o[1]=f32x16{};f32x16 negm=f32x16{};if(!NA)asm volatile("":"+v"(negm));
  #define CMASK(P0,P1,t) do{}while(0)
  #define NAFILL(C0,C1,t) do{ if(NA){ if((t)>=T0) na_mask(C0,C1,nap.r_lo+((t)-T0),nap.gr0+(wid>>1),(wid&1)*32+r32,hi,nap.tab,mhat); else { _Pragma("unroll") for(int r_=0;r_<16;++r_){C0[r_]=-mhat;C1[r_]=-mhat;} } } }while(0)
  bool resc=false;
  #define START(P0,P1) do{ const float rm=rowmax(P0,P1); resc=false; \
    { const float dl=rm; mhat=fadd_s(mhat,dl); \
      _Pragma("unroll") for(int r=0;r<16;++r){P0[r]=fsub_s(P0[r],dl);P1[r]=fsub_s(P1[r],dl);} \
      if(!NA){ _Pragma("unroll") for(int r=0;r<16;++r)negm[r]=-mhat; asm volatile("":"+v"(negm)); } } \
    _Pragma("unroll") for(int r=0;r<16;++r)P0[r]=__builtin_amdgcn_exp2f(P0[r]); }while(0)
  #define RESC() do{ if(resc){ asm volatile("s_waitcnt lgkmcnt(0)":::"memory"); \
      _Pragma("unroll") for(int d_=0;d_<2;++d_) _Pragma("unroll") for(int r=0;r<16;++r)o[d_][r]*=wsf[crow(r,hi)]; } }while(0)
  f32x16 pA0,pA1,pB0,pB1;
  int sl_prev=0,sl_cur=0,sl_next=SLOTB;
  #define ROT() do{sl_prev=sl_cur;sl_cur=sl_next;sl_next=(sl_next==(NSLOT-1)*SLOTB)?0:sl_next+SLOTB;}while(0)
  DMA_K(2,2*SLOTB);
  WAIT_BAR(3);
  qkt(pA0,pA1,Kbase,qr,negm,r32,hi);asm volatile("s_nop 15\n\ts_nop 7":"+v"(pA0),"+v"(pA1));CMASK(pA0,pA1,0);
  START(pA0,pA1);
  _Pragma("unroll") for(int r=0;r<16;++r)pA1[r]=__builtin_amdgcn_exp2f(pA1[r]);
  WAIT_BAR(0);
  DMA_K(3,0);DMA_V(1,SLOTB);
  ROT();
  kload8(kf,kp0+sl_cur);
  WAIT_BAR(2);
  s16x4 vlo[8],vhi[8]; u32x4 pw0,pw1,pw2,pw3;
  #define PKW(P,B) cvtpk_s(P[B],P[B+1])
  #define PAF(k) __builtin_bit_cast(bf16x8,pw##k)
  #define VFR(i) (bf16x8){vlo[i][0],vlo[i][1],vlo[i][2],vlo[i][3],vhi[i][0],vhi[i][1],vhi[i][2],vhi[i][3]}
  #define PIN(x) asm volatile("":"+v"(x))
  #define MX3(a,b,c) __builtin_fmaxf(__builtin_fmaxf((a),(b)),(c))
  #define GAPA(MF,A0,A1,A2,A3,W0,W1,PW) do{ MF; sacc+=A0; sacc+=A1; sacc+=A2; sacc+=A3; PIN(sacc); W0; W1; PIN(PW); SBAR(); }while(0)
  #define EX(v) __builtin_amdgcn_exp2f(v)
  #define GAPB(MF,X,B) do{ MF; X[B]=EX(X[B]); X[B+1]=EX(X[B+1]); X[B+2]=EX(X[B+2]); X[B+3]=EX(X[B+3]); PIN(X); SBAR(); }while(0)
  #define VRD(i) do{ vlo[i]=vtr(vp_+(((i)>>2)*4096+((i)&3)*1024)); vhi[i]=vtr(vp_+(((i)>>2)*4096+((i)&3)*1024+512)); }while(0)
  #define KRD(G,j) do{ if(G){ kload2(kf,kp0+sl_next,j); SBAR(); } }while(0)
  #define STEP(C0,C1,P0,P1,t,GK,GV,GL) do{ SBAR(); NAFILL(C0,C1,t); SBAR(); \
    const lds_cptr vp_=vp0+sl_prev; \
    VRD(0); SBAR(); float sacc=(P0[0]+P0[1]); \
    GAPA(C0=__builtin_amdgcn_mfma_f32_32x32x16_bf16(kf[0],qr[0],(NA?C0:negm),0,0,0), P0[2],P0[3],P0[4],P0[5],     pw0[0]=PKW(P0,0), pw0[1]=PKW(P0,2), pw0); \
    VRD(4); SBAR(); GAPA(C1=__builtin_amdgcn_mfma_f32_32x32x16_bf16(kf[1],qr[0],(NA?C1:negm),0,0,0), P0[6],P0[7],P0[8],P0[9],     pw0[2]=PKW(P0,4), pw0[3]=PKW(P0,6), pw0); \
    VRD(1); SBAR(); GAPA(C0=__builtin_amdgcn_mfma_f32_32x32x16_bf16(kf[2],qr[1],C0,0,0,0),   P0[10],P0[11],P0[12],P0[13], pw1[0]=PKW(P0,8), pw1[1]=PKW(P0,10), pw1); \
    VRD(5); SBAR(); GAPA(C1=__builtin_amdgcn_mfma_f32_32x32x16_bf16(kf[3],qr[1],C1,0,0,0),   P0[14],P0[15],P1[0],P1[1],   pw1[2]=PKW(P0,12),pw1[3]=PKW(P0,14), pw1); \
    VRD(2); SBAR(); GAPA(C0=__builtin_amdgcn_mfma_f32_32x32x16_bf16(kf[4],qr[2],C0,0,0,0),   P1[2],P1[3],P1[4],P1[5],     pw2[0]=PKW(P1,0), pw2[1]=PKW(P1,2), pw2); \
    VRD(6); SBAR(); GAPA(C1=__builtin_amdgcn_mfma_f32_32x32x16_bf16(kf[5],qr[2],C1,0,0,0),   P1[6],P1[7],P1[8],P1[9],     pw2[2]=PKW(P1,4), pw2[3]=PKW(P1,6), pw2); \
    VRD(3); SBAR(); GAPA(C0=__builtin_amdgcn_mfma_f32_32x32x16_bf16(kf[6],qr[3],C0,0,0,0),   P1[10],P1[11],P1[12],P1[13], pw3[0]=PKW(P1,8), pw3[1]=PKW(P1,10), pw3); \
    VRD(7); SBAR(); GAPA(C1=__builtin_amdgcn_mfma_f32_32x32x16_bf16(kf[7],qr[3],C1,0,0,0),   P1[14],P1[15],0.f,0.f,       pw3[2]=PKW(P1,12),pw3[3]=PKW(P1,14), pw3); \
    l_reg+=sacc; \
    if(GK){DMA_K((t)+3,sl_cur);} if(GV){DMA_V((t)+1,sl_next);} \
    CMASK(C0,C1,t); \
    { float a=MX3(C0[0],C0[1],C1[0]),b=MX3(C0[2],C0[3],C1[1]); a=MX3(a,C1[2],C1[3]); \
      _Pragma("unroll") for(int r=4;r<16;r+=4){a=MX3(a,C0[r],C0[r+1]);b=MX3(b,C0[r+2],C0[r+3]);a=MX3(a,C1[r],C1[r+1]);b=MX3(b,C1[r+2],C1[r+3]);} \
      float rm=__builtin_fmaxf(a,b); { auto rr=__builtin_amdgcn_permlane32_swap(__float_as_uint(rm),__float_as_uint(rm),false,false); rm=__builtin_fmaxf(__uint_as_float(rr[0]),__uint_as_float(rr[1])); } \
      resc=false; \
      if(__builtin_expect(__any(rm>(float)THRL),0)){ const float dl=__builtin_fmaxf(rm,0.f); mhat+=dl; \
        _Pragma("unroll") for(int r=0;r<16;++r){C0[r]-=dl;C1[r]-=dl;} \
        if(!NA){ _Pragma("unroll") for(int r=0;r<16;++r)negm[r]=-mhat; asm volatile("":"+v"(negm)); } \
        const float f=__builtin_amdgcn_exp2f(-dl); l_reg*=f; if(hi==0)wsf[r32]=f; resc=true; } } \
    SBAR(); \
    GAPB(o[0]=__builtin_amdgcn_mfma_f32_32x32x16_bf16(PAF(0),VFR(0),o[0],0,0,0), C0,0); \
    GAPB(o[1]=__builtin_amdgcn_mfma_f32_32x32x16_bf16(PAF(0),VFR(4),o[1],0,0,0), C0,4); \
    KRD(GL,0); GAPB(o[0]=__builtin_amdgcn_mfma_f32_32x32x16_bf16(PAF(1),VFR(1),o[0],0,0,0), C0,8); \
    KRD(GL,1); GAPB(o[1]=__builtin_amdgcn_mfma_f32_32x32x16_bf16(PAF(1),VFR(5),o[1],0,0,0), C0,12); \
    KRD(GL,2); GAPB(o[0]=__builtin_amdgcn_mfma_f32_32x32x16_bf16(PAF(2),VFR(2),o[0],0,0,0), C1,0); \
    KRD(GL,3); GAPB(o[1]=__builtin_amdgcn_mfma_f32_32x32x16_bf16(PAF(2),VFR(6),o[1],0,0,0), C1,4); \
    GAPB(o[0]=__builtin_amdgcn_mfma_f32_32x32x16_bf16(PAF(3),VFR(3),o[0],0,0,0), C1,8); \
    GAPB(o[1]=__builtin_amdgcn_mfma_f32_32x32x16_bf16(PAF(3),VFR(7),o[1],0,0,0), C1,12); \
    }while(0)
  int t=1;
  for(;t+5<NT;t+=2){
    STEP(pB0,pB1,pA0,pA1,t,true,true,true);     WAIT_BAR(2); RESC(); ROT();
    STEP(pA0,pA1,pB0,pB1,t+1,true,true,true);   WAIT_BAR(2); RESC(); ROT();
  }
  #define ENDW(tt) do{ if((tt)+3<NT){WAIT_BAR(2);} else if((tt)+2<NT){WAIT_BAR(1);} else {WAIT_BAR(0);} }while(0)
  for(;t+1<NT;t+=2){
    STEP(pB0,pB1,pA0,pA1,t,(t+3<NT),(t+1<NT),(t+1<NT));       ENDW(t);   RESC(); ROT();
    STEP(pA0,pA1,pB0,pB1,t+1,(t+4<NT),(t+2<NT),(t+2<NT));     ENDW(t+1); RESC(); ROT();
  }
  STEP(pB0,pB1,pA0,pA1,NT-1,false,false,false); RESC();
  { float sacc=pB0[0]+pB0[1]; _Pragma("unroll") for(int r=2;r<16;++r)sacc+=pB0[r]; _Pragma("unroll") for(int r=0;r<16;++r)sacc+=pB1[r]; l_reg+=sacc;
    pw0=(u32x4){PKW(pB0,0),PKW(pB0,2),PKW(pB0,4),PKW(pB0,6)};pw1=(u32x4){PKW(pB0,8),PKW(pB0,10),PKW(pB0,12),PKW(pB0,14)};pw2=(u32x4){PKW(pB1,0),PKW(pB1,2),PKW(pB1,4),PKW(pB1,6)};pw3=(u32x4){PKW(pB1,8),PKW(pB1,10),PKW(pB1,12),PKW(pB1,14)};
    SBAR(); pv(o,vb0+sl_cur,PAF(0),PAF(1),PAF(2),PAF(3)); }
  #undef PKW
  #undef PAF
  #undef VFR
  #undef PIN
  #undef MX3
  #undef GAPA
  #undef GAPB
  #undef EX
  #undef VRD
  #undef KRD
  #undef STEP
  #undef ENDW
  {auto rr=__builtin_amdgcn_permlane32_swap(__float_as_uint(l_reg),__float_as_uint(l_reg),false,false);l_reg=__uint_as_float(rr[0])+__uint_as_float(rr[1]);}
  if(hi==0)wsf[32+r32]=l_reg;asm volatile("s_waitcnt lgkmcnt(0)":::"memory");
  float rli[16];
  #pragma unroll
  for(int r=0;r<16;++r)rli[r]=__builtin_amdgcn_rcpf(wsf[32+crow(r,hi)]);
  bf16*Ow=Ob+(long)(wid*QBLK)*OP;
  { bf16*stg=(bf16*)(shm+LDS_OST)+wid*2048;
    #pragma unroll
    for(int r=0;r<16;++r){const int orow=crow(r,hi);
      #pragma unroll
      for(int d0=0;d0<2;++d0)stg[orow*64+d0*32+r32]=__float2bfloat16(o[d0][r]*rli[r]);}
    asm volatile("s_waitcnt lgkmcnt(0)":::"memory");
    #pragma unroll
    for(int i=0;i<4;++i){const int row=i*8+(lane>>3),ch=lane&7; const u32x4 v=*(const u32x4*)(stg+row*64+ch*8); ATTN_STORE16(Ow+(long)row*OP+ch*8,v);} }
  asm volatile("s_waitcnt lgkmcnt(0)\n\ts_barrier":::"memory");
  #undef DMA_K
  #undef KROW
  #undef DMA_V
  #undef CMASK
  #undef NAFILL
  #undef START
  #undef RESC
  #undef ROT
}
constexpr int ATTN_LDS_BYTES=LDS_BYTES;
#undef SBAR
#undef WAIT_BAR
}

#include <hip/hip_cooperative_groups.h>
namespace cg = cooperative_groups;

#ifndef PHMASK
#define PHMASK 0xffff
#endif
#ifndef REPEAT_MASK
#define REPEAT_MASK 0
#endif
#ifndef EXTRA_SYNCS
#define EXTRA_SYNCS 0
#endif
#ifndef MK_N_LAUNCHES
#define MK_N_LAUNCHES 1
#endif

#define GAS __attribute__((address_space(1)))
#define LAS __attribute__((address_space(3)))
typedef unsigned short bf16r;
typedef float f32x4 __attribute__((ext_vector_type(4)));
typedef float f32x2 __attribute__((ext_vector_type(2)));
typedef unsigned u32x2 __attribute__((ext_vector_type(2)));
typedef unsigned u32x4 __attribute__((ext_vector_type(4)));

constexpr int DM = 1024, NB = 2, SEQ = 8192, CTXL = 256, DEPTH = 2;
constexpr int ML = NB * SEQ;
constexpr int MC = NB * CTXL;
constexpr int MT = ML + MC;
constexpr int INW = 3072, FFH = 2816, FF2 = 5632, NMOD = 6 * DM;
constexpr float LN_EPS = 1e-6f, DN_ALPHA = 1.4142135623730951f;
constexpr float LOG2E = 1.4426950408889634f, QSCALE = 0.125f * LOG2E;
constexpr int NCHUNK = 132, NCHAIN = 16, NHU = NCHAIN * NCHUNK;

constexpr size_t MiB = 1u << 20;
constexpr size_t WS_MODS = 1 * MiB;
constexpr size_t WS_LB = WS_MODS + 160 * 1024;
constexpr size_t WS_ROPE = WS_LB + 8 * 1024;
constexpr size_t WS_WIN = 2 * MiB;
constexpr size_t WS_WOUT = 14 * MiB;
constexpr size_t WS_WF1 = 18 * MiB;
constexpr size_t WS_WF2 = 40 * MiB;
constexpr size_t WS_XCTX = 51 * MiB;
constexpr size_t WS_H = 53 * MiB;
constexpr size_t WS_P = 86 * MiB;
constexpr size_t ROWS2 = (size_t)MT * 2;
constexpr int QKVP = 1792;
constexpr int CGQ = 0, CGK = 384, CGV = 512, CNQ = 640, CNK = 1024, CNV = 1408;
constexpr size_t WS_QKV = WS_P;
constexpr size_t WS_NV_END = WS_QKV + ROWS2 * QKVP;
constexpr size_t WS_HQ = WS_NV_END;
constexpr size_t WS_HI = WS_HQ + ROWS2 * 256;
constexpr size_t WS_HG = WS_HI + ROWS2 * 256;
constexpr size_t WS_HF = WS_HG + ROWS2 * 256;
constexpr size_t WS_HB = WS_HF + ROWS2 * 512;
constexpr size_t WS_PEND = WS_HB + ROWS2 * 512;
constexpr size_t WS_HH = WS_P;
constexpr size_t WS_SST = 202 * MiB;
constexpr size_t WS_ADEC = 235 * MiB;
constexpr size_t WS_END = 236 * MiB;
static_assert(WS_PEND <= WS_SST && WS_HH + ROWS2 * FFH <= WS_SST && WS_SST + (size_t)NHU * 4096 * 4 <= WS_ADEC, "ws map");

constexpr int LDS_BYTES = 147456 + 256;
constexpr int BARST_OFF = 147456;
constexpr size_t WS_BAR = 0, BAR_ZERO_BYTES = 16384;
constexpr int NA_TAB_OFF = 90112;

struct Args { const float* in[17]; float* out; unsigned char* ws; int ph_lo, ph_hi; };

__device__ __forceinline__ unsigned pk_bf16(float lo, float hi) { f32x2 v = {lo, hi}; typedef __bf16 bf2 __attribute__((ext_vector_type(2))); bf2 b = __builtin_convertvector(v, bf2); return __builtin_bit_cast(unsigned, b); }
__device__ __forceinline__ float bf2f(bf16r v) { return __builtin_bit_cast(float, (unsigned)v << 16); }
__device__ __forceinline__ float silu_f(float x) { return x / (1.f + __expf(-x)); }
__device__ __forceinline__ float wave_sum(float v) {
#pragma unroll
    for (int o = 1; o < 64; o <<= 1) v += __shfl_xor(v, o);
    return v;
}
__device__ __forceinline__ int seg_of_row(int r) { return r < SEQ ? 0 : (r < ML ? 1 : 2); }
__device__ __forceinline__ float* xrow_ptr(float* out, float* xctx, int r) { return r < ML ? out + (size_t)r * DM : xctx + (size_t)(r - ML) * DM; }

struct EpiIn {
    static constexpr bool PERM = false, AFTER_DRAIN = false;
    bf16r *HQ, *HI, *HG, *QKV; float *HF, *HB;
    const float *lb, *qn, *kn; const f32x2* rope;
    __device__ __forceinline__ static void st_bf16(bf16r* p, const f32x4 v) { u32x2 w; w.x = pk_bf16(v[0], v[1]); w.y = pk_bf16(v[2], v[3]); *(u32x2*)p = w; }
    __device__ __forceinline__ void operator()(const pg8::f32x4 (&acc)[2][2][4][2], const pg8::Unit& u, int wr, int wc, int fr, int fq) const {
        const int grp = 4 * u.pn + wc;
#pragma unroll
        for (int ai = 0; ai < 2; ++ai)
#pragma unroll
            for (int m = 0; m < 4; ++m) {
                const int r = u.pm * 256 + ai * 128 + wr * 64 + m * 16 + fr;
                f32x4 v[2][2];
#pragma unroll
                for (int bj = 0; bj < 2; ++bj)
#pragma unroll
                    for (int n = 0; n < 2; ++n) { v[bj][n][0] = acc[ai][bj][m][n][0]; v[bj][n][1] = acc[ai][bj][m][n][1]; v[bj][n][2] = acc[ai][bj][m][n][2]; v[bj][n][3] = acc[ai][bj][m][n][3]; }
                if (grp < 20) {
                    const int part = grp >> 2, hc = (grp & 3) * 64;
                    if (part == 1 || part == 2) {
                        float* dst = (part == 1 ? HF : HB) + (size_t)r * 256 + hc;
                        const float* lbp = lb + (part - 1) * 256 + hc;
#pragma unroll
                        for (int bj = 0; bj < 2; ++bj)
#pragma unroll
                            for (int n = 0; n < 2; ++n) { const int d = 32 * bj + 16 * n + 4 * fq; const f32x4 l4 = *(const f32x4*)(lbp + d); f32x4 o;
#pragma unroll
                                for (int e = 0; e < 4; ++e) { const float sg = 1.f / (1.f + expf(-v[bj][n][e])); o[e] = l4[e] + (1.f - l4[e]) * sg; }
                                *(f32x4*)(dst + d) = o; }
                    } else {
                        bf16r* dst = (part == 0 ? HQ : (part == 3 ? HI : HG)) + (size_t)r * 256 + hc;
#pragma unroll
                        for (int bj = 0; bj < 2; ++bj)
#pragma unroll
                            for (int n = 0; n < 2; ++n) { const int d = 32 * bj + 16 * n + 4 * fq; f32x4 o = v[bj][n];
                                if (part != 3) {
#pragma unroll
                                    for (int e = 0; e < 4; ++e) o[e] = silu_f(o[e]); }
                                st_bf16(dst + d, o); }
                    }
                } else if (grp < 28) {
                    const bool isq = grp < 26; const int hh = isq ? grp - 20 : grp - 26;
                    const float* gn = isq ? qn : kn;
                    float ss = 0.f;
#pragma unroll
                    for (int bj = 0; bj < 2; ++bj)
#pragma unroll
                        for (int n = 0; n < 2; ++n)
#pragma unroll
                            for (int e = 0; e < 4; ++e) ss += v[bj][n][e] * v[bj][n][e];
                    ss += __shfl_xor(ss, 16); ss += __shfl_xor(ss, 32);
                    const float rn = 1.f / sqrtf(ss * (1.f / 64.f) + LN_EPS);
                    const float osc = isq ? QSCALE : 1.f;
                    bf16r* dst = QKV + (size_t)r * QKVP + (isq ? CGQ : CGK) + hh * 64;
                    const bool lat = r < ML; const int t = r & (SEQ - 1);
#pragma unroll
                    for (int bj = 0; bj < 2; ++bj) {
                        const int pos = bj ? (t & 63) : (t >> 6);
#pragma unroll
                        for (int n = 0; n < 2; ++n) { const int d = 32 * bj + 16 * n + 4 * fq; const f32x4 g4 = *(const f32x4*)(gn + d); f32x4 o;
#pragma unroll
                            for (int e = 0; e < 4; ++e) o[e] = v[bj][n][e] * rn * g4[e];
                            if (lat) {
#pragma unroll
                                for (int pp = 0; pp < 2; ++pp) { const f32x2 cs = rope[pos * 16 + 8 * n + 2 * fq + pp]; const float x1 = o[2 * pp], x2 = o[2 * pp + 1];
                                    o[2 * pp] = x1 * cs.x - x2 * cs.y; o[2 * pp + 1] = x1 * cs.y + x2 * cs.x; } }
                            o = o * osc; st_bf16(dst + d, o); }
                    }
                } else {
                    bf16r* dst; float osc = 1.f;
                    if (grp < 30) dst = QKV + (size_t)r * QKVP + CGV + (grp - 28) * 64;
                    else if (grp < 36) { dst = QKV + (size_t)r * QKVP + CNQ + (grp - 30) * 64; osc = QSCALE; }
                    else if (grp < 42) dst = QKV + (size_t)r * QKVP + CNK + (grp - 36) * 64;
                    else dst = QKV + (size_t)r * QKVP + CNV + (grp - 42) * 64;
#pragma unroll
                    for (int bj = 0; bj < 2; ++bj)
#pragma unroll
                        for (int n = 0; n < 2; ++n) { const int d = 32 * bj + 16 * n + 4 * fq; st_bf16(dst + d, v[bj][n] * osc); }
                }
            }
    }
};
struct EpiRes {
    static constexpr bool PERM = false, AFTER_DRAIN = false;
    float* out; float* xctx; const float* gate; float* dry;
    __device__ __forceinline__ void operator()(const pg8::f32x4 (&acc)[2][2][4][2], const pg8::Unit& u, int wr, int wc, int fr, int fq) const {
        const int sg = seg_of_row(u.pm * 256);
        const float* gp = gate + sg * NMOD + u.pn * 256 + wc * 32 + 4 * fq;
        f32x4 g4[2][2];
#pragma unroll
        for (int bj = 0; bj < 2; ++bj)
#pragma unroll
            for (int n = 0; n < 2; ++n) g4[bj][n] = *(const f32x4*)(gp + bj * 128 + n * 16);
#pragma unroll
        for (int ai = 0; ai < 2; ++ai)
#pragma unroll
            for (int m = 0; m < 4; ++m) {
                const int r = u.pm * 256 + ai * 128 + wr * 64 + m * 16 + fr;
                float* xp = xrow_ptr(out, xctx, r) + u.pn * 256 + wc * 32 + 4 * fq;
#pragma unroll
                for (int bj = 0; bj < 2; ++bj)
#pragma unroll
                    for (int n = 0; n < 2; ++n) { float* p = xp + bj * 128 + n * 16; const f32x4 x4 = *(const f32x4*)p; f32x4 a; a[0] = acc[ai][bj][m][n][0]; a[1] = acc[ai][bj][m][n][1]; a[2] = acc[ai][bj][m][n][2]; a[3] = acc[ai][bj][m][n][3];
                        float* q = dry ? dry + (size_t)(r & 8191) * DM + (p - xrow_ptr(out, xctx, r)) : p; *(f32x4*)q = x4 * DN_ALPHA + g4[bj][n] * a; }
            }
    }
};
struct EpiSwiglu {
    static constexpr bool PERM = false, AFTER_DRAIN = false;
    bf16r* HH;
    __device__ __forceinline__ void operator()(const pg8::f32x4 (&acc)[2][2][4][2], const pg8::Unit& u, int wr, int wc, int fr, int fq) const {
#pragma unroll
        for (int ai = 0; ai < 2; ++ai)
#pragma unroll
            for (int m = 0; m < 4; ++m) {
                const int r = u.pm * 256 + ai * 128 + wr * 64 + m * 16 + fr;
                bf16r* hp = HH + (size_t)r * FFH + u.pn * 128 + wc * 32 + 4 * fq;
#pragma unroll
                for (int n = 0; n < 2; ++n) { f32x4 o;
#pragma unroll
                    for (int e = 0; e < 4; ++e) o[e] = silu_f(acc[ai][0][m][n][e]) * acc[ai][1][m][n][e];
                    u32x2 w; w.x = pk_bf16(o[0], o[1]); w.y = pk_bf16(o[2], o[3]); *(u32x2*)(hp + n * 16) = w; }
            }
    }
};

__device__ __forceinline__ void transpose_item(const float* W, int K, int N, bf16r* WT, int mode, LAS float* scr, int item, int lane) {
    const int nblk = N / 32, kb = item / nblk, nb = item % nblk, k0 = 64 * kb, n0 = 32 * nb;
#pragma unroll 8
    for (int i = 0; i < 32; ++i) { const int kk = 2 * i + (lane >> 5); scr[kk * 33 + (lane & 31)] = W[(size_t)(k0 + kk) * N + n0 + (lane & 31)]; }
    asm volatile("s_waitcnt lgkmcnt(0)" ::: "memory");
    int ro = n0;
    if (mode == 1) ro = (n0 & ~255) + 128 * ((n0 & 63) >> 5) + 32 * ((n0 & 255) >> 6);
    else if (mode == 2) { const int up = n0 >= FFH, j = up ? n0 - FFH : n0; ro = 256 * (j >> 7) + 128 * up + (j & 127); }
    const int c = lane & 7;
#pragma unroll
    for (int j = 0; j < 4; ++j) { const int n = (lane >> 3) + 8 * j; const LAS float* s = scr + (8 * c) * 33 + n;
        u32x4 o; o.x = pk_bf16(s[0 * 33], s[1 * 33]); o.y = pk_bf16(s[2 * 33], s[3 * 33]); o.z = pk_bf16(s[4 * 33], s[5 * 33]); o.w = pk_bf16(s[6 * 33], s[7 * 33]);
        *(u32x4*)(WT + (size_t)(ro + n) * K + k0 + 8 * c) = o; }
    asm volatile("s_waitcnt lgkmcnt(0)" ::: "memory");
}

#define RLX_AGENT __ATOMIC_RELAXED, __HIP_MEMORY_SCOPE_AGENT
#define LDS_WAIT() asm volatile("s_waitcnt lgkmcnt(0)" ::: "memory")
#define VM_WAIT() asm volatile("s_waitcnt vmcnt(0)" ::: "memory")
__device__ __forceinline__ unsigned long long rt() { return __builtin_amdgcn_s_memrealtime(); }
#define XB_TMO      128
#define XB_XCNT(j)  (256  + 64 * (j))
#define XB_XSUB(j)  (1280 + 64 * (j))
#define XB_XGEN(j)  (2304 + 64 * (j))
#define XB_TOP      3328
#define XB_TOPGEN   3392
#define XCD_BAR_WORDS 3456
#define XB_SPIN_CAP (1u << 18)

__device__ __forceinline__ unsigned xb_ld(unsigned* p)              { return __hip_atomic_load(p, __ATOMIC_RELAXED, __HIP_MEMORY_SCOPE_AGENT); }
__device__ __forceinline__ unsigned xb_add(unsigned* p, unsigned v) { return __hip_atomic_fetch_add(p, v, __ATOMIC_RELAXED, __HIP_MEMORY_SCOPE_AGENT); }
__device__ __forceinline__ unsigned xb_xcc_id() { return (unsigned)__builtin_amdgcn_s_getreg((3 << 11) | 20) & 0xFu; }
#define XB_SPIN(cond, bar) do { unsigned _sp = 0; while (cond) { __builtin_amdgcn_s_sleep(1); \
    if ((++_sp & 255u) == 0u) { if (xb_ld(&(bar)[XB_TMO])) break; if (_sp > XB_SPIN_CAP) { atomicAdd(&(bar)[XB_TMO], 1u); break; } } } } while (0)

struct XcdBarrier {
    unsigned* bar; unsigned x;
    volatile LAS unsigned* st;
};

__device__ __forceinline__ XcdBarrier xcd_barrier_post(unsigned* bar, volatile LAS unsigned* st) {
    XcdBarrier b; b.bar = bar; b.x = xb_xcc_id(); b.st = st;
    if (threadIdx.x == 0) (void)xb_add(&bar[XB_XCNT(b.x)], 1u);
    return b;
}
__device__ __forceinline__ void xcd_barrier_complete(unsigned* bar, unsigned x, unsigned& nloc, unsigned& nx) {
    const unsigned G = gridDim.x * gridDim.y * gridDim.z;
    unsigned sum, cnt, mine, sp = 0u;
    for (;;) {
        sum = 0u; cnt = 0u; mine = 0u;
#pragma unroll
        for (unsigned j = 0; j < 16; ++j) { const unsigned c = xb_ld(&bar[XB_XCNT(j)]); sum += c; cnt += (c > 0u) ? 1u : 0u; mine = (j == x) ? c : mine; }
        if (sum == G) break;
        __builtin_amdgcn_s_sleep(1);
        if ((++sp & 255u) == 0u) { if (xb_ld(&bar[XB_TMO])) break; if (sp > XB_SPIN_CAP) { atomicAdd(&bar[XB_TMO], 1u); break; } }
    }
    nloc = mine > 0u ? mine : 1u; nx = cnt > 0u ? cnt : 1u;
}

__device__ __forceinline__ void xcd_barrier(const XcdBarrier& b) {
    asm volatile("s_waitcnt vmcnt(0)" ::: "memory");
    __syncthreads();
    if (threadIdx.x == 0) {
        unsigned* bar = b.bar;
        __builtin_amdgcn_s_waitcnt(0);
        unsigned nloc = b.st[0], nx = b.st[1];
        if (nloc == 0u) { xcd_barrier_complete(bar, b.x, nloc, nx); b.st[0] = nloc; b.st[1] = nx; }
        const unsigned old = xb_add(&bar[XB_XSUB(b.x)], 1u);
        const unsigned gen = old / nloc;
        if (old + 1u == (gen + 1u) * nloc) {
            __builtin_amdgcn_fence(__ATOMIC_RELEASE, "agent");
            asm volatile("s_waitcnt vmcnt(0)" ::: "memory");
            const unsigned og = xb_add(&bar[XB_TOP], 1u);
            const unsigned tg = og / nx;
            if (og + 1u == (tg + 1u) * nx) xb_add(&bar[XB_TOPGEN], 1u);
            else XB_SPIN(xb_ld(&bar[XB_TOPGEN]) == tg, bar);
            __builtin_amdgcn_fence(__ATOMIC_ACQUIRE, "agent");
            xb_add(&bar[XB_XGEN(b.x)], 1u);
            asm volatile("s_waitcnt vmcnt(0)" ::: "memory");
        } else {
            XB_SPIN(xb_ld(&bar[XB_XGEN(b.x)]) == gen, bar);
            __builtin_amdgcn_fence(__ATOMIC_ACQUIRE, "agent");
            asm volatile("s_waitcnt vmcnt(0)" ::: "memory");
        }
    }
    __syncthreads();
}

__global__ void __launch_bounds__(512) hybrid_fwd(Args args) {
    extern __shared__ __attribute__((aligned(16))) unsigned char lds[];
    LAS unsigned char* L = (LAS unsigned char*)lds;
    const int G = gridDim.x, bx = blockIdx.x, NGW = G * 8;
    unsigned char* ws = args.ws;
    float* out = args.out;
    float* xctx = (float*)(ws + WS_XCTX);
    float* MODS = (float*)(ws + WS_MODS);
    float* LBT = (float*)(ws + WS_LB);
    f32x2* ROPE = (f32x2*)(ws + WS_ROPE);
    bf16r* Hb = (bf16r*)(ws + WS_H);
    bf16r* QKV = (bf16r*)(ws + WS_QKV);
    bf16r *HQ = (bf16r*)(ws + WS_HQ), *HI = (bf16r*)(ws + WS_HI), *HG = (bf16r*)(ws + WS_HG);
    float *HF = (float*)(ws + WS_HF), *HB = (float*)(ws + WS_HB);
    bf16r* HH = (bf16r*)(ws + WS_HH);
    float* SST = (float*)(ws + WS_SST); float* ADEC = (float*)(ws + WS_ADEC);
    cg::grid_group grid = cg::this_grid();
    if (threadIdx.x < 64) ((LAS unsigned*)(L + BARST_OFF))[threadIdx.x] = 0u;
    __syncthreads();
    const XcdBarrier xbar = xcd_barrier_post((unsigned*)(ws + WS_BAR), (volatile LAS unsigned*)(L + BARST_OFF));
    int nsync_ = 0;
#define GRID_SEAM() do { if (nsync_ == 0) { __syncthreads(); grid.sync(); } else xcd_barrier(xbar); ++nsync_; } while (0)

    bool second_ = false;
    for (int ph = args.ph_lo; ph < args.ph_hi; ++ph) {
        int tid_l = threadIdx.x; asm volatile("" : "+v"(tid_l));
        const int tid = tid_l, lane = tid & 63, wave = __builtin_amdgcn_readfirstlane(tid >> 6), gw = bx * 8 + wave;
        const bool rep_this = (REPEAT_MASK != 0) && ph >= 2 && ((REPEAT_MASK >> ((ph - 2) % 9)) & 1);
        float* dryp = (rep_this && !second_) ? (float*)(args.ws + WS_SST) : nullptr;
        if (ph == 0 && (PHMASK & 1)) {
            LAS float* scr = (LAS float*)(L + wave * 16384);
            constexpr int I_IN = 16 * (INW / 32), I_OUT = 16 * (DM / 32), I_F1 = 16 * (FF2 / 32), I_F2 = (FFH / 64) * (DM / 32), I_L = I_IN + I_OUT + I_F1 + I_F2;
            for (int it = gw; it < DEPTH * I_L; it += NGW) {
                const int l = it / I_L; int r = it % I_L;
                if (r < I_IN) { transpose_item(args.in[6] + (size_t)l * DM * INW, DM, INW, (bf16r*)(ws + WS_WIN) + (size_t)l * INW * DM, 1, scr, r, lane); continue; } r -= I_IN;
                if (r < I_OUT) { transpose_item(args.in[12] + (size_t)l * DM * DM, DM, DM, (bf16r*)(ws + WS_WOUT) + (size_t)l * DM * DM, 0, scr, r, lane); continue; } r -= I_OUT;
                if (r < I_F1) { transpose_item(args.in[13] + (size_t)l * DM * FF2, DM, FF2, (bf16r*)(ws + WS_WF1) + (size_t)l * FF2 * DM, 2, scr, r, lane); continue; } r -= I_F1;
                transpose_item(args.in[14] + (size_t)l * FFH * DM, FFH, DM, (bf16r*)(ws + WS_WF2) + (size_t)l * DM * FFH, 0, scr, r, lane);
            }
            __syncthreads();
            if (bx < 192) {
                LAS float* sc = (LAS float*)L;
                LAS float* red = (LAS float*)(L + 16384);
                for (int i = tid; i < 3 * DM; i += 512) { const int s = i >> 10, k = i & 1023; const float cv = s < 2 ? args.in[1][s * DM + k] : args.in[3][k]; sc[i] = silu_f(cv); }
                __syncthreads();
                for (int it = bx; it < 192; it += G) {
                    const int l = it / 96, n0 = (it % 96) * 64;
                    const float* wa = args.in[4] + (size_t)l * DM * NMOD + n0 + lane;
                    float a0 = 0.f, a1 = 0.f, a2 = 0.f;
#pragma unroll 8
                    for (int k = wave * 128; k < wave * 128 + 128; ++k) { const float w = wa[(size_t)k * NMOD]; a0 += sc[k] * w; a1 += sc[DM + k] * w; a2 += sc[2 * DM + k] * w; }
                    red[(wave * 3 + 0) * 64 + lane] = a0; red[(wave * 3 + 1) * 64 + lane] = a1; red[(wave * 3 + 2) * 64 + lane] = a2;
                    __syncthreads();
                    if (tid < 192) { const int s = tid >> 6; float sum = 0.f;
#pragma unroll
                        for (int w = 0; w < 8; ++w) sum += red[(w * 3 + s) * 64 + lane];
                        MODS[(l * 3 + s) * NMOD + n0 + lane] = sum + args.in[5][l * NMOD + n0 + lane]; }
                    __syncthreads();
                }
            }
            if (bx == G - 1) {
                for (int i = tid; i < 128 * 16; i += 512) { const int pos = i >> 4, j = i & 15; const float invf = expf((-9.210340371976184f * (float)j) / 16.0f); const float ang = (float)pos * invf; ROPE[i] = (f32x2){cosf(ang), sinf(ang)}; }
                { const int d = tid >> 8, k = tid & 255; const float a0 = args.in[7][d * 256 + k], a1 = args.in[7][512 + d * 256 + k]; const float mx = fmaxf(a0, a1); const float e0 = expf(a0 - mx), e1 = expf(a1 - mx);
                  const float p1 = e1 / (e0 + e1); LBT[d * 256 + k] = 0.f; LBT[512 + d * 256 + k] = fminf(fmaxf(p1, 0.f), 1.f); }
            }
        } else if (ph == 1 && (PHMASK & 2)) {
            for (int r = gw; r < MT; r += NGW) {
                const float* src = r < ML ? args.in[0] + (size_t)r * DM : args.in[2] + (size_t)(r - ML) * DM;
                float* xp = xrow_ptr(out, xctx, r); const float* md = MODS + seg_of_row(r) * NMOD;
#pragma unroll
                for (int j = 0; j < 4; ++j) { const int c = 4 * lane + 256 * j; const f32x4 v = *(const f32x4*)(src + c); *(f32x4*)(xp + c) = v;
                    const f32x4 sh = *(const f32x4*)(md + c), scv = *(const f32x4*)(md + DM + c); const f32x4 h = v * (scv + 1.f) + sh;
                    u32x2 w; w.x = pk_bf16(h[0], h[1]); w.y = pk_bf16(h[2], h[3]); *(u32x2*)(Hb + (size_t)r * DM + c) = w; }
            }
        } else {
            const int l = (ph - 2) / 9, sub = (ph - 2) % 9;
            const bool need_ctx = l < DEPTH - 1;
            const float* modl = MODS + (size_t)l * 3 * NMOD;
            if (sub == 0 && (PHMASK & 4)) {
                pg8::Gemm g{Hb, (const bf16r*)(ws + WS_WIN) + (size_t)l * INW * DM, MT, INW, DM}; pg8::StaticOrder S; S.init(MT, INW, G, bx);
                EpiIn E{HQ, HI, HG, QKV, HF, HB, LBT + l * 512, args.in[9] + l * 64, args.in[10] + l * 64, ROPE};
                pg8::gemm_phase<EpiIn, pg8::StaticOrder, true, true>(L, g, S, E);
            } else if (sub == 1 && (PHMASK & 8)) {
                LAS float* stf = (LAS float*)(L + wave * 2048);
                for (int u = gw; u < NHU; u += NGW) {
                    const int chain = u / NCHUNK, c = u % NCHUNK, b = chain >> 3, h = (chain >> 1) & 3, dir = chain & 1;
                    int base, sgn;
                    if (dir == 0) { base = c < 4 ? ML + b * CTXL + 64 * c : b * SEQ + 64 * (c - 4); sgn = 1; }
                    else { base = c < 4 ? ML + b * CTXL + 255 - 64 * c : b * SEQ + SEQ - 1 - 64 * (c - 4); sgn = -1; }
                    const float* F = (dir ? HB : HF) + h * 64;
                    float s[64]; float a = 1.f;
#pragma unroll
                    for (int k = 0; k < 64; ++k) s[k] = 0.f;
#pragma unroll 1
                    for (int t0 = 0; t0 < 64; t0 += 8) {
                        float vv[8];
#pragma unroll
                        for (int j = 0; j < 2; ++j) { const int idx = lane + 64 * j, tk = idx >> 4, k4 = (idx & 15) * 4; const int row = base + sgn * (t0 + tk);
                            *(LAS f32x4*)(stf + tk * 64 + k4) = *(const f32x4*)(F + (size_t)row * 256 + k4); }
#pragma unroll
                        for (int i = 0; i < 8; ++i) { const int row = base + sgn * (t0 + i); vv[i] = bf2f(HI[(size_t)row * 256 + h * 64 + lane]); }
                        asm volatile("s_waitcnt lgkmcnt(0)" ::: "memory");
#pragma unroll 1
                        for (int i = 0; i < 8; ++i) {
                            float v = vv[0];
#pragma unroll
                            for (int q = 1; q < 8; ++q) v = (i == q) ? vv[q] : v;
                            a *= stf[i * 64 + lane];
#pragma unroll
                            for (int k4 = 0; k4 < 16; ++k4) { const f32x4 f4 = *(const LAS f32x4*)(stf + i * 64 + 4 * k4);
#pragma unroll
                                for (int e = 0; e < 4; ++e) { const int k = 4 * k4 + e; s[k] = __builtin_fmaf(f4[e], s[k] - v, v); } }
                        }
                        asm volatile("s_waitcnt lgkmcnt(0)" ::: "memory");
                    }
                    float* so = SST + (size_t)u * 4096 + lane;
#pragma unroll
                    for (int k = 0; k < 64; ++k) so[k * 64] = s[k];
                    ADEC[(size_t)u * 64 + lane] = a;
                }
            } else if (sub == 2 && (PHMASK & 16)) {
                const int gt = bx * 512 + tid;
                if (gt < NCHAIN * 4096 && !dryp) {
                    const int chain = gt >> 12, e = gt & 4095, k = e >> 6;
                    float* sp = SST + (size_t)chain * NCHUNK * 4096 + e; const float* ap = ADEC + (size_t)chain * NCHUNK * 64 + k;
                    float s = 0.f;
#pragma unroll 6
                    for (int c = 0; c < NCHUNK; ++c) { const float loc = sp[(size_t)c * 4096], a = ap[c * 64]; sp[(size_t)c * 4096] = s; s = a * s + loc; }
                }
            } else if (sub == 3 && (PHMASK & 32)) {
                using attn_body::bf16;
                bf16* MIX = (bf16*)Hb; const bf16* QK = (const bf16*)QKV;
                const attn_body::NaP nap0{0, 0, (const LAS float*)(L + NA_TAB_OFF)};
                for (int id = bx; id < 384; id += G) {
                    const int b = id / 192, rem = id % 192, h = rem >> 5, qb = rem & 31, kvh = h / 3; const long q0 = (long)b * SEQ + 256 * qb;
                    attn_body::attn_unit<8, false>(QK + q0 * QKVP + CGQ + h * 64, QK + CGK + kvh * 64, QK + CGV + kvh * 64, MIX + q0 * DM + 256 + h * 64,
                                                   b * SEQ, 128, ML + b * CTXL, 132, nap0, (char*)lds);
                }
                const int hl = G >> 1, li = bx - hl, nl = G - hl;
                if (li >= 0) {
                    for (int id = li; id < 384; id += nl) {
                        const int b = id / 192, rem = id % 192, h = rem >> 5, qb = rem & 31; const long q0 = (long)b * SEQ + 256 * qb;
                        const int gr0 = 4 * qb, lo = gr0 - 4 < 0 ? 0 : gr0 - 4; int rs3 = gr0 - 1; rs3 = rs3 < 0 ? 0 : (rs3 > 120 ? 120 : rs3);
                        const int cnt = rs3 + 7 - lo + 1, ntl = cnt == 8 ? 8 : 12;
                        __syncthreads();
                        { int t_ = tid; asm volatile("" : "+v"(t_)); if (t_ < 465) ((LAS float*)(L + NA_TAB_OFF))[t_] = args.in[11][(size_t)(l * 6 + h) * 465 + t_] * LOG2E; }
                        __syncthreads();
                        const attn_body::NaP nap{gr0, lo, (const LAS float*)(L + NA_TAB_OFF)};
                        attn_body::attn_unit<8, true>(QK + q0 * QKVP + CNQ + h * 64, QK + CNK + h * 64, QK + CNV + h * 64, MIX + q0 * DM + 640 + h * 64,
                                                      ML + b * CTXL, 4, b * SEQ + 64 * lo, 4 + ntl, nap, (char*)lds);
                    }
                    if (need_ctx) {
                        for (int id = li; id < 24; id += nl) {
                            const int na = id / 12, rem = id % 12, b = rem / 6, h = rem % 6; const long q0 = (long)ML + b * CTXL;
                            const int cq = na ? CNQ + h * 64 : CGQ + h * 64, ck = na ? CNK + h * 64 : CGK + (h / 3) * 64, cv = na ? CNV + h * 64 : CGV + (h / 3) * 64, co = (na ? 640 : 256) + h * 64;
                            attn_body::attn_unit<8, false>(QK + q0 * QKVP + cq, QK + ck, QK + cv, MIX + q0 * DM + co, (int)q0, 4, (int)q0, 4, nap0, (char*)lds);
                        }
                    }
                    __syncthreads();
                    LAS float* stf = (LAS float*)(L + wave * 2048);
                    LAS float* stq = stf + 256;
                    LAS float* ob = (LAS float*)(L + 16384 + wave * 16384);
                    const int nblk = need_ctx ? 132 : 128, NU2 = NB * 4 * nblk;
                    const float gnorm = args.in[8][l * 64 + lane];
                    for (int u = li * 8 + wave; u < NU2; u += nl * 8) {
                        const int j = u % nblk, bh = u / nblk, b = bh >> 2, h = bh & 3;
                        const int rbase = j < 128 ? b * SEQ + 64 * j : ML + b * CTXL + 64 * (j - 128);
#pragma unroll 1
                        for (int dir = 1; dir >= 0; --dir) {
                            const int chain = bh * 2 + dir;
                            const int c = dir ? (j < 128 ? 4 + (127 - j) : 3 - (j - 128)) : (j < 128 ? 4 + j : j - 128);
                            const float* F = (dir ? HB : HF) + h * 64;
                            const float* sp = SST + ((size_t)chain * NCHUNK + c) * 4096 + lane;
                            float s[64];
#pragma unroll
                            for (int k = 0; k < 64; ++k) s[k] = sp[k * 64];
#pragma unroll 1
                            for (int t0 = 0; t0 < 64; t0 += 4) {
                                float vv[4];
                                { const int tk = lane >> 4, k4 = (lane & 15) * 4; const int ro = dir ? 63 - (t0 + tk) : t0 + tk; const size_t row = (size_t)(rbase + ro);
                                  *(LAS f32x4*)(stf + tk * 64 + k4) = *(const f32x4*)(F + row * 256 + k4);
                                  const u32x2 qw = *(const u32x2*)(HQ + row * 256 + h * 64 + k4);
                                  f32x4 q4; q4[0] = __builtin_bit_cast(float, qw.x << 16); q4[1] = __builtin_bit_cast(float, qw.x & 0xffff0000u); q4[2] = __builtin_bit_cast(float, qw.y << 16); q4[3] = __builtin_bit_cast(float, qw.y & 0xffff0000u);
                                  *(LAS f32x4*)(stq + tk * 64 + k4) = q4; }
#pragma unroll
                                for (int i = 0; i < 4; ++i) { const int ro = dir ? 63 - (t0 + i) : t0 + i; vv[i] = bf2f(HI[(size_t)(rbase + ro) * 256 + h * 64 + lane]); }
                                asm volatile("s_waitcnt lgkmcnt(0)" ::: "memory");
#pragma unroll 1
                                for (int i = 0; i < 4; ++i) {
                                    const float v = (i == 0) ? vv[0] : (i == 1) ? vv[1] : (i == 2) ? vv[2] : vv[3];
                                    float o0 = 0.f, o1 = 0.f;
#pragma unroll
                                    for (int k4 = 0; k4 < 16; ++k4) { const f32x4 f4 = *(const LAS f32x4*)(stf + i * 64 + 4 * k4), q4 = *(const LAS f32x4*)(stq + i * 64 + 4 * k4);
#pragma unroll
                                        for (int e = 0; e < 4; ++e) { const int k = 4 * k4 + e; s[k] = __builtin_fmaf(f4[e], s[k] - v, v); if (e & 1) o1 = __builtin_fmaf(s[k], q4[e], o1); else o0 = __builtin_fmaf(s[k], q4[e], o0); } }
                                    const float o = o0 + o1; const int ro = dir ? 63 - (t0 + i) : t0 + i;
                                    if (dir) ob[ro * 64 + lane] = o;
                                    else {
                                        const float ot = o + ob[ro * 64 + lane];
                                        const float ms = wave_sum(ot * ot) * (1.f / 64.f);
                                        const size_t row = (size_t)(rbase + ro);
                                        const float y = ot * (1.f / sqrtf(ms + LN_EPS)) * gnorm * bf2f(HG[row * 256 + h * 64 + lane]);
                                        ((bf16r*)MIX)[row * DM + h * 64 + lane] = (bf16r)(pk_bf16(y, 0.f) & 0xffffu);
                                    }
                                }
                                asm volatile("s_waitcnt lgkmcnt(0)" ::: "memory");
                            }
                        }
                    }
                }
            } else if ((sub == 4 || sub == 7) && (PHMASK & 64)) {
                const int Mr = need_ctx ? MT : ML;
                if (sub == 4) { pg8::Gemm g{Hb, (const bf16r*)(ws + WS_WOUT) + (size_t)l * DM * DM, Mr, DM, DM}; pg8::StaticOrder S; S.init(Mr, DM, G, bx);
                    EpiRes E{out, xctx, modl + 2 * DM, dryp}; pg8::gemm_phase<EpiRes, pg8::StaticOrder, true, true>(L, g, S, E); }
                else { pg8::Gemm g{HH, (const bf16r*)(ws + WS_WF2) + (size_t)l * DM * FFH, Mr, DM, FFH}; pg8::StaticOrder S; S.init(Mr, DM, G, bx);
                    EpiRes E{out, xctx, modl + 5 * DM, dryp}; pg8::gemm_phase<EpiRes, pg8::StaticOrder, true, true>(L, g, S, E); }
            } else if ((sub == 5 || sub == 8) && (PHMASK & 128)) {
                const int which = sub == 5 ? 0 : 1; const int Mr = need_ctx ? MT : ML;
                const float* lg = args.in[15] + (size_t)(l * 2 + which) * DM; const float* lbv = args.in[16] + (size_t)(l * 2 + which) * DM;
                const bool wantH = (which == 0) || (l + 1 < DEPTH);
                const float* mdn = which == 0 ? modl + 3 * DM : MODS + (size_t)(l + 1) * 3 * NMOD;
                for (int r = gw; r < (dryp ? 0 : Mr); r += NGW) {
                    float* xp = xrow_ptr(out, xctx, r); f32x4 v[4]; float sm = 0.f;
#pragma unroll
                    for (int j = 0; j < 4; ++j) { v[j] = *(const f32x4*)(xp + 4 * lane + 256 * j); sm += (v[j][0] + v[j][1]) + (v[j][2] + v[j][3]); }
                    const float mean = wave_sum(sm) * (1.f / DM); float s2 = 0.f;
#pragma unroll
                    for (int j = 0; j < 4; ++j) { v[j] = v[j] - mean; s2 += (v[j][0] * v[j][0] + v[j][1] * v[j][1]) + (v[j][2] * v[j][2] + v[j][3] * v[j][3]); }
                    const float rstd = 1.f / sqrtf(wave_sum(s2) * (1.f / DM) + LN_EPS);
                    const float* md = mdn + seg_of_row(r) * NMOD;
#pragma unroll
                    for (int j = 0; j < 4; ++j) { const int c = 4 * lane + 256 * j; const f32x4 y = v[j] * rstd * *(const f32x4*)(lg + c) + *(const f32x4*)(lbv + c); *(f32x4*)(xp + c) = y;
                        if (wantH) { const f32x4 sh = *(const f32x4*)(md + c), scv = *(const f32x4*)(md + DM + c); const f32x4 h = y * (scv + 1.f) + sh;
                            u32x2 w; w.x = pk_bf16(h[0], h[1]); w.y = pk_bf16(h[2], h[3]); *(u32x2*)(Hb + (size_t)r * DM + c) = w; } }
                }
            } else if (sub == 6 && (PHMASK & 256)) {
                const int Mr = need_ctx ? MT : ML;
                pg8::Gemm g{Hb, (const bf16r*)(ws + WS_WF1) + (size_t)l * FF2 * DM, Mr, FF2, DM}; pg8::StaticOrder S; S.init(Mr, FF2, G, bx);
                EpiSwiglu E{HH}; pg8::gemm_phase<EpiSwiglu, pg8::StaticOrder, true, true>(L, g, S, E);
            }
        }
        if (rep_this && !second_) { second_ = true; --ph; GRID_SEAM(); continue; }
        second_ = false;
        if (ph + 1 < args.ph_hi) { GRID_SEAM(); for (int x_ = 0; x_ < EXTRA_SYNCS; ++x_) GRID_SEAM(); }
    }
}

constexpr int N_PHASES = 2 + 9 * DEPTH;
extern "C" void kernel_launch(void* const* d_in, const int* in_sizes, int n_in, void* d_out, int out_size, void* d_ws, size_t ws_size, hipStream_t stream) {
    static int grid = 0;
    if (grid == 0) {
        if (n_in != 17 || out_size != ML * DM || ws_size < WS_END) { fprintf(stderr, "kernel_launch: unexpected shapes (n_in %d out %d ws %zu)\n", n_in, out_size, ws_size); grid = -1; return; }
        int dev = 0, cus = 0, per_cu = 0;
        hipGetDevice(&dev); hipDeviceGetAttribute(&cus, hipDeviceAttributeMultiprocessorCount, dev);
        if (hipFuncSetAttribute((const void*)hybrid_fwd, hipFuncAttributeMaxDynamicSharedMemorySize, LDS_BYTES) != hipSuccess) { fprintf(stderr, "kernel_launch: hipFuncSetAttribute failed\n"); grid = -1; return; }
        if (hipOccupancyMaxActiveBlocksPerMultiprocessor(&per_cu, (const void*)hybrid_fwd, 512, LDS_BYTES) != hipSuccess || per_cu < 1) { fprintf(stderr, "kernel_launch: occupancy query says %d\n", per_cu); (void)hipGetLastError(); grid = -1; return; }
        grid = cus;
    }
    if (grid < 0) return;
    if (hipMemsetAsync((char*)d_ws + WS_BAR, 0, BAR_ZERO_BYTES, stream) != hipSuccess) { fprintf(stderr, "kernel_launch: memset failed\n"); return; }
    Args a{};
    for (int i = 0; i < 17; ++i) a.in[i] = (const float*)d_in[i];
    a.out = (float*)d_out; a.ws = (unsigned char*)d_ws;
#if MK_N_LAUNCHES == 1
    a.ph_lo = 0; a.ph_hi = N_PHASES;
    void* kargs[] = {&a};
    hipError_t e = hipLaunchCooperativeKernel((const void*)hybrid_fwd, dim3(grid), dim3(512), kargs, LDS_BYTES, stream);
    if (e != hipSuccess) fprintf(stderr, "cooperative launch failed: %s (grid %d)\n", hipGetErrorString(e), grid);
#else
    for (int p = 0; p < N_PHASES; ++p) { a.ph_lo = p; a.ph_hi = p + 1; hipLaunchKernelGGL(hybrid_fwd, dim3(grid), dim3(512), LDS_BYTES, stream, a); }
#endif
}
```

```cpp
#include <hip/hip_runtime.h>
#include <cstdio>
#include <cstdint>
namespace pg8 {
#define PG8_LAS __attribute__((address_space(3)))
typedef unsigned short bf16_t;
typedef short bf16x8 __attribute__((ext_vector_type(8)));
typedef float f32x4 __attribute__((ext_vector_type(4)));
typedef unsigned u32x4 __attribute__((ext_vector_type(4)));
constexpr int BM = 256, BK = 64, HALF = 128, HTB = HALF * BK * 2  , STAGE_BYTES = 8 * HTB, NXCD = 8, WGM = 8;

__host__ __device__ __forceinline__ int lds_byte(int r, int c) { const int st = (r >> 4) * 2 + (c >> 5), rr = r & 15, cc = c & 31, ob = rr * 64 + cc * 2; return st * 1024 + (ob ^ (((ob >> 9) & 1) << 5)); }
__host__ __device__ __forceinline__ void stage_rc(int b, int& R, int& C) { const int st = b / 1024, sb = b % 1024, swz = sb ^ (((sb >> 9) & 1) << 5); R = (st >> 1) * 16 + swz / 64; C = (st & 1) * 32 + (swz % 64) / 2; }
__host__ __device__ __forceinline__ int perm32(int rho) { const int n = rho >> 4, i = rho & 15; return 8 * (i >> 2) + 4 * n + (i & 3); }

struct Unit { int pm, pn; };
struct Gemm { const bf16_t* A; const bf16_t* Bt; int M, N, K; };

struct StaticOrder {
    int nM, nN, nwg, G, c;
    __host__ __device__ void init(int M, int N, int G_, int c_) { nM = M / BM; nN = N / BM; nwg = nM * nN; G = G_; c = c_; }
    __host__ __device__ bool next(int i, Unit& u) const {
        const long L = (long)i * G + c; if (L >= nwg) return false;
        int wgid = (int)L; { const int q = nwg / NXCD, r = nwg % NXCD, xcd = wgid % NXCD, off = wgid / NXCD; wgid = (xcd < r ? xcd * (q + 1) : r * (q + 1) + (xcd - r) * q) + off; }
        const int nig = WGM * nN, gid = wgid / nig, fm = gid * WGM, gsz = (nM - fm) < WGM ? (nM - fm) : WGM;
        u.pm = fm + ((wgid % nig) % gsz); u.pn = (wgid % nig) / gsz; return true;
    }
    __device__ __forceinline__ void a_ready(const Unit&) const {}
    __device__ __forceinline__ void done(const Unit&) const {}
};

__device__ __forceinline__ unsigned cvt_pk_bf16(float lo, float hi) { unsigned r; asm volatile("v_cvt_pk_bf16_f32 %0, %1, %2" : "=v"(r) : "v"(lo), "v"(hi)); return r; }
typedef float f32x2 __attribute__((ext_vector_type(2)));
__device__ __forceinline__ f32x2 gelu_pk(f32x2 v) {
    const f32x2 av = __builtin_elementwise_abs(v), d = av * 0.2316418882f + 1.0f;
    f32x2 t; t.x = __builtin_amdgcn_rcpf(d.x); t.y = __builtin_amdgcn_rcpf(d.y);
    f32x2 q = t * 0.5307027145f + (-0.7265760135f); q = q * t + 0.7107068705f; q = q * t + (-0.142248368f); q = q * t + 0.127414796f; q = q * t;
    const f32x2 s = (v * v) * (-0.72134752044f);
    f32x2 e; e.x = __builtin_amdgcn_exp2f(s.x); e.y = __builtin_amdgcn_exp2f(s.y);
    const f32x2 m = v * (q * e), r = v - m;
    f32x2 o; o.x = v.x < 0.f ? m.x : r.x; o.y = v.y < 0.f ? m.y : r.y; return o;
}

template <int ACT  > struct EpiBf16 {
    static constexpr bool PERM = true, AFTER_DRAIN = false; static_assert(ACT == 0 || ACT == 1, "EpiBf16: ACT is 0 (none) or 1 (gelu_pk)");
    bf16_t* O; int ldc; const float* bias; int split_cols; size_t split_stride; float scale0;
    __device__ __forceinline__ void operator()(const f32x4 (&acc)[2][2][4][2], const Unit& u, int wr, int wc, int fr, int fq) const {
        const int row0 = u.pm * BM + wr * 64 + fr; int colt = u.pn * BM; bf16_t* base = O;
        float sc = 1.f; if (split_cols) { const int t = colt / split_cols; base += (size_t)t * split_stride; colt -= t * split_cols; if (t == 0) sc = scale0; }
        const int col0 = colt + wc * 32 + 8 * fq, bcol0 = u.pn * BM + wc * 32 + 8 * fq;
        f32x4 bv[2][2];
#pragma unroll
        for (int bj = 0; bj < 2; ++bj)
#pragma unroll
            for (int n = 0; n < 2; ++n) bv[bj][n] = bias ? *(const f32x4*)(bias + bcol0 + bj * HALF + 4 * n) : (f32x4){0.f, 0.f, 0.f, 0.f};
#pragma unroll
        for (int ai = 0; ai < 2; ++ai)
#pragma unroll
            for (int m = 0; m < 4; ++m) { bf16_t* rowp = base + (size_t)(row0 + ai * HALF + m * 16) * ldc + col0;
#pragma unroll
                for (int bj = 0; bj < 2; ++bj) { f32x4 v0 = acc[ai][bj][m][0] + bv[bj][0], v1 = acc[ai][bj][m][1] + bv[bj][1];
                    if (ACT == 1) { f32x2 a = gelu_pk((f32x2){v0[0], v0[1]}), b = gelu_pk((f32x2){v0[2], v0[3]}), c = gelu_pk((f32x2){v1[0], v1[1]}), d = gelu_pk((f32x2){v1[2], v1[3]});
                        v0 = (f32x4){a.x, a.y, b.x, b.y}; v1 = (f32x4){c.x, c.y, d.x, d.y}; }
                    v0 = v0 * sc; v1 = v1 * sc; u32x4 w; w.x = cvt_pk_bf16(v0[0], v0[1]); w.y = cvt_pk_bf16(v0[2], v0[3]); w.z = cvt_pk_bf16(v1[0], v1[1]); w.w = cvt_pk_bf16(v1[2], v1[3]);
                    *(u32x4*)(rowp + bj * HALF) = w; } }
    }
};

struct PanelStats {
    unsigned* xbuf;
    unsigned* cnt;
    unsigned* tmo;
    int ntn; float eps;
    unsigned code;
    __device__ __forceinline__ bool run(const f32x4 (&v)[2][2][4][2], const Unit& u, int wr, int wc, int fr, int fq, PG8_LAS unsigned char* lds, int wid, int lane) const {
        typedef float f32x2v __attribute__((ext_vector_type(2)));
        PG8_LAS f32x2v* P = (PG8_LAS f32x2v*)lds;
        PG8_LAS f32x2v* S = (PG8_LAS f32x2v*)(lds + 8192);
        PG8_LAS unsigned* flag = (PG8_LAS unsigned*)(lds + 8192 + 2048);
#pragma unroll
        for (int ai = 0; ai < 2; ++ai)
#pragma unroll
            for (int m = 0; m < 4; ++m) {
                float s = 0.f;
#pragma unroll
                for (int bj = 0; bj < 2; ++bj)
#pragma unroll
                    for (int n = 0; n < 2; ++n) { const f32x4 x = v[ai][bj][m][n]; s += (x[0] + x[1]) + (x[2] + x[3]); }
                s += __shfl_xor(s, 16); s += __shfl_xor(s, 32);
                const float mw = s * (1.0f / 64.0f); float q = 0.f;
#pragma unroll
                for (int bj = 0; bj < 2; ++bj)
#pragma unroll
                    for (int n = 0; n < 2; ++n) { const f32x4 d = v[ai][bj][m][n] - mw; q += (d[0] * d[0] + d[1] * d[1]) + (d[2] * d[2] + d[3] * d[3]); }
                q += __shfl_xor(q, 16); q += __shfl_xor(q, 32);
                if (fq == 0) P[(ai * HALF + wr * 64 + m * 16 + fr) * 4 + wc] = (f32x2v){mw, q};
            }
        asm volatile("s_waitcnt lgkmcnt(0)" ::: "memory"); __builtin_amdgcn_s_barrier(); asm volatile("" ::: "memory");
#if defined(BROKEN_EXCHANGE_NO_WAIT)
#warning BROKEN CONTROL BUILD: the row-statistics exchange does not wait; results are wrong by design
        if (blockIdx.x >= 64) { const long long t0_ = clock64(); while (clock64() - t0_ < 60000) __builtin_amdgcn_s_sleep(8); }
#endif
        const int row = wid * 32 + (lane & 31);
        if (lane < 32) {
            const f32x2v a = P[row * 4 + 0], b = P[row * 4 + 1], c = P[row * 4 + 2], d = P[row * 4 + 3];
            const float mt = (a.x + b.x + c.x + d.x) * 0.25f;
            const float da = a.x - mt, db = b.x - mt, dc = c.x - mt, dd = d.x - mt;
            const float m2 = (a.y + b.y) + (c.y + d.y) + 64.0f * ((da * da + db * db) + (dc * dc + dd * dd));
            unsigned long long* slot = (unsigned long long*)xbuf + ((size_t)(u.pm * BM + row) * 4 + u.pn);
            __hip_atomic_store(slot, ((unsigned long long)__float_as_uint(m2) << 32) | __float_as_uint(mt), __ATOMIC_RELAXED, __HIP_MEMORY_SCOPE_AGENT);
        }
        asm volatile("s_waitcnt vmcnt(0)" ::: "memory");
        if (lane == 0) __hip_atomic_fetch_add(cnt + 64 * u.pm, 1u, __ATOMIC_RELAXED, __HIP_MEMORY_SCOPE_AGENT);
        if (wid == 0) {
            bool dead = false; const unsigned long long t0 = __builtin_amdgcn_s_memrealtime(); const unsigned want = 8u * (unsigned)ntn;
            for (;;) {
#if defined(BROKEN_EXCHANGE_NO_WAIT)
                break;
#endif
                if ((unsigned)__builtin_amdgcn_readfirstlane(__hip_atomic_load(cnt + 64 * u.pm, __ATOMIC_RELAXED, __HIP_MEMORY_SCOPE_AGENT)) >= want) break;
                if (__builtin_amdgcn_s_memrealtime() - t0 > 2000000ull) {
                    if (lane == 0) { unsigned expect = 0u; __hip_atomic_compare_exchange_strong(tmo + 1, &expect, code | (unsigned)(u.pm & 0xff), __ATOMIC_RELAXED, __ATOMIC_RELAXED, __HIP_MEMORY_SCOPE_AGENT);
                                     __hip_atomic_store(tmo, 1u, __ATOMIC_RELAXED, __HIP_MEMORY_SCOPE_AGENT); }
                    dead = true; break; }
                __builtin_amdgcn_s_sleep(2);
            }
            __builtin_amdgcn_fence(__ATOMIC_ACQUIRE, "agent");
            if (lane == 0) flag[0] = dead ? 1u : 0u;
        }
        asm volatile("s_waitcnt vmcnt(0) lgkmcnt(0)" ::: "memory"); __builtin_amdgcn_s_barrier(); asm volatile("" ::: "memory");
        const bool bad = flag[0] != 0u;
        if (lane < 32) {
            const unsigned long long* slot = (const unsigned long long*)xbuf + (size_t)(u.pm * BM + row) * 4; float mt[4], m2[4]; float ms = 0.f;
#pragma unroll
            for (int t = 0; t < 4; ++t) { if (t < ntn) { const unsigned long long w = __hip_atomic_load(slot + t, __ATOMIC_RELAXED, __HIP_MEMORY_SCOPE_AGENT); mt[t] = __uint_as_float((unsigned)w); m2[t] = __uint_as_float((unsigned)(w >> 32)); } else { mt[t] = 0.f; m2[t] = 0.f; } ms += mt[t]; }
            const float mean = ms / (float)ntn; float q = 0.f;
#pragma unroll
            for (int t = 0; t < 4; ++t) if (t < ntn) { const float dm = mt[t] - mean; q += m2[t] + 256.0f * dm * dm; }
            S[row] = (f32x2v){mean, 1.0f / sqrtf(q / (256.0f * (float)ntn) + eps)};
        }
        asm volatile("s_waitcnt lgkmcnt(0)" ::: "memory"); __builtin_amdgcn_s_barrier(); asm volatile("" ::: "memory");
        return bad;
    }
};
struct EpiLnRes {
    static constexpr bool PERM = false, AFTER_DRAIN = true;
    const float* base; float* out; int ldc; const float* bias; PanelStats st; unsigned poison;
    __device__ __forceinline__ void fused(f32x4 (&acc)[2][2][4][2], const Unit& u, int wr, int wc, int fr, int fq, PG8_LAS unsigned char* lds, int wid, int lane) const {
        typedef float f32x2v __attribute__((ext_vector_type(2)));
        const PG8_LAS f32x2v* S = (const PG8_LAS f32x2v*)(lds + 8192);
        const int col0 = u.pn * BM + wc * 32 + 4 * fq;
#pragma unroll
        for (int bj = 0; bj < 2; ++bj)
#pragma unroll
            for (int n = 0; n < 2; ++n) { const f32x4 bv = bias ? *(const f32x4*)(bias + col0 + bj * HALF + n * 16) : (f32x4){0.f, 0.f, 0.f, 0.f};
#pragma unroll
                for (int ai = 0; ai < 2; ++ai)
#pragma unroll
                    for (int m = 0; m < 4; ++m) acc[ai][bj][m][n] += bv; }
        f32x4 pre[4][2][2];
#pragma unroll
        for (int m = 0; m < 4; ++m) { const size_t off = (size_t)(u.pm * BM + wr * 64 + m * 16 + fr) * ldc + col0;
#pragma unroll
            for (int bj = 0; bj < 2; ++bj)
#pragma unroll
                for (int n = 0; n < 2; ++n) pre[m][bj][n] = *(const f32x4*)(base + off + bj * HALF + n * 16); }
        const bool bad = st.run(acc, u, wr, wc, fr, fq, lds, wid, lane) || poison != 0u;
        const float qnan = __builtin_nanf("");
#pragma unroll
        for (int ai = 0; ai < 2; ++ai)
#pragma unroll
            for (int m = 0; m < 4; ++m) { const int r = ai * HALF + wr * 64 + m * 16 + fr; const f32x2v sr = S[r]; const size_t off = (size_t)(u.pm * BM + r) * ldc + col0;
#pragma unroll
                for (int bj = 0; bj < 2; ++bj)
#pragma unroll
                    for (int n = 0; n < 2; ++n) { const f32x4 bs = ai == 0 ? pre[m][bj][n] : *(const f32x4*)(base + off + bj * HALF + n * 16); f32x4 o = bs + (acc[ai][bj][m][n] - sr.x) * sr.y;
                        if (bad) o = (f32x4){qnan, qnan, qnan, qnan}; *(f32x4*)(out + off + bj * HALF + n * 16) = o; }
                if (m & 1) asm volatile("" ::: "memory"); }
    }
};
struct EpiLnResLn {
    static constexpr bool PERM = false, AFTER_DRAIN = true;
    const float* base; float* out; bf16_t* xn; int ldc; const float* bias; PanelStats st1, st2; unsigned poison;
    __device__ __forceinline__ void fused(f32x4 (&acc)[2][2][4][2], const Unit& u, int wr, int wc, int fr, int fq, PG8_LAS unsigned char* lds, int wid, int lane) const {
        typedef float f32x2v __attribute__((ext_vector_type(2))); typedef unsigned u32x2v __attribute__((ext_vector_type(2)));
        const PG8_LAS f32x2v* S = (const PG8_LAS f32x2v*)(lds + 8192);
        const int col0 = u.pn * BM + wc * 32 + 4 * fq;
#pragma unroll
        for (int bj = 0; bj < 2; ++bj)
#pragma unroll
            for (int n = 0; n < 2; ++n) { const f32x4 bv = bias ? *(const f32x4*)(bias + col0 + bj * HALF + n * 16) : (f32x4){0.f, 0.f, 0.f, 0.f};
#pragma unroll
                for (int ai = 0; ai < 2; ++ai)
#pragma unroll
                    for (int m = 0; m < 4; ++m) acc[ai][bj][m][n] += bv; }
        bool bad = st1.run(acc, u, wr, wc, fr, fq, lds, wid, lane) || poison != 0u;
        const float qnan = __builtin_nanf("");
#pragma unroll
        for (int ai = 0; ai < 2; ++ai)
#pragma unroll
            for (int m = 0; m < 4; ++m) { const int r = ai * HALF + wr * 64 + m * 16 + fr; const f32x2v sr = S[r]; const size_t off = (size_t)(u.pm * BM + r) * ldc + col0;
#pragma unroll
                for (int bj = 0; bj < 2; ++bj)
#pragma unroll
                    for (int n = 0; n < 2; ++n) { const f32x4 bs = *(const f32x4*)(base + off + bj * HALF + n * 16); acc[ai][bj][m][n] = bs + (acc[ai][bj][m][n] - sr.x) * sr.y; }
                asm volatile("" : "+v"(acc[ai][0][m][0]), "+v"(acc[ai][0][m][1]), "+v"(acc[ai][1][m][0]), "+v"(acc[ai][1][m][1]));
                if (m & 1) asm volatile("" ::: "memory"); }
        const bool bad1 = bad;
        bad = st2.run(acc, u, wr, wc, fr, fq, lds, wid, lane) || bad;
#pragma unroll
        for (int ai = 0; ai < 2; ++ai)
#pragma unroll
            for (int m = 0; m < 4; ++m) { const int r = ai * HALF + wr * 64 + m * 16 + fr; const f32x2v sr = S[r]; const size_t off = (size_t)(u.pm * BM + r) * ldc + col0;
#pragma unroll
                for (int bj = 0; bj < 2; ++bj)
#pragma unroll
                    for (int n = 0; n < 2; ++n) { const f32x4 x1 = acc[ai][bj][m][n]; *(f32x4*)(out + off + bj * HALF + n * 16) = bad1 ? (f32x4){qnan, qnan, qnan, qnan} : x1;
                        const f32x4 o = (x1 - sr.x) * sr.y; u32x2v w; w.x = cvt_pk_bf16(o[0], o[1]); w.y = cvt_pk_bf16(o[2], o[3]);
                        if (bad) { w.x = 0x7fc07fc0u; w.y = 0x7fc07fc0u; } *(u32x2v*)(xn + off + bj * HALF + n * 16) = w; }
                asm volatile("" ::: "memory"); }
    }
};

template <class Epi, class Sched, bool ALIGN_EPI = false, bool SP2 = false>
__device__ __forceinline__ void gemm_phase(PG8_LAS unsigned char* lds, const Gemm g, const Sched& S, const Epi& E) {
    int tid_l = threadIdx.x; asm volatile("" : "+v"(tid_l));
    const int tid = tid_l, wid = __builtin_amdgcn_readfirstlane(tid >> 6), lane = tid & 63, wr = wid >> 2, wc = wid & 3, fr = lane & 15, fq = lane >> 4;
    const int K = g.K, nt = K / BK;
    unsigned voffA[2], voffB[2];
#pragma unroll
    for (int i = 0; i < 2; ++i) { int R, C; stage_rc(tid * 16 + i * 8192, R, C); const int Rb = Epi::PERM ? ((R & ~31) + perm32(R & 31)) : R;
        voffA[i] = (unsigned)(R * K + C) * 2u; voffB[i] = (unsigned)(Rb * K + C) * 2u; }
    const size_t kstep = (size_t)(BK * 2);
    const size_t hstep = (size_t)HALF * K * 2;
    const size_t tstep = 2 * hstep;
    const unsigned ldsw = (unsigned)wid * 1024u;
    const int aoff = lds_byte(wr * 64 + fr, fq * 8), boff = lds_byte(wc * 32 + fr, fq * 8);
#define PG8_SA(b, h) (((b) * 2 + (h)) * HTB)
#define PG8_SB(b, h) ((4 + (b) * 2 + (h)) * HTB)
#define PG8_STAGE(bufoff, gbase, voff) do { _Pragma("unroll") for (int _i = 0; _i < 2; ++_i) \
        __builtin_amdgcn_global_load_lds((const unsigned*)((const char*)(gbase) + (voff)[_i]), (PG8_LAS unsigned*)(lds + (bufoff) + ldsw + _i * 8192), 16, 0, 0); } while (0)
#define PG8_LDA(dst, b, h) do { _Pragma("unroll") for (int m = 0; m < 4; ++m) _Pragma("unroll") for (int k = 0; k < 2; ++k) dst[m][k] = *(const PG8_LAS bf16x8*)(lds + PG8_SA(b, h) + aoff + m * 2048 + k * 1024); } while (0)
#define PG8_LDB(dst, b, h) do { _Pragma("unroll") for (int n = 0; n < 2; ++n) _Pragma("unroll") for (int k = 0; k < 2; ++k) dst[n][k] = *(const PG8_LAS bf16x8*)(lds + PG8_SB(b, h) + boff + n * 2048 + k * 1024); } while (0)
#define PG8_MMA(ai, bj, At, Bt) do { __builtin_amdgcn_s_setprio(1); _Pragma("unroll") for (int m = 0; m < 4; ++m) _Pragma("unroll") for (int n = 0; n < 2; ++n) _Pragma("unroll") for (int k = 0; k < 2; ++k) \
        acc[ai][bj][m][n] = __builtin_amdgcn_mfma_f32_16x16x32_bf16(Bt[n][k], At[m][k], acc[ai][bj][m][n], 0, 0, 0); __builtin_amdgcn_s_setprio(0); } while (0)
#define PG8_WAIT_V(n) asm volatile("s_waitcnt vmcnt(" #n ")" ::: "memory")
#define PG8_WAIT_L(n) asm volatile("s_waitcnt lgkmcnt(" #n ")" ::: "memory")
#define PG8_BAR __builtin_amdgcn_s_barrier()
#define PG8_SCHED __builtin_amdgcn_sched_barrier(0)
    Unit cur, nxt; int ui = 0;
    if (!S.next(0, cur)) return;
    f32x4 acc[2][2][4][2];
#pragma unroll
    for (int a = 0; a < 2; ++a)
#pragma unroll
        for (int b = 0; b < 2; ++b)
#pragma unroll
            for (int m = 0; m < 4; ++m)
#pragma unroll
                for (int n = 0; n < 2; ++n) acc[a][b][m][n] = (f32x4){0.f, 0.f, 0.f, 0.f};
    bf16x8 At[4][2], B0[2][2], B1[2][2];
    const char* cA = (const char*)g.A + (size_t)cur.pm * tstep; const char* cB = (const char*)g.Bt + (size_t)cur.pn * tstep;
    S.a_ready(cur);
    if constexpr (SP2) {
        PG8_STAGE(PG8_SB(0, 0), cB, voffB); PG8_STAGE(PG8_SB(0, 1), cB + hstep, voffB); PG8_STAGE(PG8_SA(0, 0), cA, voffA); PG8_STAGE(PG8_SA(0, 1), cA + hstep, voffA);
        if (wr == 1) PG8_BAR;
        PG8_WAIT_V(2); PG8_BAR;
        PG8_STAGE(PG8_SB(1, 0), cB + kstep, voffB); PG8_STAGE(PG8_SA(1, 0), cA + kstep, voffA); PG8_STAGE(PG8_SB(1, 1), cB + hstep + kstep, voffB);
        PG8_WAIT_V(6); PG8_BAR;
    } else {
        PG8_STAGE(PG8_SB(0, 0), cB, voffB); PG8_STAGE(PG8_SA(0, 0), cA, voffA); PG8_STAGE(PG8_SB(0, 1), cB + hstep, voffB); PG8_STAGE(PG8_SA(0, 1), cA + hstep, voffA);
        if (wr == 1) PG8_BAR;
        PG8_WAIT_V(4); PG8_BAR;
        PG8_STAGE(PG8_SB(1, 0), cB + kstep, voffB); PG8_STAGE(PG8_SA(1, 0), cA + kstep, voffA); PG8_STAGE(PG8_SB(1, 1), cB + hstep + kstep, voffB);
        PG8_WAIT_V(6); PG8_BAR;
    }
    for (;;) {
        const bool has_next = S.next(ui + 1, nxt);
        const char* nA = has_next ? (const char*)g.A + (size_t)nxt.pm * tstep : cA; const char* nB = has_next ? (const char*)g.Bt + (size_t)nxt.pn * tstep : cB;
        for (int t = 0; t < nt; t += 2) {
            const bool last = (t == nt - 2);
            const char* a1 = cA + (size_t)(t + 1) * kstep;
            const char* a2 = last ? nA : cA + (size_t)(t + 2) * kstep; const char* b2 = last ? nB : cB + (size_t)(t + 2) * kstep;
            const char* a3 = a2 + kstep; const char* b3 = b2 + kstep;
            if (last && has_next) S.a_ready(nxt);
            if constexpr (SP2) {
            PG8_LDB(B0, 0, 0); PG8_LDB(B1, 0, 1); PG8_SCHED; PG8_LDA(At, 0, 0); PG8_STAGE(PG8_SA(1, 1), a1 + hstep, voffA);
            PG8_WAIT_V(8); PG8_WAIT_L(0); PG8_BAR; PG8_MMA(0, 0, At, B0); PG8_MMA(0, 1, At, B1); PG8_BAR; PG8_SCHED;
            PG8_LDA(At, 0, 1); PG8_STAGE(PG8_SB(0, 0), b2, voffB); PG8_STAGE(PG8_SB(0, 1), b2 + hstep, voffB); PG8_STAGE(PG8_SA(0, 0), a2, voffA);
            PG8_WAIT_V(8); PG8_WAIT_L(0); PG8_BAR; PG8_MMA(1, 0, At, B0); PG8_MMA(1, 1, At, B1); PG8_BAR; PG8_SCHED;
            PG8_LDB(B0, 1, 0); PG8_LDB(B1, 1, 1); PG8_SCHED; PG8_LDA(At, 1, 0); PG8_STAGE(PG8_SA(0, 1), a2 + hstep, voffA);
            PG8_WAIT_V(8); PG8_WAIT_L(0); PG8_BAR; PG8_MMA(0, 0, At, B0); PG8_MMA(0, 1, At, B1); PG8_BAR; PG8_SCHED;
            PG8_LDA(At, 1, 1); PG8_STAGE(PG8_SB(1, 0), b3, voffB); PG8_STAGE(PG8_SB(1, 1), b3 + hstep, voffB); PG8_STAGE(PG8_SA(1, 0), a3, voffA);
            PG8_WAIT_V(8); PG8_WAIT_L(0); PG8_BAR; PG8_MMA(1, 0, At, B0); PG8_MMA(1, 1, At, B1); PG8_BAR; PG8_SCHED;
            } else {
            PG8_LDB(B0, 0, 0); PG8_SCHED; PG8_LDA(At, 0, 0); PG8_STAGE(PG8_SA(1, 1), a1 + hstep, voffA);
            PG8_WAIT_L(8); PG8_BAR; PG8_WAIT_L(0); PG8_MMA(0, 0, At, B0); PG8_BAR; PG8_SCHED;
            PG8_LDB(B1, 0, 1); PG8_STAGE(PG8_SB(0, 0), b2, voffB);
            PG8_BAR; PG8_WAIT_L(0); PG8_MMA(0, 1, At, B1); PG8_BAR;
            PG8_LDA(At, 0, 1); PG8_STAGE(PG8_SA(0, 0), a2, voffA);
            PG8_BAR; PG8_WAIT_L(0); PG8_MMA(1, 0, At, B0); PG8_BAR; PG8_SCHED;
            PG8_STAGE(PG8_SB(0, 1), b2 + hstep, voffB);
            PG8_WAIT_V(6); PG8_BAR; PG8_MMA(1, 1, At, B1); PG8_BAR;
            PG8_LDB(B0, 1, 0); PG8_SCHED; PG8_LDA(At, 1, 0); PG8_STAGE(PG8_SA(0, 1), a2 + hstep, voffA);
            PG8_WAIT_L(8); PG8_BAR; PG8_WAIT_L(0); PG8_MMA(0, 0, At, B0); PG8_BAR; PG8_SCHED;
            PG8_LDB(B1, 1, 1); PG8_STAGE(PG8_SB(1, 0), b3, voffB);
            PG8_BAR; PG8_WAIT_L(0); PG8_MMA(0, 1, At, B1); PG8_BAR;
            PG8_LDA(At, 1, 1); PG8_STAGE(PG8_SA(1, 0), a3, voffA);
            PG8_BAR; PG8_WAIT_L(0); PG8_MMA(1, 0, At, B0); PG8_BAR; PG8_SCHED;
            PG8_STAGE(PG8_SB(1, 1), b3 + hstep, voffB);
            PG8_WAIT_V(6); PG8_BAR; PG8_MMA(1, 1, At, B1); PG8_BAR;
            }
        }
        if constexpr (ALIGN_EPI) { if (wr == 0) PG8_BAR; }
        if constexpr (!Epi::AFTER_DRAIN) { E(acc, cur, wr, wc, fr, fq); S.done(cur); }
        if (!has_next) break;
#pragma unroll
        for (int a = 0; a < 2; ++a)
#pragma unroll
            for (int b = 0; b < 2; ++b)
#pragma unroll
                for (int m = 0; m < 4; ++m)
#pragma unroll
                    for (int n = 0; n < 2; ++n) acc[a][b][m][n] = (f32x4){0.f, 0.f, 0.f, 0.f};
        cur = nxt; cA = nA; cB = nB; ++ui;
        if constexpr (ALIGN_EPI) { if (wr == 1) PG8_BAR; }
    }
    PG8_WAIT_V(0);
    if constexpr (!ALIGN_EPI) { if (wr == 0) PG8_BAR; }
    PG8_BAR;
    if constexpr (Epi::AFTER_DRAIN) { E.fused(acc, cur, wr, wc, fr, fq, lds, wid, lane); S.done(cur); }
#undef PG8_SA
#undef PG8_SB
#undef PG8_STAGE
#undef PG8_LDA
#undef PG8_LDB
#undef PG8_MMA
#undef PG8_WAIT_V
#undef PG8_WAIT_L
#undef PG8_BAR
#undef PG8_SCHED
}
}

#include <hip/hip_bf16.h>
#include <cmath>
namespace attn_body {
using bf16=__hip_bfloat16;
using bf16x8=__attribute__((ext_vector_type(8)))short;
using s16x4=__attribute__((ext_vector_type(4)))short;
using f32x16=__attribute__((ext_vector_type(16)))float;
using u32x4=__attribute__((ext_vector_type(4)))unsigned;
constexpr int D=64;
constexpr int NW=8,QBLK=32,QB=QBLK*NW,KVBLK=64;
__device__ __forceinline__ int crow(int r,int hi){return (r&3)+8*(r>>2)+4*hi;}
#define SBAR() __builtin_amdgcn_sched_barrier(0)

__device__ __forceinline__ void na_mask(f32x16&p0,f32x16&p1,int krow,int gr,int c,int hi,const __attribute__((address_space(3))) float* tab,float mhat){
  const float NEG=-INFINITY;
  asm volatile("":"+v"(hi),"+v"(c));
  int rs=gr-4; rs=rs<0?0:(rs>120?120:rs);
  const bool rowok=(unsigned)(krow-rs)<8u;
  if(!rowok){
    #pragma unroll
    for(int r=0;r<16;++r){p0[r]=NEG;p1[r]=NEG;}
  } else {
    int cs=c-8; cs=cs<0?0:(cs>48?48:cs);
    const int tb=(krow-gr+7)*31-c+15;
    #pragma unroll
    for(int r=0;r<16;++r){
      const int kv=crow(r,hi);
      const bool ok0=(unsigned)(kv-cs)<16u, ok1=(unsigned)(kv+32-cs)<16u;
      const float b0=tab[ok0?(tb+kv):0], b1=tab[ok1?(tb+kv+32):0];
      p0[r]=ok0?(b0-mhat):NEG; p1[r]=ok1?(b1-mhat):NEG;
    }
  }
}
constexpr int NSLOT=3, SLOTB=8192;
constexpr int LDS_K=0, LDS_V=NSLOT*SLOTB, LDS_WS=2*NSLOT*SLOTB, LDS_OST=LDS_WS+NW*64*4, LDS_BYTES=LDS_OST+NW*4096;
constexpr float C2=0.125f*1.4426950408889634f;
__device__ __forceinline__ void glds16(const void*gsrc,unsigned lds_dst){unsigned keep;
  asm volatile("s_mov_b32 %0, m0\n\ts_mov_b32 m0, %2\n\ts_nop 0\n\tglobal_load_lds_dwordx4 %1, off\n\ts_mov_b32 m0, %0":"=&s"(keep):"v"(gsrc),"s"(lds_dst):"memory");}
__device__ __forceinline__ float max3f(float a,float b,float c){float r;asm("v_max3_f32 %0, %1, %2, %3":"=v"(r):"v"(a),"v"(b),"v"(c));return r;}
__device__ __forceinline__ float max2f(float a,float b){float r;asm("v_max_f32_e32 %0, %1, %2":"=v"(r):"v"(a),"v"(b));return r;}
__device__ __forceinline__ float fadd_s(float a,float b){float r;asm("v_add_f32_e32 %0, %1, %2":"=v"(r):"v"(a),"v"(b));return r;}
__device__ __forceinline__ float fsub_s(float a,float b){float r;asm("v_sub_f32_e32 %0, %1, %2":"=v"(r):"v"(a),"v"(b));return r;}
typedef float f32x2_t __attribute__((ext_vector_type(2))); typedef __bf16 bf16x2_t __attribute__((ext_vector_type(2)));
__device__ __forceinline__ unsigned cvtpk_s(float lo,float hi){f32x2_t v={lo,hi};bf16x2_t b=__builtin_convertvector(v,bf16x2_t);return __builtin_bit_cast(unsigned,b);}
#define WAIT_BAR(N) asm volatile("s_waitcnt vmcnt(" #N ") lgkmcnt(0)\n\ts_barrier":::"memory")

__device__ __forceinline__ void qkt(f32x16&p0,f32x16&p1,const char*Kslot,const bf16x8*qr,const f32x16&negm,int r32,int hi){
  const char*kb=Kslot+hi*1024+r32*16;
  #pragma unroll
  for(int d0=0;d0<4;++d0){
    const bf16x8 b0=*reinterpret_cast<const bf16x8*>(kb+d0*2048);
    const bf16x8 b1=*reinterpret_cast<const bf16x8*>(kb+d0*2048+512);
    if(d0==0){p0=__builtin_amdgcn_mfma_f32_32x32x16_bf16(b0,qr[0],negm,0,0,0);p1=__builtin_amdgcn_mfma_f32_32x32x16_bf16(b1,qr[0],negm,0,0,0);}
    else{p0=__builtin_amdgcn_mfma_f32_32x32x16_bf16(b0,qr[d0],p0,0,0,0);p1=__builtin_amdgcn_mfma_f32_32x32x16_bf16(b1,qr[d0],p1,0,0,0);}}
}
typedef __attribute__((address_space(3))) const char* lds_cptr;
typedef short v4i16_t __attribute__((ext_vector_type(4)));
__device__ __forceinline__ void kload8(bf16x8*kf,lds_cptr kp){
  kf[0]=*(const __attribute__((address_space(3))) bf16x8*)(kp);      kf[1]=*(const __attribute__((address_space(3))) bf16x8*)(kp+512);
  kf[2]=*(const __attribute__((address_space(3))) bf16x8*)(kp+2048); kf[3]=*(const __attribute__((address_space(3))) bf16x8*)(kp+2560);
  kf[4]=*(const __attribute__((address_space(3))) bf16x8*)(kp+4096); kf[5]=*(const __attribute__((address_space(3))) bf16x8*)(kp+4608);
  kf[6]=*(const __attribute__((address_space(3))) bf16x8*)(kp+6144); kf[7]=*(const __attribute__((address_space(3))) bf16x8*)(kp+6656);
}
__device__ __forceinline__ void kload2(bf16x8*kf,lds_cptr kp,int j){ kf[2*j]=*(const __attribute__((address_space(3))) bf16x8*)(kp+j*2048); kf[2*j+1]=*(const __attribute__((address_space(3))) bf16x8*)(kp+j*2048+512); }
__device__ __forceinline__ s16x4 vtr(lds_cptr p){ return __builtin_bit_cast(s16x4,__builtin_amdgcn_ds_read_tr16_b64_v4i16((__attribute__((address_space(3))) v4i16_t*)p)); }
__device__ __forceinline__ float rowmax(const f32x16&p0,const f32x16&p1){
  float a=max3f(p0[0],p0[1],p1[0]),b=max3f(p0[2],p0[3],p1[1]);a=max3f(a,p1[2],p1[3]);
  #pragma unroll
  for(int r=4;r<16;r+=4){a=max3f(a,p0[r],p0[r+1]);b=max3f(b,p0[r+2],p0[r+3]);a=max3f(a,p1[r],p1[r+1]);b=max3f(b,p1[r+2],p1[r+3]);}
  const float m=max2f(a,b);
  auto rr=__builtin_amdgcn_permlane32_swap(__float_as_uint(m),__float_as_uint(m),false,false);
  return max2f(__uint_as_float(rr[0]),__uint_as_float(rr[1]));
}
__device__ __forceinline__ void pv(f32x16*o,int vb,bf16x8 pa0,bf16x8 pa1,bf16x8 pa2,bf16x8 pa3){
  #pragma unroll
  for(int d0=0;d0<2;++d0){s16x4 lo[4],hi[4];
    #pragma unroll
    for(int ks=0;ks<4;++ks){
      asm volatile("ds_read_b64_tr_b16 %0,%1 offset:%c2":"=&v"(lo[ks]):"v"(vb),"i"(d0*4096+ks*1024):"memory");
      asm volatile("ds_read_b64_tr_b16 %0,%1 offset:%c2":"=&v"(hi[ks]):"v"(vb),"i"(d0*4096+ks*1024+512):"memory");}
    asm volatile("s_waitcnt lgkmcnt(0)":::"memory");SBAR();
    #define PK(k) (bf16x8){lo[k][0],lo[k][1],lo[k][2],lo[k][3],hi[k][0],hi[k][1],hi[k][2],hi[k][3]}
    o[d0]=__builtin_amdgcn_mfma_f32_32x32x16_bf16(pa0,PK(0),o[d0],0,0,0);
    o[d0]=__builtin_amdgcn_mfma_f32_32x32x16_bf16(pa1,PK(1),o[d0],0,0,0);
    o[d0]=__builtin_amdgcn_mfma_f32_32x32x16_bf16(pa2,PK(2),o[d0],0,0,0);
    o[d0]=__builtin_amdgcn_mfma_f32_32x32x16_bf16(pa3,PK(3),o[d0],0,0,0);
    #undef PK
  }
}

#ifndef ATTN_STORE16
#define ATTN_STORE16(p,v) (*(u32x4*)(p)=(v))
#endif
struct NaP { int gr0; int r_lo; const __attribute__((address_space(3))) float* tab; };
template<int THRL,bool NA> __device__ __forceinline__ void attn_unit(const bf16*Qb,const bf16*Kc,const bf16*Vc,bf16*Ob,int kr0,int T0,int kr1,int NT,NaP nap,char*shm){
  constexpr int QP=1792,KP=1792,VP=1792,OP=1024;
  int tid_l=threadIdx.x; asm volatile("":"+v"(tid_l));
  const int tid=tid_l,lane=tid&63,r32=lane&31,hi=lane>>5; const int wid=__builtin_amdgcn_readfirstlane(tid>>6);
  const bf16*Qw=Qb+(long)(wid*QBLK)*QP;
  const unsigned lds0=(unsigned)(uintptr_t)shm;
  float*wsf=(float*)(shm+LDS_WS)+wid*64;
  const bf16*ksrc=Kc+(long)lane*KP+wid*8;
  const bf16*vsrc=Vc+(long)(16*(wid&3)+(lane>>2))*VP+(wid>>2)*32+(lane&3)*8;
  const unsigned kdst=lds0+LDS_K+wid*1024, vdst=lds0+LDS_V+wid*1024;
  #define KROW(t) ((long)(((t)<T0)?(kr0+(t)*KVBLK):(kr1+((t)-T0)*KVBLK)))
  #define DMA_K(t,slot) glds16(ksrc+KROW(t)*KP,(unsigned)__builtin_amdgcn_readfirstlane(kdst+(slot)))
  #define DMA_V(t,slot) glds16(vsrc+KROW(t)*VP,(unsigned)__builtin_amdgcn_readfirstlane(vdst+(slot)))
  const int vb0=(int)(lds0+LDS_V)+((lane>>4)&1)*32+(lane&3)*8+(4*hi+((lane&15)>>2))*64;
  const char*Kbase=shm+LDS_K; bf16x8 kf[8];
  const lds_cptr shm3=(lds_cptr)shm; const lds_cptr kp0=shm3+LDS_K+hi*1024+r32*16; const lds_cptr vp0=shm3+LDS_V+((lane>>4)&1)*32+(lane&3)*8+(4*hi+((lane&15)>>2))*64;
  DMA_K(0,0);DMA_V(0,0);DMA_K(1,SLOTB);
  bf16x8 qr[4];
  #pragma unroll
  for(int d0=0;d0<4;++d0)qr[d0]=*reinterpret_cast<const bf16x8*>(&Qw[(long)r32*QP+d0*16+hi*8]);
  float mhat=0.f,l_reg=0.f;f32x16 o[2];o[0]=f32x16{};o[1]=f32x16{};f32x16 negm=f32x16{};if(!NA)asm volatile("":"+v"(negm));
  #define CMASK(P0,P1,t) do{}while(0)
  #define NAFILL(C0,C1,t) do{ if(NA){ if((t)>=T0) na_mask(C0,C1,nap.r_lo+((t)-T0),nap.gr0+(wid>>1),(wid&1)*32+r32,hi,nap.tab,mhat); else { _Pragma("unroll") for(int r_=0;r_<16;++r_){C0[r_]=-mhat;C1[r_]=-mhat;} } } }while(0)
  bool resc=false;
  #define START(P0,P1) do{ const float rm=rowmax(P0,P1); resc=false; \
    { const float dl=rm; mhat=fadd_s(mhat,dl); \
      _Pragma("unroll") for(int r=0;r<16;++r){P0[r]=fsub_s(P0[r],dl);P1[r]=fsub_s(P1[r],dl);} \
      if(!NA){ _Pragma("unroll") for(int r=0;r<16;++r)negm[r]=-mhat; asm volatile("":"+v"(negm)); } } \
    _Pragma("unroll") for(int r=0;r<16;++r)P0[r]=__builtin_amdgcn_exp2f(P0[r]); }while(0)
  #define RESC() do{ if(resc){ asm volatile("s_waitcnt lgkmcnt(0)":::"memory"); \
      _Pragma("unroll") for(int d_=0;d_<2;++d_) _Pragma("unroll") for(int r=0;r<16;++r)o[d_][r]*=wsf[crow(r,hi)]; } }while(0)
  f32x16 pA0,pA1,pB0,pB1;
  int sl_prev=0,sl_cur=0,sl_next=SLOTB;
  #define ROT() do{sl_prev=sl_cur;sl_cur=sl_next;sl_next=(sl_next==(NSLOT-1)*SLOTB)?0:sl_next+SLOTB;}while(0)
  DMA_K(2,2*SLOTB);
  WAIT_BAR(3);
  qkt(pA0,pA1,Kbase,qr,negm,r32,hi);asm volatile("s_nop 15\n\ts_nop 7":"+v"(pA0),"+v"(pA1));CMASK(pA0,pA1,0);
  START(pA0,pA1);
  _Pragma("unroll") for(int r=0;r<16;++r)pA1[r]=__builtin_amdgcn_exp2f(pA1[r]);
  WAIT_BAR(0);
  DMA_K(3,0);DMA_V(1,SLOTB);
  ROT();
  kload8(kf,kp0+sl_cur);
  WAIT_BAR(2);
  s16x4 vlo[8],vhi[8]; u32x4 pw0,pw1,pw2,pw3;
  #define PKW(P,B) cvtpk_s(P[B],P[B+1])
  #define PAF(k) __builtin_bit_cast(bf16x8,pw##k)
  #define VFR(i) (bf16x8){vlo[i][0],vlo[i][1],vlo[i][2],vlo[i][3],vhi[i][0],vhi[i][1],vhi[i][2],vhi[i][3]}
  #define PIN(x) asm volatile("":"+v"(x))
  #define MX3(a,b,c) __builtin_fmaxf(__builtin_fmaxf((a),(b)),(c))
  #define GAPA(MF,A0,A1,A2,A3,W0,W1,PW) do{ MF; sacc+=A0; sacc+=A1; sacc+=A2; sacc+=A3; PIN(sacc); W0; W1; PIN(PW); SBAR(); }while(0)
  #define EX(v) __builtin_amdgcn_exp2f(v)
  #define GAPB(MF,X,B) do{ MF; X[B]=EX(X[B]); X[B+1]=EX(X[B+1]); X[B+2]=EX(X[B+2]); X[B+3]=EX(X[B+3]); PIN(X); SBAR(); }while(0)
  #define VRD(i) do{ vlo[i]=vtr(vp_+(((i)>>2)*4096+((i)&3)*1024)); vhi[i]=vtr(vp_+(((i)>>2)*4096+((i)&3)*1024+512)); }while(0)
  #define KRD(G,j) do{ if(G){ kload2(kf,kp0+sl_next,j); SBAR(); } }while(0)
  #define STEP(C0,C1,P0,P1,t,GK,GV,GL) do{ SBAR(); NAFILL(C0,C1,t); SBAR(); \
    const lds_cptr vp_=vp0+sl_prev; \
    VRD(0); SBAR(); float sacc=(P0[0]+P0[1]); \
    GAPA(C0=__builtin_amdgcn_mfma_f32_32x32x16_bf16(kf[0],qr[0],(NA?C0:negm),0,0,0), P0[2],P0[3],P0[4],P0[5],     pw0[0]=PKW(P0,0), pw0[1]=PKW(P0,2), pw0); \
    VRD(4); SBAR(); GAPA(C1=__builtin_amdgcn_mfma_f32_32x32x16_bf16(kf[1],qr[0],(NA?C1:negm),0,0,0), P0[6],P0[7],P0[8],P0[9],     pw0[2]=PKW(P0,4), pw0[3]=PKW(P0,6), pw0); \
    VRD(1); SBAR(); GAPA(C0=__builtin_amdgcn_mfma_f32_32x32x16_bf16(kf[2],qr[1],C0,0,0,0),   P0[10],P0[11],P0[12],P0[13], pw1[0]=PKW(P0,8), pw1[1]=PKW(P0,10), pw1); \
    VRD(5); SBAR(); GAPA(C1=__builtin_amdgcn_mfma_f32_32x32x16_bf16(kf[3],qr[1],C1,0,0,0),   P0[14],P0[15],P1[0],P1[1],   pw1[2]=PKW(P0,12),pw1[3]=PKW(P0,14), pw1); \
    VRD(2); SBAR(); GAPA(C0=__builtin_amdgcn_mfma_f32_32x32x16_bf16(kf[4],qr[2],C0,0,0,0),   P1[2],P1[3],P1[4],P1[5],     pw2[0]=PKW(P1,0), pw2[1]=PKW(P1,2), pw2); \
    VRD(6); SBAR(); GAPA(C1=__builtin_amdgcn_mfma_f32_32x32x16_bf16(kf[5],qr[2],C1,0,0,0),   P1[6],P1[7],P1[8],P1[9],     pw2[2]=PKW(P1,4), pw2[3]=PKW(P1,6), pw2); \
    VRD(3); SBAR(); GAPA(C0=__builtin_amdgcn_mfma_f32_32x32x16_bf16(kf[6],qr[3],C0,0,0,0),   P1[10],P1[11],P1[12],P1[13], pw3[0]=PKW(P1,8), pw3[1]=PKW(P1,10), pw3); \
    VRD(7); SBAR(); GAPA(C1=__builtin_amdgcn_mfma_f32_32x32x16_bf16(kf[7],qr[3],C1,0,0,0),   P1[14],P1[15],0.f,0.f,       pw3[2]=PKW(P1,12),pw3[3]=PKW(P1,14), pw3); \
    l_reg+=sacc; \
    if(GK){DMA_K((t)+3,sl_cur);} if(GV){DMA_V((t)+1,sl_next);} \
    CMASK(C0,C1,t); \
    { float a=MX3(C0[0],C0[1],C1[0]),b=MX3(C0[2],C0[3],C1[1]); a=MX3(a,C1[2],C1[3]); \
      _Pragma("unroll") for(int r=4;r<16;r+=4){a=MX3(a,C0[r],C0[r+1]);b=MX3(b,C0[r+2],C0[r+3]);a=MX3(a,C1[r],C1[r+1]);b=MX3(b,C1[r+2],C1[r+3]);} \
      float rm=__builtin_fmaxf(a,b); { auto rr=__builtin_amdgcn_permlane32_swap(__float_as_uint(rm),__float_as_uint(rm),false,false); rm=__builtin_fmaxf(__uint_as_float(rr[0]),__uint_as_float(rr[1])); } \
      resc=false; \
      if(__builtin_expect(__any(rm>(float)THRL),0)){ const float dl=__builtin_fmaxf(rm,0.f); mhat+=dl; \
        _Pragma("unroll") for(int r=0;r<16;++r){C0[r]-=dl;C1[r]-=dl;} \
        if(!NA){ _Pragma("unroll") for(int r=0;r<16;++r)negm[r]=-mhat; asm volatile("":"+v"(negm)); } \
        const float f=__builtin_amdgcn_exp2f(-dl); l_reg*=f; if(hi==0)wsf[r32]=f; resc=true; } } \
    SBAR(); \
    GAPB(o[0]=__builtin_amdgcn_mfma_f32_32x32x16_bf16(PAF(0),VFR(0),o[0],0,0,0), C0,0); \
    GAPB(o[1]=__builtin_amdgcn_mfma_f32_32x32x16_bf16(PAF(0),VFR(4),o[1],0,0,0), C0,4); \
    KRD(GL,0); GAPB(o[0]=__builtin_amdgcn_mfma_f32_32x32x16_bf16(PAF(1),VFR(1),o[0],0,0,0), C0,8); \
    KRD(GL,1); GAPB(o[1]=__builtin_amdgcn_mfma_f32_32x32x16_bf16(PAF(1),VFR(5),o[1],0,0,0), C0,12); \
    KRD(GL,2); GAPB(o[0]=__builtin_amdgcn_mfma_f32_32x32x16_bf16(PAF(2),VFR(2),o[0],0,0,0), C1,0); \
    KRD(GL,3); GAPB(o[1]=__builtin_amdgcn_mfma_f32_32x32x16_bf16(PAF(2),VFR(6),o[1],0,0,0), C1,4); \
    GAPB(o[0]=__builtin_amdgcn_mfma_f32_32x32x16_bf16(PAF(3),VFR(3),o[0],0,0,0), C1,8); \
    GAPB(o[1]=__builtin_amdgcn_mfma_f32_32x32x16_bf16(PAF(3),VFR(7),o[1],0,0,0), C1,12); \
    }while(0)
  int t=1;
  for(;t+5<NT;t+=2){
    STEP(pB0,pB1,pA0,pA1,t,true,true,true);     WAIT_BAR(2); RESC(); ROT();
    STEP(pA0,pA1,pB0,pB1,t+1,true,true,true);   WAIT_BAR(2); RESC(); ROT();
  }
  #define ENDW(tt) do{ if((tt)+3<NT){WAIT_BAR(2);} else if((tt)+2<NT){WAIT_BAR(1);} else {WAIT_BAR(0);} }while(0)
  for(;t+1<NT;t+=2){
    STEP(pB0,pB1,pA0,pA1,t,(t+3<NT),(t+1<NT),(t+1<NT));       ENDW(t);   RESC(); ROT();
    STEP(pA0,pA1,pB0,pB1,t+1,(t+4<NT),(t+2<NT),(t+2<NT));     ENDW(t+1); RESC(); ROT();
  }
  STEP(pB0,pB1,pA0,pA1,NT-1,false,false,false); RESC();
  { float sacc=pB0[0]+pB0[1]; _Pragma("unroll") for(int r=2;r<16;++r)sacc+=pB0[r]; _Pragma("unroll") for(int r=0;r<16;++r)sacc+=pB1[r]; l_reg+=sacc;
    pw0=(u32x4){PKW(pB0,0),PKW(pB0,2),PKW(pB0,4),PKW(pB0,6)};pw1=(u32x4){PKW(pB0,8),PKW(pB0,10),PKW(pB0,12),PKW(pB0,14)};pw2=(u32x4){PKW(pB1,0),PKW(pB1,2),PKW(pB1,4),PKW(pB1,6)};pw3=(u32x4){PKW(pB1,8),PKW(pB1,10),PKW(pB1,12),PKW(pB1,14)};
    SBAR(); pv(o,vb0+sl_cur,PAF(0),PAF(1),PAF(2),PAF(3)); }
  #undef PKW
  #undef PAF
  #undef VFR
  #undef PIN
  #undef MX3
  #undef GAPA
  #undef GAPB
  #undef EX
  #undef VRD
  #undef KRD
  #undef STEP
  #undef ENDW
  {auto rr=__builtin_amdgcn_permlane32_swap(__float_as_uint(l_reg),__float_as_uint(l_reg),false,false);l_reg=__uint_as_float(rr[0])+__uint_as_float(rr[1]);}
  if(hi==0)wsf[32+r32]=l_reg;asm volatile("s_waitcnt lgkmcnt(0)":::"memory");
  float rli[16];
  #pragma unroll
  for(int r=0;r<16;++r)rli[r]=__builtin_amdgcn_rcpf(wsf[32+crow(r,hi)]);
  bf16*Ow=Ob+(long)(wid*QBLK)*OP;
  { bf16*stg=(bf16*)(shm+LDS_OST)+wid*2048;
    #pragma unroll
    for(int r=0;r<16;++r){const int orow=crow(r,hi);
      #pragma unroll
      for(int d0=0;d0<2;++d0)stg[orow*64+d0*32+r32]=__float2bfloat16(o[d0][r]*rli[r]);}
    asm volatile("s_waitcnt lgkmcnt(0)":::"memory");
    #pragma unroll
    for(int i=0;i<4;++i){const int row=i*8+(lane>>3),ch=lane&7; const u32x4 v=*(const u32x4*)(stg+row*64+ch*8); ATTN_STORE16(Ow+(long)row*OP+ch*8,v);} }
  asm volatile("s_waitcnt lgkmcnt(0)\n\ts_barrier":::"memory");
  #undef DMA_K
  #undef KROW
  #undef DMA_V
  #undef CMASK
  #undef NAFILL
  #undef START
  #undef RESC
  #undef ROT
}
constexpr int ATTN_LDS_BYTES=LDS_BYTES;
#undef SBAR
#undef WAIT_BAR
}

#include <hip/hip_cooperative_groups.h>
namespace cg = cooperative_groups;

#ifndef PHMASK
#define PHMASK 0xffff
#endif
#ifndef REPEAT_MASK
#define REPEAT_MASK 0
#endif
#ifndef EXTRA_SYNCS
#define EXTRA_SYNCS 0
#endif
#ifndef MK_N_LAUNCHES
#define MK_N_LAUNCHES 1
#endif

#define GAS __attribute__((address_space(1)))
#define LAS __attribute__((address_space(3)))
typedef unsigned short bf16r;
typedef float f32x4 __attribute__((ext_vector_type(4)));
typedef float f32x2 __attribute__((ext_vector_type(2)));
typedef unsigned u32x2 __attribute__((ext_vector_type(2)));
typedef unsigned u32x4 __attribute__((ext_vector_type(4)));

constexpr int DM = 1024, NB = 2, SEQ = 8192, CTXL = 256, DEPTH = 2;
constexpr int ML = NB * SEQ;
constexpr int MC = NB * CTXL;
constexpr int MT = ML + MC;
constexpr int INW = 3072, FFH = 2816, FF2 = 5632, NMOD = 6 * DM;
constexpr float LN_EPS = 1e-6f, DN_ALPHA = 1.4142135623730951f;
constexpr float LOG2E = 1.4426950408889634f, QSCALE = 0.125f * LOG2E;
constexpr int NSUB = 10;
constexpr int NCHUNK = 132, NCHAIN = 16, NHU = NCHAIN * NCHUNK;

constexpr size_t MiB = 1u << 20;
constexpr size_t WS_MODS = 1 * MiB;
constexpr size_t WS_LB = WS_MODS + 160 * 1024;
constexpr size_t WS_ROPE = WS_LB + 8 * 1024;
constexpr size_t WS_WIN = 2 * MiB;
constexpr size_t WS_WOUT = 14 * MiB;
constexpr size_t WS_WF1 = 18 * MiB;
constexpr size_t WS_WF2 = 40 * MiB;
constexpr size_t WS_XCTX = 51 * MiB;
constexpr size_t WS_H = 53 * MiB;
constexpr size_t WS_P = 86 * MiB;
constexpr size_t ROWS2 = (size_t)MT * 2;
constexpr int QKVP = 1792;
constexpr int CGQ = 0, CGK = 384, CGV = 512, CNQ = 640, CNK = 1024, CNV = 1408;
constexpr size_t WS_QKV = WS_P;
constexpr size_t WS_NV_END = WS_QKV + ROWS2 * QKVP;
constexpr size_t WS_HQ = WS_NV_END;
constexpr size_t WS_HI = WS_HQ + ROWS2 * 256;
constexpr size_t WS_HG = WS_HI + ROWS2 * 256;
constexpr size_t WS_HF = WS_HG + ROWS2 * 256;
constexpr size_t WS_HB = WS_HF + ROWS2 * 512;
constexpr size_t WS_PEND = WS_HB + ROWS2 * 512;
constexpr size_t WS_HH = WS_P;
constexpr size_t WS_SST = 202 * MiB;
constexpr size_t WS_ADEC = 235 * MiB;
constexpr size_t WS_END = 236 * MiB;
static_assert(WS_PEND <= WS_SST && WS_HH + ROWS2 * FFH <= WS_SST && WS_SST + (size_t)NHU * 4096 * 4 <= WS_ADEC, "ws map");

constexpr int LDS_BYTES = 147456 + 256;
constexpr int BARST_OFF = 147456;
constexpr size_t WS_BAR = 0, BAR_ZERO_BYTES = 16384;
constexpr int NA_TAB_OFF = 90112;

struct Args { const float* in[17]; float* out; unsigned char* ws; int ph_lo, ph_hi; };

__device__ __forceinline__ unsigned pk_bf16(float lo, float hi) { f32x2 v = {lo, hi}; typedef __bf16 bf2 __attribute__((ext_vector_type(2))); bf2 b = __builtin_convertvector(v, bf2); return __builtin_bit_cast(unsigned, b); }
__device__ __forceinline__ float bf2f(bf16r v) { return __builtin_bit_cast(float, (unsigned)v << 16); }
__device__ __forceinline__ float silu_f(float x) { return x / (1.f + __expf(-x)); }
__device__ __forceinline__ float wave_sum(float v) {
#pragma unroll
    for (int o = 1; o < 64; o <<= 1) v += __shfl_xor(v, o);
    return v;
}
__device__ __forceinline__ int seg_of_row(int r) { return r < SEQ ? 0 : (r < ML ? 1 : 2); }
__device__ __forceinline__ float* xrow_ptr(float* out, float* xctx, int r) { return r < ML ? out + (size_t)r * DM : xctx + (size_t)(r - ML) * DM; }

struct EpiIn {
    static constexpr bool PERM = false, AFTER_DRAIN = false;
    bf16r *HQ, *HI, *HG, *QKV; float *HF, *HB;
    const float *lb, *qn, *kn; const f32x2* rope;
    __device__ __forceinline__ static void st_bf16(bf16r* p, const f32x4 v) { u32x2 w; w.x = pk_bf16(v[0], v[1]); w.y = pk_bf16(v[2], v[3]); *(u32x2*)p = w; }
    __device__ __forceinline__ void operator()(const pg8::f32x4 (&acc)[2][2][4][2], const pg8::Unit& u, int wr, int wc, int fr, int fq) const {
        const int grp = 4 * u.pn + wc;
#pragma unroll
        for (int ai = 0; ai < 2; ++ai)
#pragma unroll
            for (int m = 0; m < 4; ++m) {
                const int r = u.pm * 256 + ai * 128 + wr * 64 + m * 16 + fr;
                f32x4 v[2][2];
#pragma unroll
                for (int bj = 0; bj < 2; ++bj)
#pragma unroll
                    for (int n = 0; n < 2; ++n) { v[bj][n][0] = acc[ai][bj][m][n][0]; v[bj][n][1] = acc[ai][bj][m][n][1]; v[bj][n][2] = acc[ai][bj][m][n][2]; v[bj][n][3] = acc[ai][bj][m][n][3]; }
                if (grp < 20) {
                    const int part = grp >> 2, hc = (grp & 3) * 64;
                    if (part == 1 || part == 2) {
                        float* dst = (part == 1 ? HF : HB) + (size_t)r * 256 + hc;
                        const float* lbp = lb + (part - 1) * 256 + hc;
#pragma unroll
                        for (int bj = 0; bj < 2; ++bj)
#pragma unroll
                            for (int n = 0; n < 2; ++n) { const int d = 32 * bj + 16 * n + 4 * fq; const f32x4 l4 = *(const f32x4*)(lbp + d); f32x4 o;
#pragma unroll
                                for (int e = 0; e < 4; ++e) { const float sg = 1.f / (1.f + expf(-v[bj][n][e])); o[e] = l4[e] + (1.f - l4[e]) * sg; }
                                *(f32x4*)(dst + d) = o; }
                    } else {
                        bf16r* dst = (part == 0 ? HQ : (part == 3 ? HI : HG)) + (size_t)r * 256 + hc;
#pragma unroll
                        for (int bj = 0; bj < 2; ++bj)
#pragma unroll
                            for (int n = 0; n < 2; ++n) { const int d = 32 * bj + 16 * n + 4 * fq; f32x4 o = v[bj][n];
                                if (part != 3) {
#pragma unroll
                                    for (int e = 0; e < 4; ++e) o[e] = silu_f(o[e]); }
                                st_bf16(dst + d, o); }
                    }
                } else if (grp < 28) {
                    const bool isq = grp < 26; const int hh = isq ? grp - 20 : grp - 26;
                    const float* gn = isq ? qn : kn;
                    float ss = 0.f;
#pragma unroll
                    for (int bj = 0; bj < 2; ++bj)
#pragma unroll
                        for (int n = 0; n < 2; ++n)
#pragma unroll
                            for (int e = 0; e < 4; ++e) ss += v[bj][n][e] * v[bj][n][e];
                    ss += __shfl_xor(ss, 16); ss += __shfl_xor(ss, 32);
                    const float rn = 1.f / sqrtf(ss * (1.f / 64.f) + LN_EPS);
                    const float osc = isq ? QSCALE : 1.f;
                    bf16r* dst = QKV + (size_t)r * QKVP + (isq ? CGQ : CGK) + hh * 64;
                    const bool lat = r < ML; const int t = r & (SEQ - 1);
#pragma unroll
                    for (int bj = 0; bj < 2; ++bj) {
                        const int pos = bj ? (t & 63) : (t >> 6);
#pragma unroll
                        for (int n = 0; n < 2; ++n) { const int d = 32 * bj + 16 * n + 4 * fq; const f32x4 g4 = *(const f32x4*)(gn + d); f32x4 o;
#pragma unroll
                            for (int e = 0; e < 4; ++e) o[e] = v[bj][n][e] * rn * g4[e];
                            if (lat) {
#pragma unroll
                                for (int pp = 0; pp < 2; ++pp) { const f32x2 cs = rope[pos * 16 + 8 * n + 2 * fq + pp]; const float x1 = o[2 * pp], x2 = o[2 * pp + 1];
                                    o[2 * pp] = x1 * cs.x - x2 * cs.y; o[2 * pp + 1] = x1 * cs.y + x2 * cs.x; } }
                            o = o * osc; st_bf16(dst + d, o); }
                    }
                } else {
                    bf16r* dst; float osc = 1.f;
                    if (grp < 30) dst = QKV + (size_t)r * QKVP + CGV + (grp - 28) * 64;
                    else if (grp < 36) { dst = QKV + (size_t)r * QKVP + CNQ + (grp - 30) * 64; osc = QSCALE; }
                    else if (grp < 42) dst = QKV + (size_t)r * QKVP + CNK + (grp - 36) * 64;
                    else dst = QKV + (size_t)r * QKVP + CNV + (grp - 42) * 64;
#pragma unroll
                    for (int bj = 0; bj < 2; ++bj)
#pragma unroll
                        for (int n = 0; n < 2; ++n) { const int d = 32 * bj + 16 * n + 4 * fq; st_bf16(dst + d, v[bj][n] * osc); }
                }
            }
    }
};
struct EpiRes {
    static constexpr bool PERM = false, AFTER_DRAIN = false;
    float* out; float* xctx; const float* gate; float* dry;
    __device__ __forceinline__ void operator()(const pg8::f32x4 (&acc)[2][2][4][2], const pg8::Unit& u, int wr, int wc, int fr, int fq) const {
        const int sg = seg_of_row(u.pm * 256);
        const float* gp = gate + sg * NMOD + u.pn * 256 + wc * 32 + 4 * fq;
        f32x4 g4[2][2];
#pragma unroll
        for (int bj = 0; bj < 2; ++bj)
#pragma unroll
            for (int n = 0; n < 2; ++n) g4[bj][n] = *(const f32x4*)(gp + bj * 128 + n * 16);
#pragma unroll
        for (int ai = 0; ai < 2; ++ai)
#pragma unroll
            for (int m = 0; m < 4; ++m) {
                const int r = u.pm * 256 + ai * 128 + wr * 64 + m * 16 + fr;
                float* xp = xrow_ptr(out, xctx, r) + u.pn * 256 + wc * 32 + 4 * fq;
#pragma unroll
                for (int bj = 0; bj < 2; ++bj)
#pragma unroll
                    for (int n = 0; n < 2; ++n) { float* p = xp + bj * 128 + n * 16; const f32x4 x4 = *(const f32x4*)p; f32x4 a; a[0] = acc[ai][bj][m][n][0]; a[1] = acc[ai][bj][m][n][1]; a[2] = acc[ai][bj][m][n][2]; a[3] = acc[ai][bj][m][n][3];
                        float* q = dry ? dry + (size_t)(r & 8191) * DM + (p - xrow_ptr(out, xctx, r)) : p; *(f32x4*)q = x4 * DN_ALPHA + g4[bj][n] * a; }
            }
    }
};
struct EpiSwiglu {
    static constexpr bool PERM = false, AFTER_DRAIN = false;
    bf16r* HH;
    __device__ __forceinline__ void operator()(const pg8::f32x4 (&acc)[2][2][4][2], const pg8::Unit& u, int wr, int wc, int fr, int fq) const {
#pragma unroll
        for (int ai = 0; ai < 2; ++ai)
#pragma unroll
            for (int m = 0; m < 4; ++m) {
                const int r = u.pm * 256 + ai * 128 + wr * 64 + m * 16 + fr;
                bf16r* hp = HH + (size_t)r * FFH + u.pn * 128 + wc * 32 + 4 * fq;
#pragma unroll
                for (int n = 0; n < 2; ++n) { f32x4 o;
#pragma unroll
                    for (int e = 0; e < 4; ++e) o[e] = silu_f(acc[ai][0][m][n][e]) * acc[ai][1][m][n][e];
                    u32x2 w; w.x = pk_bf16(o[0], o[1]); w.y = pk_bf16(o[2], o[3]); *(u32x2*)(hp + n * 16) = w; }
            }
    }
};

__device__ __forceinline__ void transpose_item(const float* W, int K, int N, bf16r* WT, int mode, LAS float* scr, int item, int lane) {
    const int nblk = N / 32, kb = item / nblk, nb = item % nblk, k0 = 64 * kb, n0 = 32 * nb;
#pragma unroll 8
    for (int i = 0; i < 32; ++i) { const int kk = 2 * i + (lane >> 5); scr[kk * 33 + (lane & 31)] = W[(size_t)(k0 + kk) * N + n0 + (lane & 31)]; }
    asm volatile("s_waitcnt lgkmcnt(0)" ::: "memory");
    int ro = n0;
    if (mode == 1) ro = (n0 & ~255) + 128 * ((n0 & 63) >> 5) + 32 * ((n0 & 255) >> 6);
    else if (mode == 2) { const int up = n0 >= FFH, j = up ? n0 - FFH : n0; ro = 256 * (j >> 7) + 128 * up + (j & 127); }
    const int c = lane & 7;
#pragma unroll
    for (int j = 0; j < 4; ++j) { const int n = (lane >> 3) + 8 * j; const LAS float* s = scr + (8 * c) * 33 + n;
        u32x4 o; o.x = pk_bf16(s[0 * 33], s[1 * 33]); o.y = pk_bf16(s[2 * 33], s[3 * 33]); o.z = pk_bf16(s[4 * 33], s[5 * 33]); o.w = pk_bf16(s[6 * 33], s[7 * 33]);
        *(u32x4*)(WT + (size_t)(ro + n) * K + k0 + 8 * c) = o; }
    asm volatile("s_waitcnt lgkmcnt(0)" ::: "memory");
}

#define RLX_AGENT __ATOMIC_RELAXED, __HIP_MEMORY_SCOPE_AGENT
#define LDS_WAIT() asm volatile("s_waitcnt lgkmcnt(0)" ::: "memory")
#define VM_WAIT() asm volatile("s_waitcnt vmcnt(0)" ::: "memory")
__device__ __forceinline__ unsigned long long rt() { return __builtin_amdgcn_s_memrealtime(); }
#define XB_TMO      128
#define XB_XCNT(j)  (256  + 64 * (j))
#define XB_XSUB(j)  (1280 + 64 * (j))
#define XB_XGEN(j)  (2304 + 64 * (j))
#define XB_TOP      3328
#define XB_TOPGEN   3392
#define XCD_BAR_WORDS 3456
#define XB_SPIN_CAP (1u << 18)

__device__ __forceinline__ unsigned xb_ld(unsigned* p)              { return __hip_atomic_load(p, __ATOMIC_RELAXED, __HIP_MEMORY_SCOPE_AGENT); }
__device__ __forceinline__ unsigned xb_add(unsigned* p, unsigned v) { return __hip_atomic_fetch_add(p, v, __ATOMIC_RELAXED, __HIP_MEMORY_SCOPE_AGENT); }
__device__ __forceinline__ unsigned xb_xcc_id() { return (unsigned)__builtin_amdgcn_s_getreg((3 << 11) | 20) & 0xFu; }
#define XB_SPIN(cond, bar) do { unsigned _sp = 0; while (cond) { __builtin_amdgcn_s_sleep(1); \
    if ((++_sp & 255u) == 0u) { if (xb_ld(&(bar)[XB_TMO])) break; if (_sp > XB_SPIN_CAP) { atomicAdd(&(bar)[XB_TMO], 1u); break; } } } } while (0)

struct XcdBarrier {
    unsigned* bar; unsigned x;
    volatile LAS unsigned* st;
};

__device__ __forceinline__ XcdBarrier xcd_barrier_post(unsigned* bar, volatile LAS unsigned* st) {
    XcdBarrier b; b.bar = bar; b.x = xb_xcc_id(); b.st = st;
    if (threadIdx.x == 0) (void)xb_add(&bar[XB_XCNT(b.x)], 1u);
    return b;
}
__device__ __forceinline__ void xcd_barrier_complete(unsigned* bar, unsigned x, unsigned& nloc, unsigned& nx) {
    const unsigned G = gridDim.x * gridDim.y * gridDim.z;
    unsigned sum, cnt, mine, sp = 0u;
    for (;;) {
        sum = 0u; cnt = 0u; mine = 0u;
#pragma unroll
        for (unsigned j = 0; j < 16; ++j) { const unsigned c = xb_ld(&bar[XB_XCNT(j)]); sum += c; cnt += (c > 0u) ? 1u : 0u; mine = (j == x) ? c : mine; }
        if (sum == G) break;
        __builtin_amdgcn_s_sleep(1);
        if ((++sp & 255u) == 0u) { if (xb_ld(&bar[XB_TMO])) break; if (sp > XB_SPIN_CAP) { atomicAdd(&bar[XB_TMO], 1u); break; } }
    }
    nloc = mine > 0u ? mine : 1u; nx = cnt > 0u ? cnt : 1u;
}

__device__ __forceinline__ void xcd_barrier(const XcdBarrier& b) {
    asm volatile("s_waitcnt vmcnt(0)" ::: "memory");
    __syncthreads();
    if (threadIdx.x == 0) {
        unsigned* bar = b.bar;
        __builtin_amdgcn_s_waitcnt(0);
        unsigned nloc = b.st[0], nx = b.st[1];
        if (nloc == 0u) { xcd_barrier_complete(bar, b.x, nloc, nx); b.st[0] = nloc; b.st[1] = nx; }
        const unsigned old = xb_add(&bar[XB_XSUB(b.x)], 1u);
        const unsigned gen = old / nloc;
        if (old + 1u == (gen + 1u) * nloc) {
            __builtin_amdgcn_fence(__ATOMIC_RELEASE, "agent");
            asm volatile("s_waitcnt vmcnt(0)" ::: "memory");
            const unsigned og = xb_add(&bar[XB_TOP], 1u);
            const unsigned tg = og / nx;
            if (og + 1u == (tg + 1u) * nx) xb_add(&bar[XB_TOPGEN], 1u);
            else XB_SPIN(xb_ld(&bar[XB_TOPGEN]) == tg, bar);
            __builtin_amdgcn_fence(__ATOMIC_ACQUIRE, "agent");
            xb_add(&bar[XB_XGEN(b.x)], 1u);
            asm volatile("s_waitcnt vmcnt(0)" ::: "memory");
        } else {
            XB_SPIN(xb_ld(&bar[XB_XGEN(b.x)]) == gen, bar);
            __builtin_amdgcn_fence(__ATOMIC_ACQUIRE, "agent");
            asm volatile("s_waitcnt vmcnt(0)" ::: "memory");
        }
    }
    __syncthreads();
}

__global__ void __launch_bounds__(512) hybrid_fwd(Args args) {
    extern __shared__ __attribute__((aligned(16))) unsigned char lds[];
    LAS unsigned char* L = (LAS unsigned char*)lds;
    const int G = gridDim.x, bx = blockIdx.x, NGW = G * 8;
    unsigned char* ws = args.ws;
    float* out = args.out;
    float* xctx = (float*)(ws + WS_XCTX);
    float* MODS = (float*)(ws + WS_MODS);
    float* LBT = (float*)(ws + WS_LB);
    f32x2* ROPE = (f32x2*)(ws + WS_ROPE);
    bf16r* Hb = (bf16r*)(ws + WS_H);
    bf16r* QKV = (bf16r*)(ws + WS_QKV);
    bf16r *HQ = (bf16r*)(ws + WS_HQ), *HI = (bf16r*)(ws + WS_HI), *HG = (bf16r*)(ws + WS_HG);
    float *HF = (float*)(ws + WS_HF), *HB = (float*)(ws + WS_HB);
    bf16r* HH = (bf16r*)(ws + WS_HH);
    float* SST = (float*)(ws + WS_SST); float* ADEC = (float*)(ws + WS_ADEC);
    cg::grid_group grid = cg::this_grid();
    if (threadIdx.x < 64) ((LAS unsigned*)(L + BARST_OFF))[threadIdx.x] = 0u;
    __syncthreads();
    const XcdBarrier xbar = xcd_barrier_post((unsigned*)(ws + WS_BAR), (volatile LAS unsigned*)(L + BARST_OFF));
    int nsync_ = 0;
#define GRID_SEAM() do { if (nsync_ == 0) { __syncthreads(); grid.sync(); } else xcd_barrier(xbar); ++nsync_; } while (0)

    bool second_ = false;
    for (int ph = args.ph_lo; ph < args.ph_hi; ++ph) {
        int tid_l = threadIdx.x; asm volatile("" : "+v"(tid_l));
        const int tid = tid_l, lane = tid & 63, wave = __builtin_amdgcn_readfirstlane(tid >> 6), gw = bx * 8 + wave;
        const bool rep_this = (REPEAT_MASK != 0) && ph >= 2 && ((REPEAT_MASK >> ((ph - 2) % NSUB)) & 1);
        float* dryp = (rep_this && !second_) ? (float*)(args.ws + WS_SST) : nullptr;
        if (ph == 0 && (PHMASK & 1)) {
            LAS float* scr = (LAS float*)(L + wave * 16384);
            constexpr int I_IN = 16 * (INW / 32), I_OUT = 16 * (DM / 32), I_F1 = 16 * (FF2 / 32), I_F2 = (FFH / 64) * (DM / 32), I_L = I_IN + I_OUT + I_F1 + I_F2;
            for (int it = gw; it < DEPTH * I_L; it += NGW) {
                const int l = it / I_L; int r = it % I_L;
                if (r < I_IN) { transpose_item(args.in[6] + (size_t)l * DM * INW, DM, INW, (bf16r*)(ws + WS_WIN) + (size_t)l * INW * DM, 1, scr, r, lane); continue; } r -= I_IN;
                if (r < I_OUT) { transpose_item(args.in[12] + (size_t)l * DM * DM, DM, DM, (bf16r*)(ws + WS_WOUT) + (size_t)l * DM * DM, 0, scr, r, lane); continue; } r -= I_OUT;
                if (r < I_F1) { transpose_item(args.in[13] + (size_t)l * DM * FF2, DM, FF2, (bf16r*)(ws + WS_WF1) + (size_t)l * FF2 * DM, 2, scr, r, lane); continue; } r -= I_F1;
                transpose_item(args.in[14] + (size_t)l * FFH * DM, FFH, DM, (bf16r*)(ws + WS_WF2) + (size_t)l * DM * FFH, 0, scr, r, lane);
            }
            __syncthreads();
            if (bx < 192) {
                LAS float* sc = (LAS float*)L;
                LAS float* red = (LAS float*)(L + 16384);
                for (int i = tid; i < 3 * DM; i += 512) { const int s = i >> 10, k = i & 1023; const float cv = s < 2 ? args.in[1][s * DM + k] : args.in[3][k]; sc[i] = silu_f(cv); }
                __syncthreads();
                for (int it = bx; it < 192; it += G) {
                    const int l = it / 96, n0 = (it % 96) * 64;
                    const float* wa = args.in[4] + (size_t)l * DM * NMOD + n0 + lane;
                    float a0 = 0.f, a1 = 0.f, a2 = 0.f;
#pragma unroll 8
                    for (int k = wave * 128; k < wave * 128 + 128; ++k) { const float w = wa[(size_t)k * NMOD]; a0 += sc[k] * w; a1 += sc[DM + k] * w; a2 += sc[2 * DM + k] * w; }
                    red[(wave * 3 + 0) * 64 + lane] = a0; red[(wave * 3 + 1) * 64 + lane] = a1; red[(wave * 3 + 2) * 64 + lane] = a2;
                    __syncthreads();
                    if (tid < 192) { const int s = tid >> 6; float sum = 0.f;
#pragma unroll
                        for (int w = 0; w < 8; ++w) sum += red[(w * 3 + s) * 64 + lane];
                        MODS[(l * 3 + s) * NMOD + n0 + lane] = sum + args.in[5][l * NMOD + n0 + lane]; }
                    __syncthreads();
                }
            }
            if (bx == G - 1) {
                for (int i = tid; i < 128 * 16; i += 512) { const int pos = i >> 4, j = i & 15; const float invf = expf((-9.210340371976184f * (float)j) / 16.0f); const float ang = (float)pos * invf; ROPE[i] = (f32x2){cosf(ang), sinf(ang)}; }
                { const int d = tid >> 8, k = tid & 255; const float a0 = args.in[7][d * 256 + k], a1 = args.in[7][512 + d * 256 + k]; const float mx = fmaxf(a0, a1); const float e0 = expf(a0 - mx), e1 = expf(a1 - mx);
                  const float p1 = e1 / (e0 + e1); LBT[d * 256 + k] = 0.f; LBT[512 + d * 256 + k] = fminf(fmaxf(p1, 0.f), 1.f); }
            }
        } else if (ph == 1 && (PHMASK & 2)) {
            for (int r = gw; r < MT; r += NGW) {
                const float* src = r < ML ? args.in[0] + (size_t)r * DM : args.in[2] + (size_t)(r - ML) * DM;
                float* xp = xrow_ptr(out, xctx, r); const float* md = MODS + seg_of_row(r) * NMOD;
#pragma unroll
                for (int j = 0; j < 4; ++j) { const int c = 4 * lane + 256 * j; const f32x4 v = *(const f32x4*)(src + c); *(f32x4*)(xp + c) = v;
                    const f32x4 sh = *(const f32x4*)(md + c), scv = *(const f32x4*)(md + DM + c); const f32x4 h = v * (scv + 1.f) + sh;
                    u32x2 w; w.x = pk_bf16(h[0], h[1]); w.y = pk_bf16(h[2], h[3]); *(u32x2*)(Hb + (size_t)r * DM + c) = w; }
            }
        } else {
            const int l = (ph - 2) / NSUB, sub = (ph - 2) % NSUB;
            const bool need_ctx = l < DEPTH - 1;
            const float* modl = MODS + (size_t)l * 3 * NMOD;
            if (sub == 0 && (PHMASK & 4)) {
                pg8::Gemm g{Hb, (const bf16r*)(ws + WS_WIN) + (size_t)l * INW * DM, MT, INW, DM}; pg8::StaticOrder S; S.init(MT, INW, G, bx);
                EpiIn E{HQ, HI, HG, QKV, HF, HB, LBT + l * 512, args.in[9] + l * 64, args.in[10] + l * 64, ROPE};
                pg8::gemm_phase<EpiIn, pg8::StaticOrder, true, true>(L, g, S, E);
            } else if (sub == 1 && (PHMASK & 8)) {
                LAS float* stf = (LAS float*)(L + wave * 2048);
                LAS float* stv = stf + 256;
                const int kq = lane >> 4, vl = lane & 15, tk = lane >> 4, k4 = (lane & 15) * 4;
                for (int u = wave * G + bx; u < NHU; u += NGW) {
                    const int chain = u / NCHUNK, c = u % NCHUNK, b = chain >> 3, h = (chain >> 1) & 3, dir = chain & 1;
                    int base, sgn;
                    if (dir == 0) { base = c < 4 ? ML + b * CTXL + 64 * c : b * SEQ + 64 * (c - 4); sgn = 1; }
                    else { base = c < 4 ? ML + b * CTXL + 255 - 64 * c : b * SEQ + SEQ - 1 - 64 * (c - 4); sgn = -1; }
                    const float* F = (dir ? HB : HF) + h * 64 + k4; const bf16r* VI = HI + h * 64 + k4;
                    f32x2 s[16][2], a[8];
#pragma unroll
                    for (int kk = 0; kk < 16; ++kk) { s[kk][0] = (f32x2){0.f, 0.f}; s[kk][1] = (f32x2){0.f, 0.f}; }
#pragma unroll
                    for (int kk = 0; kk < 8; ++kk) a[kk] = (f32x2){1.f, 1.f};
                    f32x4 rf; u32x2 rv;
                    { const size_t row = (size_t)(base + sgn * tk); rf = *(const f32x4*)(F + row * 256); rv = *(const u32x2*)(VI + row * 256); }
#pragma unroll 1
                    for (int g = 0; g < 16; ++g) {
                        *(LAS f32x4*)(stf + tk * 64 + k4) = rf;
                        { f32x4 v4; v4[0] = __builtin_bit_cast(float, rv.x << 16); v4[1] = __builtin_bit_cast(float, rv.x & 0xffff0000u); v4[2] = __builtin_bit_cast(float, rv.y << 16); v4[3] = __builtin_bit_cast(float, rv.y & 0xffff0000u);
                          *(LAS f32x4*)(stv + tk * 64 + k4) = v4; }
                        if (g + 1 < 16) { const size_t row = (size_t)(base + sgn * (4 * (g + 1) + tk)); rf = *(const f32x4*)(F + row * 256); rv = *(const u32x2*)(VI + row * 256); }
#pragma unroll
                        for (int i = 0; i < 4; ++i) {
                            f32x2 v2[2]; v2[0] = (f32x2){stv[i * 64 + vl], stv[i * 64 + vl + 16]}; v2[1] = (f32x2){stv[i * 64 + vl + 32], stv[i * 64 + vl + 48]};
#pragma unroll
                            for (int j = 0; j < 4; ++j) { const f32x4 f4 = *(const LAS f32x4*)(stf + i * 64 + 16 * kq + 4 * j);
#pragma unroll
                                for (int e = 0; e < 4; ++e) { const int kk = 4 * j + e; const f32x2 f2 = (f32x2){f4[e], f4[e]}; s[kk][0] = f2 * (s[kk][0] - v2[0]) + v2[0]; s[kk][1] = f2 * (s[kk][1] - v2[1]) + v2[1]; }
                                a[2 * j] = a[2 * j] * (f32x2){f4[0], f4[1]}; a[2 * j + 1] = a[2 * j + 1] * (f32x2){f4[2], f4[3]}; }
                        }
                    }
                    float* so = SST + (size_t)u * 4096 + lane;
#pragma unroll
                    for (int kk = 0; kk < 16; ++kk) { so[(kk * 4 + 0) * 64] = s[kk][0].x; so[(kk * 4 + 1) * 64] = s[kk][0].y; so[(kk * 4 + 2) * 64] = s[kk][1].x; so[(kk * 4 + 3) * 64] = s[kk][1].y; }
                    if (vl == 0) {
#pragma unroll
                        for (int kk = 0; kk < 8; ++kk) { ADEC[(size_t)u * 64 + 16 * kq + 2 * kk] = a[kk].x; ADEC[(size_t)u * 64 + 16 * kq + 2 * kk + 1] = a[kk].y; } }
                }
            } else if (sub == 2 && (PHMASK & 16)) {
                const int gt = bx * 512 + tid;
                if (gt < NCHAIN * 4096 && !dryp) {
                    const int chain = gt >> 12, e = gt & 4095, k = 16 * ((e & 63) >> 4) + (e >> 8);
                    float* sp = SST + (size_t)chain * NCHUNK * 4096 + e; const float* ap = ADEC + (size_t)chain * NCHUNK * 64 + k;
                    float s = 0.f;
#pragma unroll 6
                    for (int c = 0; c < NCHUNK; ++c) { const float loc = sp[(size_t)c * 4096], a = ap[c * 64]; sp[(size_t)c * 4096] = s; s = a * s + loc; }
                }
            } else if (sub == 3 && (PHMASK & 512)) {
                LAS float* stf = (LAS float*)(L + wave * 3072);
                LAS float* stq = stf + 256; LAS float* stv = stf + 512;
                LAS bf16r* ob = (LAS bf16r*)(L + 24576 + wave * 8192);
                const int kq = lane >> 4, vl = lane & 15, tk = lane >> 4, k4 = (lane & 15) * 4;
                const int nblk = need_ctx ? 132 : 128, NU2 = NB * 4 * nblk;
                const float gnorm = args.in[8][l * 64 + lane];
                bf16r* MIXr = Hb;
                for (int u = wave * G + bx; u < NU2; u += NGW) {
                    const int j = u % nblk, bh = u / nblk, b = bh >> 2, h = bh & 3;
                    const int rbase = j < 128 ? b * SEQ + 64 * j : ML + b * CTXL + 64 * (j - 128);
#pragma unroll 1
                    for (int dir = 1; dir >= 0; --dir) {
                        const int chain = bh * 2 + dir;
                        const int c = dir ? (j < 128 ? 4 + (127 - j) : 3 - (j - 128)) : (j < 128 ? 4 + j : j - 128);
                        const float* F = (dir ? HB : HF) + h * 64 + k4; const bf16r* QI = HQ + h * 64 + k4; const bf16r* VI = HI + h * 64 + k4; const bf16r* GI = HG + h * 64 + lane;
                        const float* sp = SST + ((size_t)chain * NCHUNK + c) * 4096 + lane;
                        f32x2 s[16][2];
#pragma unroll
                        for (int kk = 0; kk < 16; ++kk) { s[kk][0] = (f32x2){sp[(kk * 4 + 0) * 64], sp[(kk * 4 + 1) * 64]}; s[kk][1] = (f32x2){sp[(kk * 4 + 2) * 64], sp[(kk * 4 + 3) * 64]}; }
                        f32x4 rf; u32x2 rq, rv; bf16r rg[4];
                        { const size_t row = (size_t)(rbase + (dir ? 63 - tk : tk)); rf = *(const f32x4*)(F + row * 256); rq = *(const u32x2*)(QI + row * 256); rv = *(const u32x2*)(VI + row * 256); }
#pragma unroll
                        for (int i = 0; i < 4; ++i) rg[i] = GI[(size_t)(rbase + (dir ? 63 - i : i)) * 256];
#pragma unroll 1
                        for (int g = 0; g < 16; ++g) {
                            *(LAS f32x4*)(stf + tk * 64 + k4) = rf;
                            { f32x4 q4; q4[0] = __builtin_bit_cast(float, rq.x << 16); q4[1] = __builtin_bit_cast(float, rq.x & 0xffff0000u); q4[2] = __builtin_bit_cast(float, rq.y << 16); q4[3] = __builtin_bit_cast(float, rq.y & 0xffff0000u); *(LAS f32x4*)(stq + tk * 64 + k4) = q4; }
                            { f32x4 v4; v4[0] = __builtin_bit_cast(float, rv.x << 16); v4[1] = __builtin_bit_cast(float, rv.x & 0xffff0000u); v4[2] = __builtin_bit_cast(float, rv.y << 16); v4[3] = __builtin_bit_cast(float, rv.y & 0xffff0000u); *(LAS f32x4*)(stv + tk * 64 + k4) = v4; }
                            float gt4[4];
#pragma unroll
                            for (int i = 0; i < 4; ++i) gt4[i] = bf2f(rg[i]);
                            if (g + 1 < 16) { const int t1 = 4 * (g + 1); const size_t row = (size_t)(rbase + (dir ? 63 - (t1 + tk) : t1 + tk)); rf = *(const f32x4*)(F + row * 256); rq = *(const u32x2*)(QI + row * 256); rv = *(const u32x2*)(VI + row * 256);
#pragma unroll
                                for (int i = 0; i < 4; ++i) rg[i] = GI[(size_t)(rbase + (dir ? 63 - (t1 + i) : t1 + i)) * 256]; }
#pragma unroll
                            for (int i = 0; i < 4; ++i) {
                                f32x2 v2[2]; v2[0] = (f32x2){stv[i * 64 + vl], stv[i * 64 + vl + 16]}; v2[1] = (f32x2){stv[i * 64 + vl + 32], stv[i * 64 + vl + 48]};
                                f32x2 oa[2]; oa[0] = (f32x2){0.f, 0.f}; oa[1] = (f32x2){0.f, 0.f};
#pragma unroll
                                for (int jj = 0; jj < 4; ++jj) { const f32x4 f4 = *(const LAS f32x4*)(stf + i * 64 + 16 * kq + 4 * jj), q4 = *(const LAS f32x4*)(stq + i * 64 + 16 * kq + 4 * jj);
#pragma unroll
                                    for (int e = 0; e < 4; ++e) { const int kk = 4 * jj + e; const f32x2 f2 = (f32x2){f4[e], f4[e]}, q2 = (f32x2){q4[e], q4[e]};
                                        s[kk][0] = f2 * (s[kk][0] - v2[0]) + v2[0]; s[kk][1] = f2 * (s[kk][1] - v2[1]) + v2[1]; oa[0] = s[kk][0] * q2 + oa[0]; oa[1] = s[kk][1] * q2 + oa[1]; } }
                                float o[4] = {oa[0].x, oa[0].y, oa[1].x, oa[1].y};
#pragma unroll
                                for (int ii = 0; ii < 4; ++ii) { o[ii] += __shfl_xor(o[ii], 16); o[ii] += __shfl_xor(o[ii], 32); }
                                const int ro = dir ? 63 - (4 * g + i) : 4 * g + i;
                                if (dir) { const float mine = kq == 0 ? o[0] : (kq == 1 ? o[1] : (kq == 2 ? o[2] : o[3])); ob[ro * 64 + lane] = (bf16r)(pk_bf16(mine, 0.f) & 0xffffu); }
                                else {
                                    float ss = 0.f;
#pragma unroll
                                    for (int ii = 0; ii < 4; ++ii) { o[ii] += bf2f(ob[ro * 64 + vl + 16 * ii]); ss += o[ii] * o[ii]; }
                                    ss += __shfl_xor(ss, 1); ss += __shfl_xor(ss, 2); ss += __shfl_xor(ss, 4); ss += __shfl_xor(ss, 8);
                                    const float mine = kq == 0 ? o[0] : (kq == 1 ? o[1] : (kq == 2 ? o[2] : o[3]));
                                    const float y = mine * (1.f / sqrtf(ss * (1.f / 64.f) + LN_EPS)) * gnorm * gt4[i];
                                    MIXr[(size_t)(rbase + ro) * DM + h * 64 + lane] = (bf16r)(pk_bf16(y, 0.f) & 0xffffu);
                                }
                            }
                        }
                    }
                }
            } else if (sub == 4 && (PHMASK & 32)) {
                using attn_body::bf16;
                bf16* MIX = (bf16*)Hb; const bf16* QK = (const bf16*)QKV;
                const attn_body::NaP nap0{0, 0, (const LAS float*)(L + NA_TAB_OFF)};
                for (int id = bx; id < 384; id += G) {
                    const int b = id / 192, rem = id % 192, h = rem >> 5, qb = rem & 31, kvh = h / 3; const long q0 = (long)b * SEQ + 256 * qb;
                    attn_body::attn_unit<8, false>(QK + q0 * QKVP + CGQ + h * 64, QK + CGK + kvh * 64, QK + CGV + kvh * 64, MIX + q0 * DM + 256 + h * 64,
                                                   b * SEQ, 128, ML + b * CTXL, 132, nap0, (char*)lds);
                }
                const int hl = G >> 1, li = bx - hl, nl = G - hl;
                if (li >= 0) {
                    for (int id = li; id < 384; id += nl) {
                        const int b = id / 192, rem = id % 192, h = rem >> 5, qb = rem & 31; const long q0 = (long)b * SEQ + 256 * qb;
                        const int gr0 = 4 * qb, lo = gr0 - 4 < 0 ? 0 : gr0 - 4; int rs3 = gr0 - 1; rs3 = rs3 < 0 ? 0 : (rs3 > 120 ? 120 : rs3);
                        const int cnt = rs3 + 7 - lo + 1, ntl = cnt == 8 ? 8 : 12;
                        __syncthreads();
                        { int t_ = tid; asm volatile("" : "+v"(t_)); if (t_ < 465) ((LAS float*)(L + NA_TAB_OFF))[t_] = args.in[11][(size_t)(l * 6 + h) * 465 + t_] * LOG2E; }
                        __syncthreads();
                        const attn_body::NaP nap{gr0, lo, (const LAS float*)(L + NA_TAB_OFF)};
                        attn_body::attn_unit<8, true>(QK + q0 * QKVP + CNQ + h * 64, QK + CNK + h * 64, QK + CNV + h * 64, MIX + q0 * DM + 640 + h * 64,
                                                      ML + b * CTXL, 4, b * SEQ + 64 * lo, 4 + ntl, nap, (char*)lds);
                    }
                    if (need_ctx) {
                        for (int id = li; id < 24; id += nl) {
                            const int na = id / 12, rem = id % 12, b = rem / 6, h = rem % 6; const long q0 = (long)ML + b * CTXL;
                            const int cq = na ? CNQ + h * 64 : CGQ + h * 64, ck = na ? CNK + h * 64 : CGK + (h / 3) * 64, cv = na ? CNV + h * 64 : CGV + (h / 3) * 64, co = (na ? 640 : 256) + h * 64;
                            attn_body::attn_unit<8, false>(QK + q0 * QKVP + cq, QK + ck, QK + cv, MIX + q0 * DM + co, (int)q0, 4, (int)q0, 4, nap0, (char*)lds);
                        }
                    }
                }
            } else if ((sub == 5 || sub == 8) && (PHMASK & 64)) {
                const int Mr = need_ctx ? MT : ML;
                if (sub == 5) { pg8::Gemm g{Hb, (const bf16r*)(ws + WS_WOUT) + (size_t)l * DM * DM, Mr, DM, DM}; pg8::StaticOrder S; S.init(Mr, DM, G, bx);
                    EpiRes E{out, xctx, modl + 2 * DM, dryp}; pg8::gemm_phase<EpiRes, pg8::StaticOrder, true, true>(L, g, S, E); }
                else { pg8::Gemm g{HH, (const bf16r*)(ws + WS_WF2) + (size_t)l * DM * FFH, Mr, DM, FFH}; pg8::StaticOrder S; S.init(Mr, DM, G, bx);
                    EpiRes E{out, xctx, modl + 5 * DM, dryp}; pg8::gemm_phase<EpiRes, pg8::StaticOrder, true, true>(L, g, S, E); }
            } else if ((sub == 6 || sub == 9) && (PHMASK & 128)) {
                const int which = sub == 6 ? 0 : 1; const int Mr = need_ctx ? MT : ML;
                const float* lg = args.in[15] + (size_t)(l * 2 + which) * DM; const float* lbv = args.in[16] + (size_t)(l * 2 + which) * DM;
                const bool wantH = (which == 0) || (l + 1 < DEPTH);
                const float* mdn = which == 0 ? modl + 3 * DM : MODS + (size_t)(l + 1) * 3 * NMOD;
                for (int r = gw; r < (dryp ? 0 : Mr); r += NGW) {
                    float* xp = xrow_ptr(out, xctx, r); f32x4 v[4]; float sm = 0.f;
#pragma unroll
                    for (int j = 0; j < 4; ++j) { v[j] = *(const f32x4*)(xp + 4 * lane + 256 * j); sm += (v[j][0] + v[j][1]) + (v[j][2] + v[j][3]); }
                    const float mean = wave_sum(sm) * (1.f / DM); float s2 = 0.f;
#pragma unroll
                    for (int j = 0; j < 4; ++j) { v[j] = v[j] - mean; s2 += (v[j][0] * v[j][0] + v[j][1] * v[j][1]) + (v[j][2] * v[j][2] + v[j][3] * v[j][3]); }
                    const float rstd = 1.f / sqrtf(wave_sum(s2) * (1.f / DM) + LN_EPS);
                    const float* md = mdn + seg_of_row(r) * NMOD;
#pragma unroll
                    for (int j = 0; j < 4; ++j) { const int c = 4 * lane + 256 * j; const f32x4 y = v[j] * rstd * *(const f32x4*)(lg + c) + *(const f32x4*)(lbv + c); *(f32x4*)(xp + c) = y;
                        if (wantH) { const f32x4 sh = *(const f32x4*)(md + c), scv = *(const f32x4*)(md + DM + c); const f32x4 h = y * (scv + 1.f) + sh;
                            u32x2 w; w.x = pk_bf16(h[0], h[1]); w.y = pk_bf16(h[2], h[3]); *(u32x2*)(Hb + (size_t)r * DM + c) = w; } }
                }
            } else if (sub == 7 && (PHMASK & 256)) {
                const int Mr = need_ctx ? MT : ML;
                pg8::Gemm g{Hb, (const bf16r*)(ws + WS_WF1) + (size_t)l * FF2 * DM, Mr, FF2, DM}; pg8::StaticOrder S; S.init(Mr, FF2, G, bx);
                EpiSwiglu E{HH}; pg8::gemm_phase<EpiSwiglu, pg8::StaticOrder, true, true>(L, g, S, E);
            }
        }
        if (rep_this && !second_) { second_ = true; --ph; GRID_SEAM(); continue; }
        second_ = false;
        if (ph + 1 < args.ph_hi) { GRID_SEAM(); for (int x_ = 0; x_ < EXTRA_SYNCS; ++x_) GRID_SEAM(); }
    }
}

constexpr int N_PHASES = 2 + NSUB * DEPTH;
extern "C" void kernel_launch(void* const* d_in, const int* in_sizes, int n_in, void* d_out, int out_size, void* d_ws, size_t ws_size, hipStream_t stream) {
    static int grid = 0;
    if (grid == 0) {
        if (n_in != 17 || out_size != ML * DM || ws_size < WS_END) { fprintf(stderr, "kernel_launch: unexpected shapes (n_in %d out %d ws %zu)\n", n_in, out_size, ws_size); grid = -1; return; }
        int dev = 0, cus = 0, per_cu = 0;
        hipGetDevice(&dev); hipDeviceGetAttribute(&cus, hipDeviceAttributeMultiprocessorCount, dev);
        if (hipFuncSetAttribute((const void*)hybrid_fwd, hipFuncAttributeMaxDynamicSharedMemorySize, LDS_BYTES) != hipSuccess) { fprintf(stderr, "kernel_launch: hipFuncSetAttribute failed\n"); grid = -1; return; }
        if (hipOccupancyMaxActiveBlocksPerMultiprocessor(&per_cu, (const void*)hybrid_fwd, 512, LDS_BYTES) != hipSuccess || per_cu < 1) { fprintf(stderr, "kernel_launch: occupancy query says %d\n", per_cu); (void)hipGetLastError(); grid = -1; return; }
        grid = cus;
    }
    if (grid < 0) return;
    if (hipMemsetAsync((char*)d_ws + WS_BAR, 0, BAR_ZERO_BYTES, stream) != hipSuccess) { fprintf(stderr, "kernel_launch: memset failed\n"); return; }
    Args a{};
    for (int i = 0; i < 17; ++i) a.in[i] = (const float*)d_in[i];
    a.out = (float*)d_out; a.ws = (unsigned char*)d_ws;
#if MK_N_LAUNCHES == 1
    a.ph_lo = 0; a.ph_hi = N_PHASES;
    void* kargs[] = {&a};
    hipError_t e = hipLaunchCooperativeKernel((const void*)hybrid_fwd, dim3(grid), dim3(512), kargs, LDS_BYTES, stream);
    if (e != hipSuccess) fprintf(stderr, "cooperative launch failed: %s (grid %d)\n", hipGetErrorString(e), grid);
#else
    for (int p = 0; p < N_PHASES; ++p) { a.ph_lo = p; a.ph_hi = p + 1; hipLaunchKernelGGL(hybrid_fwd, dim3(grid), dim3(512), LDS_BYTES, stream, a); }
#endif
}
```

```cpp
#include <hip/hip_runtime.h>
#include <cstdio>
#include <cstdint>
namespace pg8 {
#define PG8_LAS __attribute__((address_space(3)))
typedef unsigned short bf16_t;
typedef short bf16x8 __attribute__((ext_vector_type(8)));
typedef float f32x4 __attribute__((ext_vector_type(4)));
typedef unsigned u32x4 __attribute__((ext_vector_type(4)));
constexpr int BM = 256, BK = 64, HALF = 128, HTB = HALF * BK * 2  , STAGE_BYTES = 8 * HTB, NXCD = 8, WGM = 8;

__host__ __device__ __forceinline__ int lds_byte(int r, int c) { const int st = (r >> 4) * 2 + (c >> 5), rr = r & 15, cc = c & 31, ob = rr * 64 + cc * 2; return st * 1024 + (ob ^ (((ob >> 9) & 1) << 5)); }
__host__ __device__ __forceinline__ void stage_rc(int b, int& R, int& C) { const int st = b / 1024, sb = b % 1024, swz = sb ^ (((sb >> 9) & 1) << 5); R = (st >> 1) * 16 + swz / 64; C = (st & 1) * 32 + (swz % 64) / 2; }
__host__ __device__ __forceinline__ int perm32(int rho) { const int n = rho >> 4, i = rho & 15; return 8 * (i >> 2) + 4 * n + (i & 3); }

struct Unit { int pm, pn; };
struct Gemm { const bf16_t* A; const bf16_t* Bt; int M, N, K; };

struct StaticOrder {
    int nM, nN, nwg, G, c;
    __host__ __device__ void init(int M, int N, int G_, int c_) { nM = M / BM; nN = N / BM; nwg = nM * nN; G = G_; c = c_; }
    __host__ __device__ bool next(int i, Unit& u) const {
        const long L = (long)i * G + c; if (L >= nwg) return false;
        int wgid = (int)L; { const int q = nwg / NXCD, r = nwg % NXCD, xcd = wgid % NXCD, off = wgid / NXCD; wgid = (xcd < r ? xcd * (q + 1) : r * (q + 1) + (xcd - r) * q) + off; }
        const int nig = WGM * nN, gid = wgid / nig, fm = gid * WGM, gsz = (nM - fm) < WGM ? (nM - fm) : WGM;
        u.pm = fm + ((wgid % nig) % gsz); u.pn = (wgid % nig) / gsz; return true;
    }
    __device__ __forceinline__ void a_ready(const Unit&) const {}
    __device__ __forceinline__ void done(const Unit&) const {}
};

__device__ __forceinline__ unsigned cvt_pk_bf16(float lo, float hi) { unsigned r; asm volatile("v_cvt_pk_bf16_f32 %0, %1, %2" : "=v"(r) : "v"(lo), "v"(hi)); return r; }
typedef float f32x2 __attribute__((ext_vector_type(2)));
__device__ __forceinline__ f32x2 gelu_pk(f32x2 v) {
    const f32x2 av = __builtin_elementwise_abs(v), d = av * 0.2316418882f + 1.0f;
    f32x2 t; t.x = __builtin_amdgcn_rcpf(d.x); t.y = __builtin_amdgcn_rcpf(d.y);
    f32x2 q = t * 0.5307027145f + (-0.7265760135f); q = q * t + 0.7107068705f; q = q * t + (-0.142248368f); q = q * t + 0.127414796f; q = q * t;
    const f32x2 s = (v * v) * (-0.72134752044f);
    f32x2 e; e.x = __builtin_amdgcn_exp2f(s.x); e.y = __builtin_amdgcn_exp2f(s.y);
    const f32x2 m = v * (q * e), r = v - m;
    f32x2 o; o.x = v.x < 0.f ? m.x : r.x; o.y = v.y < 0.f ? m.y : r.y; return o;
}

template <int ACT  > struct EpiBf16 {
    static constexpr bool PERM = true, AFTER_DRAIN = false; static_assert(ACT == 0 || ACT == 1, "EpiBf16: ACT is 0 (none) or 1 (gelu_pk)");
    bf16_t* O; int ldc; const float* bias; int split_cols; size_t split_stride; float scale0;
    __device__ __forceinline__ void operator()(const f32x4 (&acc)[2][2][4][2], const Unit& u, int wr, int wc, int fr, int fq) const {
        const int row0 = u.pm * BM + wr * 64 + fr; int colt = u.pn * BM; bf16_t* base = O;
        float sc = 1.f; if (split_cols) { const int t = colt / split_cols; base += (size_t)t * split_stride; colt -= t * split_cols; if (t == 0) sc = scale0; }
        const int col0 = colt + wc * 32 + 8 * fq, bcol0 = u.pn * BM + wc * 32 + 8 * fq;
        f32x4 bv[2][2];
#pragma unroll
        for (int bj = 0; bj < 2; ++bj)
#pragma unroll
            for (int n = 0; n < 2; ++n) bv[bj][n] = bias ? *(const f32x4*)(bias + bcol0 + bj * HALF + 4 * n) : (f32x4){0.f, 0.f, 0.f, 0.f};
#pragma unroll
        for (int ai = 0; ai < 2; ++ai)
#pragma unroll
            for (int m = 0; m < 4; ++m) { bf16_t* rowp = base + (size_t)(row0 + ai * HALF + m * 16) * ldc + col0;
#pragma unroll
                for (int bj = 0; bj < 2; ++bj) { f32x4 v0 = acc[ai][bj][m][0] + bv[bj][0], v1 = acc[ai][bj][m][1] + bv[bj][1];
                    if (ACT == 1) { f32x2 a = gelu_pk((f32x2){v0[0], v0[1]}), b = gelu_pk((f32x2){v0[2], v0[3]}), c = gelu_pk((f32x2){v1[0], v1[1]}), d = gelu_pk((f32x2){v1[2], v1[3]});
                        v0 = (f32x4){a.x, a.y, b.x, b.y}; v1 = (f32x4){c.x, c.y, d.x, d.y}; }
                    v0 = v0 * sc; v1 = v1 * sc; u32x4 w; w.x = cvt_pk_bf16(v0[0], v0[1]); w.y = cvt_pk_bf16(v0[2], v0[3]); w.z = cvt_pk_bf16(v1[0], v1[1]); w.w = cvt_pk_bf16(v1[2], v1[3]);
                    *(u32x4*)(rowp + bj * HALF) = w; } }
    }
};

struct PanelStats {
    unsigned* xbuf;
    unsigned* cnt;
    unsigned* tmo;
    int ntn; float eps;
    unsigned code;
    __device__ __forceinline__ bool run(const f32x4 (&v)[2][2][4][2], const Unit& u, int wr, int wc, int fr, int fq, PG8_LAS unsigned char* lds, int wid, int lane) const {
        typedef float f32x2v __attribute__((ext_vector_type(2)));
        PG8_LAS f32x2v* P = (PG8_LAS f32x2v*)lds;
        PG8_LAS f32x2v* S = (PG8_LAS f32x2v*)(lds + 8192);
        PG8_LAS unsigned* flag = (PG8_LAS unsigned*)(lds + 8192 + 2048);
#pragma unroll
        for (int ai = 0; ai < 2; ++ai)
#pragma unroll
            for (int m = 0; m < 4; ++m) {
                float s = 0.f;
#pragma unroll
                for (int bj = 0; bj < 2; ++bj)
#pragma unroll
                    for (int n = 0; n < 2; ++n) { const f32x4 x = v[ai][bj][m][n]; s += (x[0] + x[1]) + (x[2] + x[3]); }
                s += __shfl_xor(s, 16); s += __shfl_xor(s, 32);
                const float mw = s * (1.0f / 64.0f); float q = 0.f;
#pragma unroll
                for (int bj = 0; bj < 2; ++bj)
#pragma unroll
                    for (int n = 0; n < 2; ++n) { const f32x4 d = v[ai][bj][m][n] - mw; q += (d[0] * d[0] + d[1] * d[1]) + (d[2] * d[2] + d[3] * d[3]); }
                q += __shfl_xor(q, 16); q += __shfl_xor(q, 32);
                if (fq == 0) P[(ai * HALF + wr * 64 + m * 16 + fr) * 4 + wc] = (f32x2v){mw, q};
            }
        asm volatile("s_waitcnt lgkmcnt(0)" ::: "memory"); __builtin_amdgcn_s_barrier(); asm volatile("" ::: "memory");
#if defined(BROKEN_EXCHANGE_NO_WAIT)
#warning BROKEN CONTROL BUILD: the row-statistics exchange does not wait; results are wrong by design
        if (blockIdx.x >= 64) { const long long t0_ = clock64(); while (clock64() - t0_ < 60000) __builtin_amdgcn_s_sleep(8); }
#endif
        const int row = wid * 32 + (lane & 31);
        if (lane < 32) {
            const f32x2v a = P[row * 4 + 0], b = P[row * 4 + 1], c = P[row * 4 + 2], d = P[row * 4 + 3];
            const float mt = (a.x + b.x + c.x + d.x) * 0.25f;
            const float da = a.x - mt, db = b.x - mt, dc = c.x - mt, dd = d.x - mt;
            const float m2 = (a.y + b.y) + (c.y + d.y) + 64.0f * ((da * da + db * db) + (dc * dc + dd * dd));
            unsigned long long* slot = (unsigned long long*)xbuf + ((size_t)(u.pm * BM + row) * 4 + u.pn);
            __hip_atomic_store(slot, ((unsigned long long)__float_as_uint(m2) << 32) | __float_as_uint(mt), __ATOMIC_RELAXED, __HIP_MEMORY_SCOPE_AGENT);
        }
        asm volatile("s_waitcnt vmcnt(0)" ::: "memory");
        if (lane == 0) __hip_atomic_fetch_add(cnt + 64 * u.pm, 1u, __ATOMIC_RELAXED, __HIP_MEMORY_SCOPE_AGENT);
        if (wid == 0) {
            bool dead = false; const unsigned long long t0 = __builtin_amdgcn_s_memrealtime(); const unsigned want = 8u * (unsigned)ntn;
            for (;;) {
#if defined(BROKEN_EXCHANGE_NO_WAIT)
                break;
#endif
                if ((unsigned)__builtin_amdgcn_readfirstlane(__hip_atomic_load(cnt + 64 * u.pm, __ATOMIC_RELAXED, __HIP_MEMORY_SCOPE_AGENT)) >= want) break;
                if (__builtin_amdgcn_s_memrealtime() - t0 > 2000000ull) {
                    if (lane == 0) { unsigned expect = 0u; __hip_atomic_compare_exchange_strong(tmo + 1, &expect, code | (unsigned)(u.pm & 0xff), __ATOMIC_RELAXED, __ATOMIC_RELAXED, __HIP_MEMORY_SCOPE_AGENT);
                                     __hip_atomic_store(tmo, 1u, __ATOMIC_RELAXED, __HIP_MEMORY_SCOPE_AGENT); }
                    dead = true; break; }
                __builtin_amdgcn_s_sleep(2);
            }
            __builtin_amdgcn_fence(__ATOMIC_ACQUIRE, "agent");
            if (lane == 0) flag[0] = dead ? 1u : 0u;
        }
        asm volatile("s_waitcnt vmcnt(0) lgkmcnt(0)" ::: "memory"); __builtin_amdgcn_s_barrier(); asm volatile("" ::: "memory");
        const bool bad = flag[0] != 0u;
        if (lane < 32) {
            const unsigned long long* slot = (const unsigned long long*)xbuf + (size_t)(u.pm * BM + row) * 4; float mt[4], m2[4]; float ms = 0.f;
#pragma unroll
            for (int t = 0; t < 4; ++t) { if (t < ntn) { const unsigned long long w = __hip_atomic_load(slot + t, __ATOMIC_RELAXED, __HIP_MEMORY_SCOPE_AGENT); mt[t] = __uint_as_float((unsigned)w); m2[t] = __uint_as_float((unsigned)(w >> 32)); } else { mt[t] = 0.f; m2[t] = 0.f; } ms += mt[t]; }
            const float mean = ms / (float)ntn; float q = 0.f;
#pragma unroll
            for (int t = 0; t < 4; ++t) if (t < ntn) { const float dm = mt[t] - mean; q += m2[t] + 256.0f * dm * dm; }
            S[row] = (f32x2v){mean, 1.0f / sqrtf(q / (256.0f * (float)ntn) + eps)};
        }
        asm volatile("s_waitcnt lgkmcnt(0)" ::: "memory"); __builtin_amdgcn_s_barrier(); asm volatile("" ::: "memory");
        return bad;
    }
};
struct EpiLnRes {
    static constexpr bool PERM = false, AFTER_DRAIN = true;
    const float* base; float* out; int ldc; const float* bias; PanelStats st; unsigned poison;
    __device__ __forceinline__ void fused(f32x4 (&acc)[2][2][4][2], const Unit& u, int wr, int wc, int fr, int fq, PG8_LAS unsigned char* lds, int wid, int lane) const {
        typedef float f32x2v __attribute__((ext_vector_type(2)));
        const PG8_LAS f32x2v* S = (const PG8_LAS f32x2v*)(lds + 8192);
        const int col0 = u.pn * BM + wc * 32 + 4 * fq;
#pragma unroll
        for (int bj = 0; bj < 2; ++bj)
#pragma unroll
            for (int n = 0; n < 2; ++n) { const f32x4 bv = bias ? *(const f32x4*)(bias + col0 + bj * HALF + n * 16) : (f32x4){0.f, 0.f, 0.f, 0.f};
#pragma unroll
                for (int ai = 0; ai < 2; ++ai)
#pragma unroll
                    for (int m = 0; m < 4; ++m) acc[ai][bj][m][n] += bv; }
        f32x4 pre[4][2][2];
#pragma unroll
        for (int m = 0; m < 4; ++m) { const size_t off = (size_t)(u.pm * BM + wr * 64 + m * 16 + fr) * ldc + col0;
#pragma unroll
            for (int bj = 0; bj < 2; ++bj)
#pragma unroll
                for (int n = 0; n < 2; ++n) pre[m][bj][n] = *(const f32x4*)(base + off + bj * HALF + n * 16); }
        const bool bad = st.run(acc, u, wr, wc, fr, fq, lds, wid, lane) || poison != 0u;
        const float qnan = __builtin_nanf("");
#pragma unroll
        for (int ai = 0; ai < 2; ++ai)
#pragma unroll
            for (int m = 0; m < 4; ++m) { const int r = ai * HALF + wr * 64 + m * 16 + fr; const f32x2v sr = S[r]; const size_t off = (size_t)(u.pm * BM + r) * ldc + col0;
#pragma unroll
                for (int bj = 0; bj < 2; ++bj)
#pragma unroll
                    for (int n = 0; n < 2; ++n) { const f32x4 bs = ai == 0 ? pre[m][bj][n] : *(const f32x4*)(base + off + bj * HALF + n * 16); f32x4 o = bs + (acc[ai][bj][m][n] - sr.x) * sr.y;
                        if (bad) o = (f32x4){qnan, qnan, qnan, qnan}; *(f32x4*)(out + off + bj * HALF + n * 16) = o; }
                if (m & 1) asm volatile("" ::: "memory"); }
    }
};
struct EpiLnResLn {
    static constexpr bool PERM = false, AFTER_DRAIN = true;
    const float* base; float* out; bf16_t* xn; int ldc; const float* bias; PanelStats st1, st2; unsigned poison;
    __device__ __forceinline__ void fused(f32x4 (&acc)[2][2][4][2], const Unit& u, int wr, int wc, int fr, int fq, PG8_LAS unsigned char* lds, int wid, int lane) const {
        typedef float f32x2v __attribute__((ext_vector_type(2))); typedef unsigned u32x2v __attribute__((ext_vector_type(2)));
        const PG8_LAS f32x2v* S = (const PG8_LAS f32x2v*)(lds + 8192);
        const int col0 = u.pn * BM + wc * 32 + 4 * fq;
#pragma unroll
        for (int bj = 0; bj < 2; ++bj)
#pragma unroll
            for (int n = 0; n < 2; ++n) { const f32x4 bv = bias ? *(const f32x4*)(bias + col0 + bj * HALF + n * 16) : (f32x4){0.f, 0.f, 0.f, 0.f};
#pragma unroll
                for (int ai = 0; ai < 2; ++ai)
#pragma unroll
                    for (int m = 0; m < 4; ++m) acc[ai][bj][m][n] += bv; }
        bool bad = st1.run(acc, u, wr, wc, fr, fq, lds, wid, lane) || poison != 0u;
        const float qnan = __builtin_nanf("");
#pragma unroll
        for (int ai = 0; ai < 2; ++ai)
#pragma unroll
            for (int m = 0; m < 4; ++m) { const int r = ai * HALF + wr * 64 + m * 16 + fr; const f32x2v sr = S[r]; const size_t off = (size_t)(u.pm * BM + r) * ldc + col0;
#pragma unroll
                for (int bj = 0; bj < 2; ++bj)
#pragma unroll
                    for (int n = 0; n < 2; ++n) { const f32x4 bs = *(const f32x4*)(base + off + bj * HALF + n * 16); acc[ai][bj][m][n] = bs + (acc[ai][bj][m][n] - sr.x) * sr.y; }
                asm volatile("" : "+v"(acc[ai][0][m][0]), "+v"(acc[ai][0][m][1]), "+v"(acc[ai][1][m][0]), "+v"(acc[ai][1][m][1]));
                if (m & 1) asm volatile("" ::: "memory"); }
        const bool bad1 = bad;
        bad = st2.run(acc, u, wr, wc, fr, fq, lds, wid, lane) || bad;
#pragma unroll
        for (int ai = 0; ai < 2; ++ai)
#pragma unroll
            for (int m = 0; m < 4; ++m) { const int r = ai * HALF + wr * 64 + m * 16 + fr; const f32x2v sr = S[r]; const size_t off = (size_t)(u.pm * BM + r) * ldc + col0;
#pragma unroll
                for (int bj = 0; bj < 2; ++bj)
#pragma unroll
                    for (int n = 0; n < 2; ++n) { const f32x4 x1 = acc[ai][bj][m][n]; *(f32x4*)(out + off + bj * HALF + n * 16) = bad1 ? (f32x4){qnan, qnan, qnan, qnan} : x1;
                        const f32x4 o = (x1 - sr.x) * sr.y; u32x2v w; w.x = cvt_pk_bf16(o[0], o[1]); w.y = cvt_pk_bf16(o[2], o[3]);
                        if (bad) { w.x = 0x7fc07fc0u; w.y = 0x7fc07fc0u; } *(u32x2v*)(xn + off + bj * HALF + n * 16) = w; }
                asm volatile("" ::: "memory"); }
    }
};

template <class Epi, class Sched, bool ALIGN_EPI = false, bool SP2 = false>
__device__ __forceinline__ void gemm_phase(PG8_LAS unsigned char* lds, const Gemm g, const Sched& S, const Epi& E) {
    int tid_l = threadIdx.x; asm volatile("" : "+v"(tid_l));
    const int tid = tid_l, wid = __builtin_amdgcn_readfirstlane(tid >> 6), lane = tid & 63, wr = wid >> 2, wc = wid & 3, fr = lane & 15, fq = lane >> 4;
    const int K = g.K, nt = K / BK;
    unsigned voffA[2], voffB[2];
#pragma unroll
    for (int i = 0; i < 2; ++i) { int R, C; stage_rc(tid * 16 + i * 8192, R, C); const int Rb = Epi::PERM ? ((R & ~31) + perm32(R & 31)) : R;
        voffA[i] = (unsigned)(R * K + C) * 2u; voffB[i] = (unsigned)(Rb * K + C) * 2u; }
    const size_t kstep = (size_t)(BK * 2);
    const size_t hstep = (size_t)HALF * K * 2;
    const size_t tstep = 2 * hstep;
    const unsigned ldsw = (unsigned)wid * 1024u;
    const int aoff = lds_byte(wr * 64 + fr, fq * 8), boff = lds_byte(wc * 32 + fr, fq * 8);
#define PG8_SA(b, h) (((b) * 2 + (h)) * HTB)
#define PG8_SB(b, h) ((4 + (b) * 2 + (h)) * HTB)
#define PG8_STAGE(bufoff, gbase, voff) do { _Pragma("unroll") for (int _i = 0; _i < 2; ++_i) \
        __builtin_amdgcn_global_load_lds((const unsigned*)((const char*)(gbase) + (voff)[_i]), (PG8_LAS unsigned*)(lds + (bufoff) + ldsw + _i * 8192), 16, 0, 0); } while (0)
#define PG8_LDA(dst, b, h) do { _Pragma("unroll") for (int m = 0; m < 4; ++m) _Pragma("unroll") for (int k = 0; k < 2; ++k) dst[m][k] = *(const PG8_LAS bf16x8*)(lds + PG8_SA(b, h) + aoff + m * 2048 + k * 1024); } while (0)
#define PG8_LDB(dst, b, h) do { _Pragma("unroll") for (int n = 0; n < 2; ++n) _Pragma("unroll") for (int k = 0; k < 2; ++k) dst[n][k] = *(const PG8_LAS bf16x8*)(lds + PG8_SB(b, h) + boff + n * 2048 + k * 1024); } while (0)
#define PG8_MMA(ai, bj, At, Bt) do { __builtin_amdgcn_s_setprio(1); _Pragma("unroll") for (int m = 0; m < 4; ++m) _Pragma("unroll") for (int n = 0; n < 2; ++n) _Pragma("unroll") for (int k = 0; k < 2; ++k) \
        acc[ai][bj][m][n] = __builtin_amdgcn_mfma_f32_16x16x32_bf16(Bt[n][k], At[m][k], acc[ai][bj][m][n], 0, 0, 0); __builtin_amdgcn_s_setprio(0); } while (0)
#define PG8_WAIT_V(n) asm volatile("s_waitcnt vmcnt(" #n ")" ::: "memory")
#define PG8_WAIT_L(n) asm volatile("s_waitcnt lgkmcnt(" #n ")" ::: "memory")
#define PG8_BAR __builtin_amdgcn_s_barrier()
#define PG8_SCHED __builtin_amdgcn_sched_barrier(0)
    Unit cur, nxt; int ui = 0;
    if (!S.next(0, cur)) return;
    f32x4 acc[2][2][4][2];
#pragma unroll
    for (int a = 0; a < 2; ++a)
#pragma unroll
        for (int b = 0; b < 2; ++b)
#pragma unroll
            for (int m = 0; m < 4; ++m)
#pragma unroll
                for (int n = 0; n < 2; ++n) acc[a][b][m][n] = (f32x4){0.f, 0.f, 0.f, 0.f};
    bf16x8 At[4][2], B0[2][2], B1[2][2];
    const char* cA = (const char*)g.A + (size_t)cur.pm * tstep; const char* cB = (const char*)g.Bt + (size_t)cur.pn * tstep;
    S.a_ready(cur);
    if constexpr (SP2) {
        PG8_STAGE(PG8_SB(0, 0), cB, voffB); PG8_STAGE(PG8_SB(0, 1), cB + hstep, voffB); PG8_STAGE(PG8_SA(0, 0), cA, voffA); PG8_STAGE(PG8_SA(0, 1), cA + hstep, voffA);
        if (wr == 1) PG8_BAR;
        PG8_WAIT_V(2); PG8_BAR;
        PG8_STAGE(PG8_SB(1, 0), cB + kstep, voffB); PG8_STAGE(PG8_SA(1, 0), cA + kstep, voffA); PG8_STAGE(PG8_SB(1, 1), cB + hstep + kstep, voffB);
        PG8_WAIT_V(6); PG8_BAR;
    } else {
        PG8_STAGE(PG8_SB(0, 0), cB, voffB); PG8_STAGE(PG8_SA(0, 0), cA, voffA); PG8_STAGE(PG8_SB(0, 1), cB + hstep, voffB); PG8_STAGE(PG8_SA(0, 1), cA + hstep, voffA);
        if (wr == 1) PG8_BAR;
        PG8_WAIT_V(4); PG8_BAR;
        PG8_STAGE(PG8_SB(1, 0), cB + kstep, voffB); PG8_STAGE(PG8_SA(1, 0), cA + kstep, voffA); PG8_STAGE(PG8_SB(1, 1), cB + hstep + kstep, voffB);
        PG8_WAIT_V(6); PG8_BAR;
    }
    for (;;) {
        const bool has_next = S.next(ui + 1, nxt);
        const char* nA = has_next ? (const char*)g.A + (size_t)nxt.pm * tstep : cA; const char* nB = has_next ? (const char*)g.Bt + (size_t)nxt.pn * tstep : cB;
        for (int t = 0; t < nt; t += 2) {
            const bool last = (t == nt - 2);
            const char* a1 = cA + (size_t)(t + 1) * kstep;
            const char* a2 = last ? nA : cA + (size_t)(t + 2) * kstep; const char* b2 = last ? nB : cB + (size_t)(t + 2) * kstep;
            const char* a3 = a2 + kstep; const char* b3 = b2 + kstep;
            if (last && has_next) S.a_ready(nxt);
            if constexpr (SP2) {
            PG8_LDB(B0, 0, 0); PG8_LDB(B1, 0, 1); PG8_SCHED; PG8_LDA(At, 0, 0); PG8_STAGE(PG8_SA(1, 1), a1 + hstep, voffA);
            PG8_WAIT_V(8); PG8_WAIT_L(0); PG8_BAR; PG8_MMA(0, 0, At, B0); PG8_MMA(0, 1, At, B1); PG8_BAR; PG8_SCHED;
            PG8_LDA(At, 0, 1); PG8_STAGE(PG8_SB(0, 0), b2, voffB); PG8_STAGE(PG8_SB(0, 1), b2 + hstep, voffB); PG8_STAGE(PG8_SA(0, 0), a2, voffA);
            PG8_WAIT_V(8); PG8_WAIT_L(0); PG8_BAR; PG8_MMA(1, 0, At, B0); PG8_MMA(1, 1, At, B1); PG8_BAR; PG8_SCHED;
            PG8_LDB(B0, 1, 0); PG8_LDB(B1, 1, 1); PG8_SCHED; PG8_LDA(At, 1, 0); PG8_STAGE(PG8_SA(0, 1), a2 + hstep, voffA);
            PG8_WAIT_V(8); PG8_WAIT_L(0); PG8_BAR; PG8_MMA(0, 0, At, B0); PG8_MMA(0, 1, At, B1); PG8_BAR; PG8_SCHED;
            PG8_LDA(At, 1, 1); PG8_STAGE(PG8_SB(1, 0), b3, voffB); PG8_STAGE(PG8_SB(1, 1), b3 + hstep, voffB); PG8_STAGE(PG8_SA(1, 0), a3, voffA);
            PG8_WAIT_V(8); PG8_WAIT_L(0); PG8_BAR; PG8_MMA(1, 0, At, B0); PG8_MMA(1, 1, At, B1); PG8_BAR; PG8_SCHED;
            } else {
            PG8_LDB(B0, 0, 0); PG8_SCHED; PG8_LDA(At, 0, 0); PG8_STAGE(PG8_SA(1, 1), a1 + hstep, voffA);
            PG8_WAIT_L(8); PG8_BAR; PG8_WAIT_L(0); PG8_MMA(0, 0, At, B0); PG8_BAR; PG8_SCHED;
            PG8_LDB(B1, 0, 1); PG8_STAGE(PG8_SB(0, 0), b2, voffB);
            PG8_BAR; PG8_WAIT_L(0); PG8_MMA(0, 1, At, B1); PG8_BAR;
            PG8_LDA(At, 0, 1); PG8_STAGE(PG8_SA(0, 0), a2, voffA);
            PG8_BAR; PG8_WAIT_L(0); PG8_MMA(1, 0, At, B0); PG8_BAR; PG8_SCHED;
            PG8_STAGE(PG8_SB(0, 1), b2 + hstep, voffB);
            PG8_WAIT_V(6); PG8_BAR; PG8_MMA(1, 1, At, B1); PG8_BAR;
            PG8_LDB(B0, 1, 0); PG8_SCHED; PG8_LDA(At, 1, 0); PG8_STAGE(PG8_SA(0, 1), a2 + hstep, voffA);
            PG8_WAIT_L(8); PG8_BAR; PG8_WAIT_L(0); PG8_MMA(0, 0, At, B0); PG8_BAR; PG8_SCHED;
            PG8_LDB(B1, 1, 1); PG8_STAGE(PG8_SB(1, 0), b3, voffB);
            PG8_BAR; PG8_WAIT_L(0); PG8_MMA(0, 1, At, B1); PG8_BAR;
            PG8_LDA(At, 1, 1); PG8_STAGE(PG8_SA(1, 0), a3, voffA);
            PG8_BAR; PG8_WAIT_L(0); PG8_MMA(1, 0, At, B0); PG8_BAR; PG8_SCHED;
            PG8_STAGE(PG8_SB(1, 1), b3 + hstep, voffB);
            PG8_WAIT_V(6); PG8_BAR; PG8_MMA(1, 1, At, B1); PG8_BAR;
            }
        }
        if constexpr (ALIGN_EPI) { if (wr == 0) PG8_BAR; }
        if constexpr (!Epi::AFTER_DRAIN) { E(acc, cur, wr, wc, fr, fq); S.done(cur); }
        if (!has_next) break;
#pragma unroll
        for (int a = 0; a < 2; ++a)
#pragma unroll
            for (int b = 0; b < 2; ++b)
#pragma unroll
                for (int m = 0; m < 4; ++m)
#pragma unroll
                    for (int n = 0; n < 2; ++n) acc[a][b][m][n] = (f32x4){0.f, 0.f, 0.f, 0.f};
        cur = nxt; cA = nA; cB = nB; ++ui;
        if constexpr (ALIGN_EPI) { if (wr == 1) PG8_BAR; }
    }
    PG8_WAIT_V(0);
    if constexpr (!ALIGN_EPI) { if (wr == 0) PG8_BAR; }
    PG8_BAR;
    if constexpr (Epi::AFTER_DRAIN) { E.fused(acc, cur, wr, wc, fr, fq, lds, wid, lane); S.done(cur); }
#undef PG8_SA
#undef PG8_SB
#undef PG8_STAGE
#undef PG8_LDA
#undef PG8_LDB
#undef PG8_MMA
#undef PG8_WAIT_V
#undef PG8_WAIT_L
#undef PG8_BAR
#undef PG8_SCHED
}
}

#include <hip/hip_bf16.h>
#include <cmath>
namespace attn_body {
using bf16=__hip_bfloat16;
using bf16x8=__attribute__((ext_vector_type(8)))short;
using s16x4=__attribute__((ext_vector_type(4)))short;
using f32x16=__attribute__((ext_vector_type(16)))float;
using u32x4=__attribute__((ext_vector_type(4)))unsigned;
constexpr int D=64;
constexpr int NW=8,QBLK=32,QB=QBLK*NW,KVBLK=64;
__device__ __forceinline__ int crow(int r,int hi){return (r&3)+8*(r>>2)+4*hi;}
#define SBAR() __builtin_amdgcn_sched_barrier(0)

__device__ __forceinline__ void na_mask(f32x16&p0,f32x16&p1,int krow,int gr,int c,int hi,const __attribute__((address_space(3))) float* tab,float mhat){
  const float NEG=-INFINITY;
  asm volatile("":"+v"(hi),"+v"(c));
  int rs=gr-4; rs=rs<0?0:(rs>120?120:rs);
  const bool rowok=(unsigned)(krow-rs)<8u;
  if(!rowok){
    #pragma unroll
    for(int r=0;r<16;++r){p0[r]=NEG;p1[r]=NEG;}
  } else {
    int cs=c-8; cs=cs<0?0:(cs>48?48:cs);
    const int tb=(krow-gr+7)*31-c+15;
    #pragma unroll
    for(int r=0;r<16;++r){
      const int kv=crow(r,hi);
      const bool ok0=(unsigned)(kv-cs)<16u, ok1=(unsigned)(kv+32-cs)<16u;
      const float b0=tab[ok0?(tb+kv):0], b1=tab[ok1?(tb+kv+32):0];
      p0[r]=ok0?(b0-mhat):NEG; p1[r]=ok1?(b1-mhat):NEG;
    }
  }
}
constexpr int NSLOT=3, SLOTB=8192;
constexpr int LDS_K=0, LDS_V=NSLOT*SLOTB, LDS_WS=2*NSLOT*SLOTB, LDS_OST=LDS_WS+NW*64*4, LDS_BYTES=LDS_OST+NW*4096;
constexpr float C2=0.125f*1.4426950408889634f;
__device__ __forceinline__ void glds16(const void*gsrc,unsigned lds_dst){unsigned keep;
  asm volatile("s_mov_b32 %0, m0\n\ts_mov_b32 m0, %2\n\ts_nop 0\n\tglobal_load_lds_dwordx4 %1, off\n\ts_mov_b32 m0, %0":"=&s"(keep):"v"(gsrc),"s"(lds_dst):"memory");}
__device__ __forceinline__ float max3f(float a,float b,float c){float r;asm("v_max3_f32 %0, %1, %2, %3":"=v"(r):"v"(a),"v"(b),"v"(c));return r;}
__device__ __forceinline__ float max2f(float a,float b){float r;asm("v_max_f32_e32 %0, %1, %2":"=v"(r):"v"(a),"v"(b));return r;}
__device__ __forceinline__ float fadd_s(float a,float b){float r;asm("v_add_f32_e32 %0, %1, %2":"=v"(r):"v"(a),"v"(b));return r;}
__device__ __forceinline__ float fsub_s(float a,float b){float r;asm("v_sub_f32_e32 %0, %1, %2":"=v"(r):"v"(a),"v"(b));return r;}
typedef float f32x2_t __attribute__((ext_vector_type(2))); typedef __bf16 bf16x2_t __attribute__((ext_vector_type(2)));
__device__ __forceinline__ unsigned cvtpk_s(float lo,float hi){f32x2_t v={lo,hi};bf16x2_t b=__builtin_convertvector(v,bf16x2_t);return __builtin_bit_cast(unsigned,b);}
#define WAIT_BAR(N) asm volatile("s_waitcnt vmcnt(" #N ") lgkmcnt(0)\n\ts_barrier":::"memory")

__device__ __forceinline__ void qkt(f32x16&p0,f32x16&p1,const char*Kslot,const bf16x8*qr,const f32x16&negm,int r32,int hi){
  const char*kb=Kslot+hi*1024+r32*16;
  #pragma unroll
  for(int d0=0;d0<4;++d0){
    const bf16x8 b0=*reinterpret_cast<const bf16x8*>(kb+d0*2048);
    const bf16x8 b1=*reinterpret_cast<const bf16x8*>(kb+d0*2048+512);
    if(d0==0){p0=__builtin_amdgcn_mfma_f32_32x32x16_bf16(b0,qr[0],negm,0,0,0);p1=__builtin_amdgcn_mfma_f32_32x32x16_bf16(b1,qr[0],negm,0,0,0);}
    else{p0=__builtin_amdgcn_mfma_f32_32x32x16_bf16(b0,qr[d0],p0,0,0,0);p1=__builtin_amdgcn_mfma_f32_32x32x16_bf16(b1,qr[d0],p1,0,0,0);}}
}
typedef __attribute__((address_space(3))) const char* lds_cptr;
typedef short v4i16_t __attribute__((ext_vector_type(4)));
__device__ __forceinline__ void kload8(bf16x8*kf,lds_cptr kp){
  kf[0]=*(const __attribute__((address_space(3))) bf16x8*)(kp);      kf[1]=*(const __attribute__((address_space(3))) bf16x8*)(kp+512);
  kf[2]=*(const __attribute__((address_space(3))) bf16x8*)(kp+2048); kf[3]=*(const __attribute__((address_space(3))) bf16x8*)(kp+2560);
  kf[4]=*(const __attribute__((address_space(3))) bf16x8*)(kp+4096); kf[5]=*(const __attribute__((address_space(3))) bf16x8*)(kp+4608);
  kf[6]=*(const __attribute__((address_space(3))) bf16x8*)(kp+6144); kf[7]=*(const __attribute__((address_space(3))) bf16x8*)(kp+6656);
}
__device__ __forceinline__ void kload2(bf16x8*kf,lds_cptr kp,int j){ kf[2*j]=*(const __attribute__((address_space(3))) bf16x8*)(kp+j*2048); kf[2*j+1]=*(const __attribute__((address_space(3))) bf16x8*)(kp+j*2048+512); }
__device__ __forceinline__ s16x4 vtr(lds_cptr p){ return __builtin_bit_cast(s16x4,__builtin_amdgcn_ds_read_tr16_b64_v4i16((__attribute__((address_space(3))) v4i16_t*)p)); }
__device__ __forceinline__ float rowmax(const f32x16&p0,const f32x16&p1){
  float a=max3f(p0[0],p0[1],p1[0]),b=max3f(p0[2],p0[3],p1[1]);a=max3f(a,p1[2],p1[3]);
  #pragma unroll
  for(int r=4;r<16;r+=4){a=max3f(a,p0[r],p0[r+1]);b=max3f(b,p0[r+2],p0[r+3]);a=max3f(a,p1[r],p1[r+1]);b=max3f(b,p1[r+2],p1[r+3]);}
  const float m=max2f(a,b);
  auto rr=__builtin_amdgcn_permlane32_swap(__float_as_uint(m),__float_as_uint(m),false,false);
  return max2f(__uint_as_float(rr[0]),__uint_as_float(rr[1]));
}
__device__ __forceinline__ void pv(f32x16*o,int vb,bf16x8 pa0,bf16x8 pa1,bf16x8 pa2,bf16x8 pa3){
  #pragma unroll
  for(int d0=0;d0<2;++d0){s16x4 lo[4],hi[4];
    #pragma unroll
    for(int ks=0;ks<4;++ks){
      asm volatile("ds_read_b64_tr_b16 %0,%1 offset:%c2":"=&v"(lo[ks]):"v"(vb),"i"(d0*4096+ks*1024):"memory");
      asm volatile("ds_read_b64_tr_b16 %0,%1 offset:%c2":"=&v"(hi[ks]):"v"(vb),"i"(d0*4096+ks*1024+512):"memory");}
    asm volatile("s_waitcnt lgkmcnt(0)":::"memory");SBAR();
    #define PK(k) (bf16x8){lo[k][0],lo[k][1],lo[k][2],lo[k][3],hi[k][0],hi[k][1],hi[k][2],hi[k][3]}
    o[d0]=__builtin_amdgcn_mfma_f32_32x32x16_bf16(pa0,PK(0),o[d0],0,0,0);
    o[d0]=__builtin_amdgcn_mfma_f32_32x32x16_bf16(pa1,PK(1),o[d0],0,0,0);
    o[d0]=__builtin_amdgcn_mfma_f32_32x32x16_bf16(pa2,PK(2),o[d0],0,0,0);
    o[d0]=__builtin_amdgcn_mfma_f32_32x32x16_bf16(pa3,PK(3),o[d0],0,0,0);
    #undef PK
  }
}

#ifndef ATTN_STORE16
#define ATTN_STORE16(p,v) (*(u32x4*)(p)=(v))
#endif
struct NaP { int gr0; int r_lo; const __attribute__((address_space(3))) float* tab; };
template<int THRL,bool NA> __device__ __forceinline__ void attn_unit(const bf16*Qb,const bf16*Kc,const bf16*Vc,bf16*Ob,int kr0,int T0,int kr1,int NT,NaP nap,char*shm){
  constexpr int QP=1792,KP=1792,VP=1792,OP=1024;
  int tid_l=threadIdx.x; asm volatile("":"+v"(tid_l));
  const int tid=tid_l,lane=tid&63,r32=lane&31,hi=lane>>5; const int wid=__builtin_amdgcn_readfirstlane(tid>>6);
  const bf16*Qw=Qb+(long)(wid*QBLK)*QP;
  const unsigned lds0=(unsigned)(uintptr_t)shm;
  float*wsf=(float*)(shm+LDS_WS)+wid*64;
  const bf16*ksrc=Kc+(long)lane*KP+wid*8;
  const bf16*vsrc=Vc+(long)(16*(wid&3)+(lane>>2))*VP+(wid>>2)*32+(lane&3)*8;
  const unsigned kdst=lds0+LDS_K+wid*1024, vdst=lds0+LDS_V+wid*1024;
  #define KROW(t) ((long)(((t)<T0)?(kr0+(t)*KVBLK):(kr1+((t)-T0)*KVBLK)))
  #define DMA_K(t,slot) glds16(ksrc+KROW(t)*KP,(unsigned)__builtin_amdgcn_readfirstlane(kdst+(slot)))
  #define DMA_V(t,slot) glds16(vsrc+KROW(t)*VP,(unsigned)__builtin_amdgcn_readfirstlane(vdst+(slot)))
  const int vb0=(int)(lds0+LDS_V)+((lane>>4)&1)*32+(lane&3)*8+(4*hi+((lane&15)>>2))*64;
  const char*Kbase=shm+LDS_K; bf16x8 kf[8];
  const lds_cptr shm3=(lds_cptr)shm; const lds_cptr kp0=shm3+LDS_K+hi*1024+r32*16; const lds_cptr vp0=shm3+LDS_V+((lane>>4)&1)*32+(lane&3)*8+(4*hi+((lane&15)>>2))*64;
  DMA_K(0,0);DMA_V(0,0);DMA_K(1,SLOTB);
  bf16x8 qr[4];
  #pragma unroll
  for(int d0=0;d0<4;++d0)qr[d0]=*reinterpret_cast<const bf16x8*>(&Qw[(long)r32*QP+d0*16+hi*8]);
  float mhat=0.f,l_reg=0.f;f32x16 o[2];o[0]=f32x16{};o[1]=f32x16{};f32x16 negm=f32x16{};if(!NA)asm volatile("":"+v"(negm));
  #define CMASK(P0,P1,t) do{}while(0)
  #define NAFILL(C0,C1,t) do{ if(NA){ if((t)>=T0) na_mask(C0,C1,nap.r_lo+((t)-T0),nap.gr0+(wid>>1),(wid&1)*32+r32,hi,nap.tab,mhat); else { _Pragma("unroll") for(int r_=0;r_<16;++r_){C0[r_]=-mhat;C1[r_]=-mhat;} } } }while(0)
  bool resc=false;
  #define START(P0,P1) do{ const float rm=rowmax(P0,P1); resc=false; \
    { const float dl=rm; mhat=fadd_s(mhat,dl); \
      _Pragma("unroll") for(int r=0;r<16;++r){P0[r]=fsub_s(P0[r],dl);P1[r]=fsub_s(P1[r],dl);} \
      if(!NA){ _Pragma("unroll") for(int r=0;r<16;++r)negm[r]=-mhat; asm volatile("":"+v"(negm)); } } \
    _Pragma("unroll") for(int r=0;r<16;++r)P0[r]=__builtin_amdgcn_exp2f(P0[r]); }while(0)
  #define RESC() do{ if(resc){ asm volatile("s_waitcnt lgkmcnt(0)":::"memory"); \
      _Pragma("unroll") for(int d_=0;d_<2;++d_) _Pragma("unroll") for(int r=0;r<16;++r)o[d_][r]*=wsf[crow(r,hi)]; } }while(0)
  f32x16 pA0,pA1,pB0,pB1;
  int sl_prev=0,sl_cur=0,sl_next=SLOTB;
  #define ROT() do{sl_prev=sl_cur;sl_cur=sl_next;sl_next=(sl_next==(NSLOT-1)*SLOTB)?0:sl_next+SLOTB;}while(0)
  DMA_K(2,2*SLOTB);
  WAIT_BAR(3);
  qkt(pA0,pA1,Kbase,qr,negm,r32,hi);asm volatile("s_nop 15\n\ts_nop 7":"+v"(pA0),"+v"(pA1));CMASK(pA0,pA1,0);
  START(pA0,pA1);
  _Pragma("unroll") for(int r=0;r<16;++r)pA1[r]=__builtin_amdgcn_exp2f(pA1[r]);
  WAIT_BAR(0);
  DMA_K(3,0);DMA_V(1,SLOTB);
  ROT();
  kload8(kf,kp0+sl_cur);
  WAIT_BAR(2);
  s16x4 vlo[8],vhi[8]; u32x4 pw0,pw1,pw2,pw3;
  #define PKW(P,B) cvtpk_s(P[B],P[B+1])
  #define PAF(k) __builtin_bit_cast(bf16x8,pw##k)
  #define VFR(i) (bf16x8){vlo[i][0],vlo[i][1],vlo[i][2],vlo[i][3],vhi[i][0],vhi[i][1],vhi[i][2],vhi[i][3]}
  #define PIN(x) asm volatile("":"+v"(x))
  #define MX3(a,b,c) __builtin_fmaxf(__builtin_fmaxf((a),(b)),(c))
  #define GAPA(MF,A0,A1,A2,A3,W0,W1,PW) do{ MF; sacc+=A0; sacc+=A1; sacc+=A2; sacc+=A3; PIN(sacc); W0; W1; PIN(PW); SBAR(); }while(0)
  #define EX(v) __builtin_amdgcn_exp2f(v)
  #define GAPB(MF,X,B) do{ MF; X[B]=EX(X[B]); X[B+1]=EX(X[B+1]); X[B+2]=EX(X[B+2]); X[B+3]=EX(X[B+3]); PIN(X); SBAR(); }while(0)
  #define VRD(i) do{ vlo[i]=vtr(vp_+(((i)>>2)*4096+((i)&3)*1024)); vhi[i]=vtr(vp_+(((i)>>2)*4096+((i)&3)*1024+512)); }while(0)
  #define KRD(G,j) do{ if(G){ kload2(kf,kp0+sl_next,j); SBAR(); } }while(0)
  #define STEP(C0,C1,P0,P1,t,GK,GV,GL) do{ SBAR(); NAFILL(C0,C1,t); SBAR(); \
    const lds_cptr vp_=vp0+sl_prev; \
    VRD(0); SBAR(); float sacc=(P0[0]+P0[1]); \
    GAPA(C0=__builtin_amdgcn_mfma_f32_32x32x16_bf16(kf[0],qr[0],(NA?C0:negm),0,0,0), P0[2],P0[3],P0[4],P0[5],     pw0[0]=PKW(P0,0), pw0[1]=PKW(P0,2), pw0); \
    VRD(4); SBAR(); GAPA(C1=__builtin_amdgcn_mfma_f32_32x32x16_bf16(kf[1],qr[0],(NA?C1:negm),0,0,0), P0[6],P0[7],P0[8],P0[9],     pw0[2]=PKW(P0,4), pw0[3]=PKW(P0,6), pw0); \
    VRD(1); SBAR(); GAPA(C0=__builtin_amdgcn_mfma_f32_32x32x16_bf16(kf[2],qr[1],C0,0,0,0),   P0[10],P0[11],P0[12],P0[13], pw1[0]=PKW(P0,8), pw1[1]=PKW(P0,10), pw1); \
    VRD(5); SBAR(); GAPA(C1=__builtin_amdgcn_mfma_f32_32x32x16_bf16(kf[3],qr[1],C1,0,0,0),   P0[14],P0[15],P1[0],P1[1],   pw1[2]=PKW(P0,12),pw1[3]=PKW(P0,14), pw1); \
    VRD(2); SBAR(); GAPA(C0=__builtin_amdgcn_mfma_f32_32x32x16_bf16(kf[4],qr[2],C0,0,0,0),   P1[2],P1[3],P1[4],P1[5],     pw2[0]=PKW(P1,0), pw2[1]=PKW(P1,2), pw2); \
    VRD(6); SBAR(); GAPA(C1=__builtin_amdgcn_mfma_f32_32x32x16_bf16(kf[5],qr[2],C1,0,0,0),   P1[6],P1[7],P1[8],P1[9],     pw2[2]=PKW(P1,4), pw2[3]=PKW(P1,6), pw2); \
    VRD(3); SBAR(); GAPA(C0=__builtin_amdgcn_mfma_f32_32x32x16_bf16(kf[6],qr[3],C0,0,0,0),   P1[10],P1[11],P1[12],P1[13], pw3[0]=PKW(P1,8), pw3[1]=PKW(P1,10), pw3); \
    VRD(7); SBAR(); GAPA(C1=__builtin_amdgcn_mfma_f32_32x32x16_bf16(kf[7],qr[3],C1,0,0,0),   P1[14],P1[15],0.f,0.f,       pw3[2]=PKW(P1,12),pw3[3]=PKW(P1,14), pw3); \
    l_reg+=sacc; \
    if(GK){DMA_K((t)+3,sl_cur);} if(GV){DMA_V((t)+1,sl_next);} \
    CMASK(C0,C1,t); \
    { float a=MX3(C0[0],C0[1],C1[0]),b=MX3(C0[2],C0[3],C1[1]); a=MX3(a,C1[2],C1[3]); \
      _Pragma("unroll") for(int r=4;r<16;r+=4){a=MX3(a,C0[r],C0[r+1]);b=MX3(b,C0[r+2],C0[r+3]);a=MX3(a,C1[r],C1[r+1]);b=MX3(b,C1[r+2],C1[r+3]);} \
      float rm=__builtin_fmaxf(a,b); { auto rr=__builtin_amdgcn_permlane32_swap(__float_as_uint(rm),__float_as_uint(rm),false,false); rm=__builtin_fmaxf(__uint_as_float(rr[0]),__uint_as_float(rr[1])); } \
      resc=false; \
      if(__builtin_expect(__any(rm>(float)THRL),0)){ const float dl=__builtin_fmaxf(rm,0.f); mhat+=dl; \
        _Pragma("unroll") for(int r=0;r<16;++r){C0[r]-=dl;C1[r]-=dl;} \
        if(!NA){ _Pragma("unroll") for(int r=0;r<16;++r)negm[r]=-mhat; asm volatile("":"+v"(negm)); } \
        const float f=__builtin_amdgcn_exp2f(-dl); l_reg*=f; if(hi==0)wsf[r32]=f; resc=true; } } \
    SBAR(); \
    GAPB(o[0]=__builtin_amdgcn_mfma_f32_32x32x16_bf16(PAF(0),VFR(0),o[0],0,0,0), C0,0); \
    GAPB(o[1]=__builtin_amdgcn_mfma_f32_32x32x16_bf16(PAF(0),VFR(4),o[1],0,0,0), C0,4); \
    KRD(GL,0); GAPB(o[0]=__builtin_amdgcn_mfma_f32_32x32x16_bf16(PAF(1),VFR(1),o[0],0,0,0), C0,8); \
    KRD(GL,1); GAPB(o[1]=__builtin_amdgcn_mfma_f32_32x32x16_bf16(PAF(1),VFR(5),o[1],0,0,0), C0,12); \
    KRD(GL,2); GAPB(o[0]=__builtin_amdgcn_mfma_f32_32x32x16_bf16(PAF(2),VFR(2),o[0],0,0,0), C1,0); \
    KRD(GL,3); GAPB(o[1]=__builtin_amdgcn_mfma_f32_32x32x16_bf16(PAF(2),VFR(6),o[1],0,0,0), C1,4); \
    GAPB(o[0]=__builtin_amdgcn_mfma_f32_32x32x16_bf16(PAF(3),VFR(3),o[0],0,0,0), C1,8); \
    GAPB(o[1]=__builtin_amdgcn_mfma_f32_32x32x16_bf16(PAF(3),VFR(7),o[1],0,0,0), C1,12); \
    }while(0)
  int t=1;
  for(;t+5<NT;t+=2){
    STEP(pB0,pB1,pA0,pA1,t,true,true,true);     WAIT_BAR(2); RESC(); ROT();
    STEP(pA0,pA1,pB0,pB1,t+1,true,true,true);   WAIT_BAR(2); RESC(); ROT();
  }
  #define ENDW(tt) do{ if((tt)+3<NT){WAIT_BAR(2);} else if((tt)+2<NT){WAIT_BAR(1);} else {WAIT_BAR(0);} }while(0)
  for(;t+1<NT;t+=2){
    STEP(pB0,pB1,pA0,pA1,t,(t+3<NT),(t+1<NT),(t+1<NT));       ENDW(t);   RESC(); ROT();
    STEP(pA0,pA1,pB0,pB1,t+1,(t+4<NT),(t+2<NT),(t+2<NT));     ENDW(t+1); RESC(); ROT();
  }
  STEP(pB0,pB1,pA0,pA1,NT-1,false,false,false); RESC();
  { float sacc=pB0[0]+pB0[1]; _Pragma("unroll") for(int r=2;r<16;++r)sacc+=pB0[r]; _Pragma("unroll") for(int r=0;r<16;++r)sacc+=pB1[r]; l_reg+=sacc;
    pw0=(u32x4){PKW(pB0,0),PKW(pB0,2),PKW(pB0,4),PKW(pB0,6)};pw1=(u32x4){PKW(pB0,8),PKW(pB0,10),PKW(pB0,12),PKW(pB0,14)};pw2=(u32x4){PKW(pB1,0),PKW(pB1,2),PKW(pB1,4),PKW(pB1,6)};pw3=(u32x4){PKW(pB1,8),PKW(pB1,10),PKW(pB1,12),PKW(pB1,14)};
    SBAR(); pv(o,vb0+sl_cur,PAF(0),PAF(1),PAF(2),PAF(3)); }
  #undef PKW
  #undef PAF
  #undef VFR
  #undef PIN
  #undef MX3
  #undef GAPA
  #undef GAPB
  #undef EX
  #undef VRD
  #undef KRD
  #undef STEP
  #undef ENDW
  {auto rr=__builtin_amdgcn_permlane32_swap(__float_as_uint(l_reg),__float_as_uint(l_reg),false,false);l_reg=__uint_as_float(rr[0])+__uint_as_float(rr[1]);}
  if(hi==0)wsf[32+r32]=l_reg;asm volatile("s_waitcnt lgkmcnt(0)":::"memory");
  float rli[16];
  #pragma unroll
  for(int r=0;r<16;++r)rli[r]=__builtin_amdgcn_rcpf(wsf[32+crow(r,hi)]);
  bf16*Ow=Ob+(long)(wid*QBLK)*OP;
  { bf16*stg=(bf16*)(shm+LDS_OST)+wid*2048;
    #pragma unroll
    for(int r=0;r<16;++r){const int orow=crow(r,hi);
      #pragma unroll
      for(int d0=0;d0<2;++d0)stg[orow*64+d0*32+r32]=__float2bfloat16(o[d0][r]*rli[r]);}
    asm volatile("s_waitcnt lgkmcnt(0)":::"memory");
    #pragma unroll
    for(int i=0;i<4;++i){const int row=i*8+(lane>>3),ch=lane&7; const u32x4 v=*(const u32x4*)(stg+row*64+ch*8); ATTN_STORE16(Ow+(long)row*OP+ch*8,v);} }
  asm volatile("s_waitcnt lgkmcnt(0)\n\ts_barrier":::"memory");
  #undef DMA_K
  #undef KROW
  #undef DMA_V
  #undef CMASK
  #undef NAFILL
  #undef START
  #undef RESC
  #undef ROT
}
constexpr int ATTN_LDS_BYTES=LDS_BYTES;
#undef SBAR
#undef WAIT_BAR
}

#include <hip/hip_cooperative_groups.h>
namespace cg = cooperative_groups;

#ifndef PHMASK
#define PHMASK 0xffff
#endif
#ifndef REPEAT_MASK
#define REPEAT_MASK 0
#endif
#ifndef EXTRA_SYNCS
#define EXTRA_SYNCS 0
#endif
#ifndef MK_N_LAUNCHES
#define MK_N_LAUNCHES 1
#endif

#define GAS __attribute__((address_space(1)))
#define LAS __attribute__((address_space(3)))
typedef unsigned short bf16r;
typedef float f32x4 __attribute__((ext_vector_type(4)));
typedef float f32x2 __attribute__((ext_vector_type(2)));
typedef unsigned u32x2 __attribute__((ext_vector_type(2)));
typedef unsigned u32x4 __attribute__((ext_vector_type(4)));

constexpr int DM = 1024, NB = 2, SEQ = 8192, CTXL = 256, DEPTH = 2;
constexpr int ML = NB * SEQ;
constexpr int MC = NB * CTXL;
constexpr int MT = ML + MC;
constexpr int INW = 3072, FFH = 2816, FF2 = 5632, NMOD = 6 * DM;
constexpr float LN_EPS = 1e-6f, DN_ALPHA = 1.4142135623730951f;
constexpr float LOG2E = 1.4426950408889634f, QSCALE = 0.125f * LOG2E;
constexpr int NSUB = 10;
constexpr int NCHUNK = 132, NCHAIN = 16, NHU = NCHAIN * NCHUNK;

constexpr size_t MiB = 1u << 20;
constexpr size_t WS_MODS = 1 * MiB;
constexpr size_t WS_LB = WS_MODS + 160 * 1024;
constexpr size_t WS_ROPE = WS_LB + 8 * 1024;
constexpr size_t WS_WIN = 2 * MiB;
constexpr size_t WS_WOUT = 14 * MiB;
constexpr size_t WS_WF1 = 18 * MiB;
constexpr size_t WS_WF2 = 40 * MiB;
constexpr size_t WS_XCTX = 51 * MiB;
constexpr size_t WS_H = 53 * MiB;
constexpr size_t WS_P = 86 * MiB;
constexpr size_t ROWS2 = (size_t)MT * 2;
constexpr int QKVP = 1792;
constexpr int CGQ = 0, CGK = 384, CGV = 512, CNQ = 640, CNK = 1024, CNV = 1408;
constexpr size_t WS_QKV = WS_P;
constexpr size_t WS_NV_END = WS_QKV + ROWS2 * QKVP;
constexpr size_t WS_HQ = WS_NV_END;
constexpr size_t WS_HI = WS_HQ + ROWS2 * 256;
constexpr size_t WS_HG = WS_HI + ROWS2 * 256;
constexpr size_t WS_HF = WS_HG + ROWS2 * 256;
constexpr size_t WS_HB = WS_HF + ROWS2 * 512;
constexpr size_t WS_PEND = WS_HB + ROWS2 * 512;
constexpr size_t WS_HH = WS_P;
constexpr size_t WS_SST = 202 * MiB;
constexpr size_t WS_ADEC = 235 * MiB;
constexpr size_t WS_END = 236 * MiB;
static_assert(WS_PEND <= WS_SST && WS_HH + ROWS2 * FFH <= WS_SST && WS_SST + (size_t)NHU * 4096 * 4 <= WS_ADEC, "ws map");

constexpr int LDS_BYTES = 147456 + 256;
constexpr int BARST_OFF = 147456;
constexpr size_t WS_BAR = 0, BAR_ZERO_BYTES = 16384;
constexpr int NA_TAB_OFF = 90112;

struct Args { const float* in[17]; float* out; unsigned char* ws; int ph_lo, ph_hi; };

__device__ __forceinline__ unsigned pk_bf16(float lo, float hi) { f32x2 v = {lo, hi}; typedef __bf16 bf2 __attribute__((ext_vector_type(2))); bf2 b = __builtin_convertvector(v, bf2); return __builtin_bit_cast(unsigned, b); }
__device__ __forceinline__ float bf2f(bf16r v) { return __builtin_bit_cast(float, (unsigned)v << 16); }
__device__ __forceinline__ float silu_f(float x) { return x / (1.f + __expf(-x)); }
__device__ __forceinline__ float wave_sum(float v) {
#pragma unroll
    for (int o = 1; o < 64; o <<= 1) v += __shfl_xor(v, o);
    return v;
}
__device__ __forceinline__ float sum_kq4(float x) {
    auto r1 = __builtin_amdgcn_permlane16_swap(__float_as_uint(x), __float_as_uint(x), false, false); float y = __uint_as_float(r1[0]) + __uint_as_float(r1[1]);
    auto r2 = __builtin_amdgcn_permlane32_swap(__float_as_uint(y), __float_as_uint(y), false, false); return __uint_as_float(r2[0]) + __uint_as_float(r2[1]);
}
#define DPP_ADD(x, ctrl) ((x) + __uint_as_float((unsigned)__builtin_amdgcn_update_dpp(0, (int)__float_as_uint(x), (ctrl), 0xf, 0xf, false)))
__device__ __forceinline__ float sum_row16(float x) { x = DPP_ADD(x, 0xB1); x = DPP_ADD(x, 0x4E); x = DPP_ADD(x, 0x124); x = DPP_ADD(x, 0x128); return x; }
__device__ __forceinline__ int seg_of_row(int r) { return r < SEQ ? 0 : (r < ML ? 1 : 2); }
__device__ __forceinline__ float* xrow_ptr(float* out, float* xctx, int r) { return r < ML ? out + (size_t)r * DM : xctx + (size_t)(r - ML) * DM; }

struct EpiIn {
    static constexpr bool PERM = false, AFTER_DRAIN = false;
    bf16r *HQ, *HI, *HG, *QKV; float *HF, *HB;
    const float *lb, *qn, *kn; const f32x2* rope;
    __device__ __forceinline__ static void st_bf16(bf16r* p, const f32x4 v) { u32x2 w; w.x = pk_bf16(v[0], v[1]); w.y = pk_bf16(v[2], v[3]); *(u32x2*)p = w; }
    __device__ __forceinline__ void operator()(const pg8::f32x4 (&acc)[2][2][4][2], const pg8::Unit& u, int wr, int wc, int fr, int fq) const {
        const int grp = 4 * u.pn + wc;
#pragma unroll
        for (int ai = 0; ai < 2; ++ai)
#pragma unroll
            for (int m = 0; m < 4; ++m) {
                const int r = u.pm * 256 + ai * 128 + wr * 64 + m * 16 + fr;
                f32x4 v[2][2];
#pragma unroll
                for (int bj = 0; bj < 2; ++bj)
#pragma unroll
                    for (int n = 0; n < 2; ++n) { v[bj][n][0] = acc[ai][bj][m][n][0]; v[bj][n][1] = acc[ai][bj][m][n][1]; v[bj][n][2] = acc[ai][bj][m][n][2]; v[bj][n][3] = acc[ai][bj][m][n][3]; }
                if (grp < 20) {
                    const int part = grp >> 2, hc = (grp & 3) * 64;
                    if (part == 1 || part == 2) {
                        float* dst = (part == 1 ? HF : HB) + (size_t)r * 256 + hc;
                        const float* lbp = lb + (part - 1) * 256 + hc;
#pragma unroll
                        for (int bj = 0; bj < 2; ++bj)
#pragma unroll
                            for (int n = 0; n < 2; ++n) { const int d = 32 * bj + 16 * n + 4 * fq; const f32x4 l4 = *(const f32x4*)(lbp + d); f32x4 o;
#pragma unroll
                                for (int e = 0; e < 4; ++e) { const float sg = 1.f / (1.f + expf(-v[bj][n][e])); o[e] = l4[e] + (1.f - l4[e]) * sg; }
                                *(f32x4*)(dst + d) = o; }
                    } else {
                        bf16r* dst = (part == 0 ? HQ : (part == 3 ? HI : HG)) + (size_t)r * 256 + hc;
#pragma unroll
                        for (int bj = 0; bj < 2; ++bj)
#pragma unroll
                            for (int n = 0; n < 2; ++n) { const int d = 32 * bj + 16 * n + 4 * fq; f32x4 o = v[bj][n];
                                if (part != 3) {
#pragma unroll
                                    for (int e = 0; e < 4; ++e) o[e] = silu_f(o[e]); }
                                st_bf16(dst + d, o); }
                    }
                } else if (grp < 28) {
                    const bool isq = grp < 26; const int hh = isq ? grp - 20 : grp - 26;
                    const float* gn = isq ? qn : kn;
                    float ss = 0.f;
#pragma unroll
                    for (int bj = 0; bj < 2; ++bj)
#pragma unroll
                        for (int n = 0; n < 2; ++n)
#pragma unroll
                            for (int e = 0; e < 4; ++e) ss += v[bj][n][e] * v[bj][n][e];
                    ss += __shfl_xor(ss, 16); ss += __shfl_xor(ss, 32);
                    const float rn = 1.f / sqrtf(ss * (1.f / 64.f) + LN_EPS);
                    const float osc = isq ? QSCALE : 1.f;
                    bf16r* dst = QKV + (size_t)r * QKVP + (isq ? CGQ : CGK) + hh * 64;
                    const bool lat = r < ML; const int t = r & (SEQ - 1);
#pragma unroll
                    for (int bj = 0; bj < 2; ++bj) {
                        const int pos = bj ? (t & 63) : (t >> 6);
#pragma unroll
                        for (int n = 0; n < 2; ++n) { const int d = 32 * bj + 16 * n + 4 * fq; const f32x4 g4 = *(const f32x4*)(gn + d); f32x4 o;
#pragma unroll
                            for (int e = 0; e < 4; ++e) o[e] = v[bj][n][e] * rn * g4[e];
                            if (lat) {
#pragma unroll
                                for (int pp = 0; pp < 2; ++pp) { const f32x2 cs = rope[pos * 16 + 8 * n + 2 * fq + pp]; const float x1 = o[2 * pp], x2 = o[2 * pp + 1];
                                    o[2 * pp] = x1 * cs.x - x2 * cs.y; o[2 * pp + 1] = x1 * cs.y + x2 * cs.x; } }
                            o = o * osc; st_bf16(dst + d, o); }
                    }
                } else {
                    bf16r* dst; float osc = 1.f;
                    if (grp < 30) dst = QKV + (size_t)r * QKVP + CGV + (grp - 28) * 64;
                    else if (grp < 36) { dst = QKV + (size_t)r * QKVP + CNQ + (grp - 30) * 64; osc = QSCALE; }
                    else if (grp < 42) dst = QKV + (size_t)r * QKVP + CNK + (grp - 36) * 64;
                    else dst = QKV + (size_t)r * QKVP + CNV + (grp - 42) * 64;
#pragma unroll
                    for (int bj = 0; bj < 2; ++bj)
#pragma unroll
                        for (int n = 0; n < 2; ++n) { const int d = 32 * bj + 16 * n + 4 * fq; st_bf16(dst + d, v[bj][n] * osc); }
                }
            }
    }
};
struct EpiRes {
    static constexpr bool PERM = false, AFTER_DRAIN = false;
    float* out; float* xctx; const float* gate; float* dry;
    __device__ __forceinline__ void operator()(const pg8::f32x4 (&acc)[2][2][4][2], const pg8::Unit& u, int wr, int wc, int fr, int fq) const {
        const int sg = seg_of_row(u.pm * 256);
        const float* gp = gate + sg * NMOD + u.pn * 256 + wc * 32 + 4 * fq;
        f32x4 g4[2][2];
#pragma unroll
        for (int bj = 0; bj < 2; ++bj)
#pragma unroll
            for (int n = 0; n < 2; ++n) g4[bj][n] = *(const f32x4*)(gp + bj * 128 + n * 16);
#pragma unroll
        for (int ai = 0; ai < 2; ++ai)
#pragma unroll
            for (int m = 0; m < 4; ++m) {
                const int r = u.pm * 256 + ai * 128 + wr * 64 + m * 16 + fr;
                float* xp = xrow_ptr(out, xctx, r) + u.pn * 256 + wc * 32 + 4 * fq;
#pragma unroll
                for (int bj = 0; bj < 2; ++bj)
#pragma unroll
                    for (int n = 0; n < 2; ++n) { float* p = xp + bj * 128 + n * 16; const f32x4 x4 = *(const f32x4*)p; f32x4 a; a[0] = acc[ai][bj][m][n][0]; a[1] = acc[ai][bj][m][n][1]; a[2] = acc[ai][bj][m][n][2]; a[3] = acc[ai][bj][m][n][3];
                        float* q = dry ? dry + (size_t)(r & 8191) * DM + (p - xrow_ptr(out, xctx, r)) : p; *(f32x4*)q = x4 * DN_ALPHA + g4[bj][n] * a; }
            }
    }
};
struct EpiSwiglu {
    static constexpr bool PERM = false, AFTER_DRAIN = false;
    bf16r* HH;
    __device__ __forceinline__ void operator()(const pg8::f32x4 (&acc)[2][2][4][2], const pg8::Unit& u, int wr, int wc, int fr, int fq) const {
#pragma unroll
        for (int ai = 0; ai < 2; ++ai)
#pragma unroll
            for (int m = 0; m < 4; ++m) {
                const int r = u.pm * 256 + ai * 128 + wr * 64 + m * 16 + fr;
                bf16r* hp = HH + (size_t)r * FFH + u.pn * 128 + wc * 32 + 4 * fq;
#pragma unroll
                for (int n = 0; n < 2; ++n) { f32x4 o;
#pragma unroll
                    for (int e = 0; e < 4; ++e) o[e] = silu_f(acc[ai][0][m][n][e]) * acc[ai][1][m][n][e];
                    u32x2 w; w.x = pk_bf16(o[0], o[1]); w.y = pk_bf16(o[2], o[3]); *(u32x2*)(hp + n * 16) = w; }
            }
    }
};

__device__ __forceinline__ void transpose_item(const float* W, int K, int N, bf16r* WT, int mode, LAS float* scr, int item, int lane) {
    const int nblk = N / 32, kb = item / nblk, nb = item % nblk, k0 = 64 * kb, n0 = 32 * nb;
#pragma unroll 8
    for (int i = 0; i < 32; ++i) { const int kk = 2 * i + (lane >> 5); scr[kk * 33 + (lane & 31)] = W[(size_t)(k0 + kk) * N + n0 + (lane & 31)]; }
    asm volatile("s_waitcnt lgkmcnt(0)" ::: "memory");
    int ro = n0;
    if (mode == 1) ro = (n0 & ~255) + 128 * ((n0 & 63) >> 5) + 32 * ((n0 & 255) >> 6);
    else if (mode == 2) { const int up = n0 >= FFH, j = up ? n0 - FFH : n0; ro = 256 * (j >> 7) + 128 * up + (j & 127); }
    const int c = lane & 7;
#pragma unroll
    for (int j = 0; j < 4; ++j) { const int n = (lane >> 3) + 8 * j; const LAS float* s = scr + (8 * c) * 33 + n;
        u32x4 o; o.x = pk_bf16(s[0 * 33], s[1 * 33]); o.y = pk_bf16(s[2 * 33], s[3 * 33]); o.z = pk_bf16(s[4 * 33], s[5 * 33]); o.w = pk_bf16(s[6 * 33], s[7 * 33]);
        *(u32x4*)(WT + (size_t)(ro + n) * K + k0 + 8 * c) = o; }
    asm volatile("s_waitcnt lgkmcnt(0)" ::: "memory");
}

#define RLX_AGENT __ATOMIC_RELAXED, __HIP_MEMORY_SCOPE_AGENT
#define LDS_WAIT() asm volatile("s_waitcnt lgkmcnt(0)" ::: "memory")
#define VM_WAIT() asm volatile("s_waitcnt vmcnt(0)" ::: "memory")
__device__ __forceinline__ unsigned long long rt() { return __builtin_amdgcn_s_memrealtime(); }
#define XB_TMO      128
#define XB_XCNT(j)  (256  + 64 * (j))
#define XB_XSUB(j)  (1280 + 64 * (j))
#define XB_XGEN(j)  (2304 + 64 * (j))
#define XB_TOP      3328
#define XB_TOPGEN   3392
#define XCD_BAR_WORDS 3456
#define XB_SPIN_CAP (1u << 18)

__device__ __forceinline__ unsigned xb_ld(unsigned* p)              { return __hip_atomic_load(p, __ATOMIC_RELAXED, __HIP_MEMORY_SCOPE_AGENT); }
__device__ __forceinline__ unsigned xb_add(unsigned* p, unsigned v) { return __hip_atomic_fetch_add(p, v, __ATOMIC_RELAXED, __HIP_MEMORY_SCOPE_AGENT); }
__device__ __forceinline__ unsigned xb_xcc_id() { return (unsigned)__builtin_amdgcn_s_getreg((3 << 11) | 20) & 0xFu; }
#define XB_SPIN(cond, bar) do { unsigned _sp = 0; while (cond) { __builtin_amdgcn_s_sleep(1); \
    if ((++_sp & 255u) == 0u) { if (xb_ld(&(bar)[XB_TMO])) break; if (_sp > XB_SPIN_CAP) { atomicAdd(&(bar)[XB_TMO], 1u); break; } } } } while (0)

struct XcdBarrier {
    unsigned* bar; unsigned x;
    volatile LAS unsigned* st;
};

__device__ __forceinline__ XcdBarrier xcd_barrier_post(unsigned* bar, volatile LAS unsigned* st) {
    XcdBarrier b; b.bar = bar; b.x = xb_xcc_id(); b.st = st;
    if (threadIdx.x == 0) (void)xb_add(&bar[XB_XCNT(b.x)], 1u);
    return b;
}
__device__ __forceinline__ void xcd_barrier_complete(unsigned* bar, unsigned x, unsigned& nloc, unsigned& nx) {
    const unsigned G = gridDim.x * gridDim.y * gridDim.z;
    unsigned sum, cnt, mine, sp = 0u;
    for (;;) {
        sum = 0u; cnt = 0u; mine = 0u;
#pragma unroll
        for (unsigned j = 0; j < 16; ++j) { const unsigned c = xb_ld(&bar[XB_XCNT(j)]); sum += c; cnt += (c > 0u) ? 1u : 0u; mine = (j == x) ? c : mine; }
        if (sum == G) break;
        __builtin_amdgcn_s_sleep(1);
        if ((++sp & 255u) == 0u) { if (xb_ld(&bar[XB_TMO])) break; if (sp > XB_SPIN_CAP) { atomicAdd(&bar[XB_TMO], 1u); break; } }
    }
    nloc = mine > 0u ? mine : 1u; nx = cnt > 0u ? cnt : 1u;
}

__device__ __forceinline__ void xcd_barrier(const XcdBarrier& b) {
    asm volatile("s_waitcnt vmcnt(0)" ::: "memory");
    __syncthreads();
    if (threadIdx.x == 0) {
        unsigned* bar = b.bar;
        __builtin_amdgcn_s_waitcnt(0);
        unsigned nloc = b.st[0], nx = b.st[1];
        if (nloc == 0u) { xcd_barrier_complete(bar, b.x, nloc, nx); b.st[0] = nloc; b.st[1] = nx; }
        const unsigned old = xb_add(&bar[XB_XSUB(b.x)], 1u);
        const unsigned gen = old / nloc;
        if (old + 1u == (gen + 1u) * nloc) {
            __builtin_amdgcn_fence(__ATOMIC_RELEASE, "agent");
            asm volatile("s_waitcnt vmcnt(0)" ::: "memory");
            const unsigned og = xb_add(&bar[XB_TOP], 1u);
            const unsigned tg = og / nx;
            if (og + 1u == (tg + 1u) * nx) xb_add(&bar[XB_TOPGEN], 1u);
            else XB_SPIN(xb_ld(&bar[XB_TOPGEN]) == tg, bar);
            __builtin_amdgcn_fence(__ATOMIC_ACQUIRE, "agent");
            xb_add(&bar[XB_XGEN(b.x)], 1u);
            asm volatile("s_waitcnt vmcnt(0)" ::: "memory");
        } else {
            XB_SPIN(xb_ld(&bar[XB_XGEN(b.x)]) == gen, bar);
            __builtin_amdgcn_fence(__ATOMIC_ACQUIRE, "agent");
            asm volatile("s_waitcnt vmcnt(0)" ::: "memory");
        }
    }
    __syncthreads();
}

__global__ void __launch_bounds__(512) hybrid_fwd(Args args) {
    extern __shared__ __attribute__((aligned(16))) unsigned char lds[];
    LAS unsigned char* L = (LAS unsigned char*)lds;
    const int G = gridDim.x, bx = blockIdx.x, NGW = G * 8;
    unsigned char* ws = args.ws;
    float* out = args.out;
    float* xctx = (float*)(ws + WS_XCTX);
    float* MODS = (float*)(ws + WS_MODS);
    float* LBT = (float*)(ws + WS_LB);
    f32x2* ROPE = (f32x2*)(ws + WS_ROPE);
    bf16r* Hb = (bf16r*)(ws + WS_H);
    bf16r* QKV = (bf16r*)(ws + WS_QKV);
    bf16r *HQ = (bf16r*)(ws + WS_HQ), *HI = (bf16r*)(ws + WS_HI), *HG = (bf16r*)(ws + WS_HG);
    float *HF = (float*)(ws + WS_HF), *HB = (float*)(ws + WS_HB);
    bf16r* HH = (bf16r*)(ws + WS_HH);
    float* SST = (float*)(ws + WS_SST); float* ADEC = (float*)(ws + WS_ADEC);
    cg::grid_group grid = cg::this_grid();
    if (threadIdx.x < 64) ((LAS unsigned*)(L + BARST_OFF))[threadIdx.x] = 0u;
    __syncthreads();
    const XcdBarrier xbar = xcd_barrier_post((unsigned*)(ws + WS_BAR), (volatile LAS unsigned*)(L + BARST_OFF));
    int nsync_ = 0;
#define GRID_SEAM() do { if (args.ph_lo < 0) { __syncthreads(); grid.sync(); } xcd_barrier(xbar); ++nsync_; } while (0)

    bool second_ = false;
    for (int ph = args.ph_lo; ph < args.ph_hi; ++ph) {
        int tid_l = threadIdx.x; asm volatile("" : "+v"(tid_l));
        const int tid = tid_l, lane = tid & 63, wave = __builtin_amdgcn_readfirstlane(tid >> 6), gw = bx * 8 + wave;
        const bool rep_this = (REPEAT_MASK != 0) && ph >= 2 && ((REPEAT_MASK >> ((ph - 2) % NSUB)) & 1);
        float* dryp = (rep_this && !second_) ? (float*)(args.ws + WS_SST) : nullptr;
        if (ph == 0 && (PHMASK & 1)) {
            LAS float* scr = (LAS float*)(L + wave * 16384);
            constexpr int I_IN = 16 * (INW / 32), I_OUT = 16 * (DM / 32), I_F1 = 16 * (FF2 / 32), I_F2 = (FFH / 64) * (DM / 32), I_L = I_IN + I_OUT + I_F1 + I_F2;
            for (int it = gw; it < DEPTH * I_L; it += NGW) {
                const int l = it / I_L; int r = it % I_L;
                if (r < I_IN) { transpose_item(args.in[6] + (size_t)l * DM * INW, DM, INW, (bf16r*)(ws + WS_WIN) + (size_t)l * INW * DM, 1, scr, r, lane); continue; } r -= I_IN;
                if (r < I_OUT) { transpose_item(args.in[12] + (size_t)l * DM * DM, DM, DM, (bf16r*)(ws + WS_WOUT) + (size_t)l * DM * DM, 0, scr, r, lane); continue; } r -= I_OUT;
                if (r < I_F1) { transpose_item(args.in[13] + (size_t)l * DM * FF2, DM, FF2, (bf16r*)(ws + WS_WF1) + (size_t)l * FF2 * DM, 2, scr, r, lane); continue; } r -= I_F1;
                transpose_item(args.in[14] + (size_t)l * FFH * DM, FFH, DM, (bf16r*)(ws + WS_WF2) + (size_t)l * DM * FFH, 0, scr, r, lane);
            }
            __syncthreads();
            if (bx < 192) {
                LAS float* sc = (LAS float*)L;
                LAS float* red = (LAS float*)(L + 16384);
                for (int i = tid; i < 3 * DM; i += 512) { const int s = i >> 10, k = i & 1023; const float cv = s < 2 ? args.in[1][s * DM + k] : args.in[3][k]; sc[i] = silu_f(cv); }
                __syncthreads();
                for (int it = bx; it < 192; it += G) {
                    const int l = it / 96, n0 = (it % 96) * 64;
                    const float* wa = args.in[4] + (size_t)l * DM * NMOD + n0 + lane;
                    float a0 = 0.f, a1 = 0.f, a2 = 0.f;
#pragma unroll 8
                    for (int k = wave * 128; k < wave * 128 + 128; ++k) { const float w = wa[(size_t)k * NMOD]; a0 += sc[k] * w; a1 += sc[DM + k] * w; a2 += sc[2 * DM + k] * w; }
                    red[(wave * 3 + 0) * 64 + lane] = a0; red[(wave * 3 + 1) * 64 + lane] = a1; red[(wave * 3 + 2) * 64 + lane] = a2;
                    __syncthreads();
                    if (tid < 192) { const int s = tid >> 6; float sum = 0.f;
#pragma unroll
                        for (int w = 0; w < 8; ++w) sum += red[(w * 3 + s) * 64 + lane];
                        MODS[(l * 3 + s) * NMOD + n0 + lane] = sum + args.in[5][l * NMOD + n0 + lane]; }
                    __syncthreads();
                }
            }
            if (bx == G - 1) {
                for (int i = tid; i < 128 * 16; i += 512) { const int pos = i >> 4, j = i & 15; const float invf = expf((-9.210340371976184f * (float)j) / 16.0f); const float ang = (float)pos * invf; ROPE[i] = (f32x2){cosf(ang), sinf(ang)}; }
                { const int d = tid >> 8, k = tid & 255; const float a0 = args.in[7][d * 256 + k], a1 = args.in[7][512 + d * 256 + k]; const float mx = fmaxf(a0, a1); const float e0 = expf(a0 - mx), e1 = expf(a1 - mx);
                  const float p1 = e1 / (e0 + e1); LBT[d * 256 + k] = 0.f; LBT[512 + d * 256 + k] = fminf(fmaxf(p1, 0.f), 1.f); }
            }
        } else if (ph == 1 && (PHMASK & 2)) {
            for (int r = gw; r < MT; r += NGW) {
                const float* src = r < ML ? args.in[0] + (size_t)r * DM : args.in[2] + (size_t)(r - ML) * DM;
                float* xp = xrow_ptr(out, xctx, r); const float* md = MODS + seg_of_row(r) * NMOD;
#pragma unroll
                for (int j = 0; j < 4; ++j) { const int c = 4 * lane + 256 * j; const f32x4 v = *(const f32x4*)(src + c); *(f32x4*)(xp + c) = v;
                    const f32x4 sh = *(const f32x4*)(md + c), scv = *(const f32x4*)(md + DM + c); const f32x4 h = v * (scv + 1.f) + sh;
                    u32x2 w; w.x = pk_bf16(h[0], h[1]); w.y = pk_bf16(h[2], h[3]); *(u32x2*)(Hb + (size_t)r * DM + c) = w; }
            }
        } else {
            const int l = (ph - 2) / NSUB, sub = (ph - 2) % NSUB;
            const bool need_ctx = l < DEPTH - 1;
            const float* modl = MODS + (size_t)l * 3 * NMOD;
            if (sub == 0 && (PHMASK & 4)) {
                pg8::Gemm g{Hb, (const bf16r*)(ws + WS_WIN) + (size_t)l * INW * DM, MT, INW, DM}; pg8::StaticOrder S; S.init(MT, INW, G, bx);
                EpiIn E{HQ, HI, HG, QKV, HF, HB, LBT + l * 512, args.in[9] + l * 64, args.in[10] + l * 64, ROPE};
                pg8::gemm_phase<EpiIn, pg8::StaticOrder, true, true>(L, g, S, E);
            } else if (sub == 1 && (PHMASK & 8)) {
                LAS float* stf = (LAS float*)(L + wave * 2048);
                LAS float* stv = stf + 256;
                const int kq = lane >> 4, vl = lane & 15, tk = lane >> 4, k4 = (lane & 15) * 4;
                for (int u = wave * G + bx; u < NHU; u += NGW) {
                    const int chain = u / NCHUNK, c = u % NCHUNK, b = chain >> 3, h = (chain >> 1) & 3, dir = chain & 1;
                    int base, sgn;
                    if (dir == 0) { base = c < 4 ? ML + b * CTXL + 64 * c : b * SEQ + 64 * (c - 4); sgn = 1; }
                    else { base = c < 4 ? ML + b * CTXL + 255 - 64 * c : b * SEQ + SEQ - 1 - 64 * (c - 4); sgn = -1; }
                    const float* F = (dir ? HB : HF) + h * 64 + k4; const bf16r* VI = HI + h * 64 + k4;
                    f32x2 s[16][2], a[8];
#pragma unroll
                    for (int kk = 0; kk < 16; ++kk) { s[kk][0] = (f32x2){0.f, 0.f}; s[kk][1] = (f32x2){0.f, 0.f}; }
#pragma unroll
                    for (int kk = 0; kk < 8; ++kk) a[kk] = (f32x2){1.f, 1.f};
                    f32x4 rf; u32x2 rv;
                    { const size_t row = (size_t)(base + sgn * tk); rf = *(const f32x4*)(F + row * 256); rv = *(const u32x2*)(VI + row * 256); }
#pragma unroll 1
                    for (int g = 0; g < 16; ++g) {
                        *(LAS f32x4*)(stf + tk * 64 + k4) = rf;
                        { f32x4 v4; v4[0] = __builtin_bit_cast(float, rv.x << 16); v4[1] = __builtin_bit_cast(float, rv.x & 0xffff0000u); v4[2] = __builtin_bit_cast(float, rv.y << 16); v4[3] = __builtin_bit_cast(float, rv.y & 0xffff0000u);
                          *(LAS f32x4*)(stv + tk * 64 + k4) = v4; }
                        if (g + 1 < 16) { const size_t row = (size_t)(base + sgn * (4 * (g + 1) + tk)); rf = *(const f32x4*)(F + row * 256); rv = *(const u32x2*)(VI + row * 256); }
#pragma unroll
                        for (int i = 0; i < 4; ++i) {
                            f32x2 v2[2]; v2[0] = (f32x2){stv[i * 64 + vl], stv[i * 64 + vl + 16]}; v2[1] = (f32x2){stv[i * 64 + vl + 32], stv[i * 64 + vl + 48]};
#pragma unroll
                            for (int j = 0; j < 4; ++j) { const f32x4 f4 = *(const LAS f32x4*)(stf + i * 64 + 16 * kq + 4 * j);
#pragma unroll
                                for (int e = 0; e < 4; ++e) { const int kk = 4 * j + e; const f32x2 f2 = (f32x2){f4[e], f4[e]}; s[kk][0] = f2 * (s[kk][0] - v2[0]) + v2[0]; s[kk][1] = f2 * (s[kk][1] - v2[1]) + v2[1]; }
                                a[2 * j] = a[2 * j] * (f32x2){f4[0], f4[1]}; a[2 * j + 1] = a[2 * j + 1] * (f32x2){f4[2], f4[3]}; }
                        }
                    }
                    float* so = SST + (size_t)u * 4096 + lane;
#pragma unroll
                    for (int kk = 0; kk < 16; ++kk) { so[(kk * 4 + 0) * 64] = s[kk][0].x; so[(kk * 4 + 1) * 64] = s[kk][0].y; so[(kk * 4 + 2) * 64] = s[kk][1].x; so[(kk * 4 + 3) * 64] = s[kk][1].y; }
                    if (vl == 0) {
#pragma unroll
                        for (int kk = 0; kk < 8; ++kk) { ADEC[(size_t)u * 64 + 16 * kq + 2 * kk] = a[kk].x; ADEC[(size_t)u * 64 + 16 * kq + 2 * kk + 1] = a[kk].y; } }
                }
            } else if (sub == 2 && (PHMASK & 16)) {
                const int gt = bx * 512 + tid;
                if (gt < NCHAIN * 4096 && !dryp) {
                    const int chain = gt >> 12, e = gt & 4095, k = 16 * ((e & 63) >> 4) + (e >> 8);
                    float* sp = SST + (size_t)chain * NCHUNK * 4096 + e; const float* ap = ADEC + (size_t)chain * NCHUNK * 64 + k;
                    float s = 0.f;
#pragma unroll 12
                    for (int c = 0; c < NCHUNK; ++c) { const float loc = sp[(size_t)c * 4096], a = ap[c * 64]; sp[(size_t)c * 4096] = s; s = a * s + loc; }
                }
            } else if (sub == 3 && (PHMASK & 512)) {
                LAS float* stf = (LAS float*)(L + wave * 3072);
                LAS float* stq = stf + 256; LAS float* stv = stf + 512;
                LAS bf16r* ob = (LAS bf16r*)(L + 24576 + wave * 8192);
                const int kq = lane >> 4, vl = lane & 15, tk = lane >> 4, k4 = (lane & 15) * 4;
                const int nblk = need_ctx ? 132 : 128, NU2 = NB * 4 * nblk;
                const float gnorm = args.in[8][l * 64 + lane];
                bf16r* MIXr = Hb;
                for (int u = wave * G + bx; u < NU2; u += NGW) {
                    const int j = u % nblk, bh = u / nblk, b = bh >> 2, h = bh & 3;
                    const int rbase = j < 128 ? b * SEQ + 64 * j : ML + b * CTXL + 64 * (j - 128);
#pragma unroll 1
                    for (int dir = 1; dir >= 0; --dir) {
                        const int chain = bh * 2 + dir;
                        const int c = dir ? (j < 128 ? 4 + (127 - j) : 3 - (j - 128)) : (j < 128 ? 4 + j : j - 128);
                        const float* F = (dir ? HB : HF) + h * 64 + k4; const bf16r* QI = HQ + h * 64 + k4; const bf16r* VI = HI + h * 64 + k4; const bf16r* GI = HG + h * 64 + lane;
                        const float* sp = SST + ((size_t)chain * NCHUNK + c) * 4096 + lane;
                        f32x2 s[16][2];
#pragma unroll
                        for (int kk = 0; kk < 16; ++kk) { s[kk][0] = (f32x2){sp[(kk * 4 + 0) * 64], sp[(kk * 4 + 1) * 64]}; s[kk][1] = (f32x2){sp[(kk * 4 + 2) * 64], sp[(kk * 4 + 3) * 64]}; }
                        f32x4 rf; u32x2 rq, rv; bf16r rg[4];
                        { const size_t row = (size_t)(rbase + (dir ? 63 - tk : tk)); rf = *(const f32x4*)(F + row * 256); rq = *(const u32x2*)(QI + row * 256); rv = *(const u32x2*)(VI + row * 256); }
#pragma unroll
                        for (int i = 0; i < 4; ++i) rg[i] = GI[(size_t)(rbase + (dir ? 63 - i : i)) * 256];
#pragma unroll 1
                        for (int g = 0; g < 16; ++g) {
                            *(LAS f32x4*)(stf + tk * 64 + k4) = rf;
                            { f32x4 q4; q4[0] = __builtin_bit_cast(float, rq.x << 16); q4[1] = __builtin_bit_cast(float, rq.x & 0xffff0000u); q4[2] = __builtin_bit_cast(float, rq.y << 16); q4[3] = __builtin_bit_cast(float, rq.y & 0xffff0000u); *(LAS f32x4*)(stq + tk * 64 + k4) = q4; }
                            { f32x4 v4; v4[0] = __builtin_bit_cast(float, rv.x << 16); v4[1] = __builtin_bit_cast(float, rv.x & 0xffff0000u); v4[2] = __builtin_bit_cast(float, rv.y << 16); v4[3] = __builtin_bit_cast(float, rv.y & 0xffff0000u); *(LAS f32x4*)(stv + tk * 64 + k4) = v4; }
                            float gt4[4];
#pragma unroll
                            for (int i = 0; i < 4; ++i) gt4[i] = bf2f(rg[i]);
                            if (g + 1 < 16) { const int t1 = 4 * (g + 1); const size_t row = (size_t)(rbase + (dir ? 63 - (t1 + tk) : t1 + tk)); rf = *(const f32x4*)(F + row * 256); rq = *(const u32x2*)(QI + row * 256); rv = *(const u32x2*)(VI + row * 256);
#pragma unroll
                                for (int i = 0; i < 4; ++i) rg[i] = GI[(size_t)(rbase + (dir ? 63 - (t1 + i) : t1 + i)) * 256]; }
#pragma unroll
                            for (int i = 0; i < 4; ++i) {
                                f32x2 v2[2]; v2[0] = (f32x2){stv[i * 64 + vl], stv[i * 64 + vl + 16]}; v2[1] = (f32x2){stv[i * 64 + vl + 32], stv[i * 64 + vl + 48]};
                                f32x2 oa[2]; oa[0] = (f32x2){0.f, 0.f}; oa[1] = (f32x2){0.f, 0.f};
#pragma unroll
                                for (int jj = 0; jj < 4; ++jj) { const f32x4 f4 = *(const LAS f32x4*)(stf + i * 64 + 16 * kq + 4 * jj), q4 = *(const LAS f32x4*)(stq + i * 64 + 16 * kq + 4 * jj);
#pragma unroll
                                    for (int e = 0; e < 4; ++e) { const int kk = 4 * jj + e; const f32x2 f2 = (f32x2){f4[e], f4[e]}, q2 = (f32x2){q4[e], q4[e]};
                                        s[kk][0] = f2 * (s[kk][0] - v2[0]) + v2[0]; s[kk][1] = f2 * (s[kk][1] - v2[1]) + v2[1]; oa[0] = s[kk][0] * q2 + oa[0]; oa[1] = s[kk][1] * q2 + oa[1]; } }
                                float o[4] = {oa[0].x, oa[0].y, oa[1].x, oa[1].y};
#pragma unroll
                                for (int ii = 0; ii < 4; ++ii) o[ii] = sum_kq4(o[ii]);
                                const int ro = dir ? 63 - (4 * g + i) : 4 * g + i;
                                if (dir) { const float mine = kq == 0 ? o[0] : (kq == 1 ? o[1] : (kq == 2 ? o[2] : o[3])); ob[ro * 64 + lane] = (bf16r)(pk_bf16(mine, 0.f) & 0xffffu); }
                                else {
                                    float ss = 0.f;
#pragma unroll
                                    for (int ii = 0; ii < 4; ++ii) { o[ii] += bf2f(ob[ro * 64 + vl + 16 * ii]); ss += o[ii] * o[ii]; }
                                    ss = sum_row16(ss);
                                    const float mine = kq == 0 ? o[0] : (kq == 1 ? o[1] : (kq == 2 ? o[2] : o[3]));
                                    const float y = mine * (1.f / sqrtf(ss * (1.f / 64.f) + LN_EPS)) * gnorm * gt4[i];
                                    MIXr[(size_t)(rbase + ro) * DM + h * 64 + lane] = (bf16r)(pk_bf16(y, 0.f) & 0xffffu);
                                }
                            }
                        }
                    }
                }
            } else if (sub == 4 && (PHMASK & 32)) {
                using attn_body::bf16;
                bf16* MIX = (bf16*)Hb; const bf16* QK = (const bf16*)QKV;
                const attn_body::NaP nap0{0, 0, (const LAS float*)(L + NA_TAB_OFF)};
                for (int id = bx; id < 384; id += G) {
                    const int b = id / 192, rem = id % 192, h = rem >> 5, qb = rem & 31, kvh = h / 3; const long q0 = (long)b * SEQ + 256 * qb;
                    attn_body::attn_unit<8, false>(QK + q0 * QKVP + CGQ + h * 64, QK + CGK + kvh * 64, QK + CGV + kvh * 64, MIX + q0 * DM + 256 + h * 64,
                                                   b * SEQ, 128, ML + b * CTXL, 132, nap0, (char*)lds);
                }
                const int hl = G >> 1, li = bx - hl, nl = G - hl;
                if (li >= 0) {
                    for (int id = li; id < 384; id += nl) {
                        const int b = id / 192, rem = id % 192, h = rem >> 5, qb = rem & 31; const long q0 = (long)b * SEQ + 256 * qb;
                        const int gr0 = 4 * qb, lo = gr0 - 4 < 0 ? 0 : gr0 - 4; int rs3 = gr0 - 1; rs3 = rs3 < 0 ? 0 : (rs3 > 120 ? 120 : rs3);
                        const int cnt = rs3 + 7 - lo + 1, ntl = cnt == 8 ? 8 : 12;
                        __syncthreads();
                        { int t_ = tid; asm volatile("" : "+v"(t_)); if (t_ < 465) ((LAS float*)(L + NA_TAB_OFF))[t_] = args.in[11][(size_t)(l * 6 + h) * 465 + t_] * LOG2E; }
                        __syncthreads();
                        const attn_body::NaP nap{gr0, lo, (const LAS float*)(L + NA_TAB_OFF)};
                        attn_body::attn_unit<8, true>(QK + q0 * QKVP + CNQ + h * 64, QK + CNK + h * 64, QK + CNV + h * 64, MIX + q0 * DM + 640 + h * 64,
                                                      ML + b * CTXL, 4, b * SEQ + 64 * lo, 4 + ntl, nap, (char*)lds);
                    }
                    if (need_ctx) {
                        for (int id = li; id < 24; id += nl) {
                            const int na = id / 12, rem = id % 12, b = rem / 6, h = rem % 6; const long q0 = (long)ML + b * CTXL;
                            const int cq = na ? CNQ + h * 64 : CGQ + h * 64, ck = na ? CNK + h * 64 : CGK + (h / 3) * 64, cv = na ? CNV + h * 64 : CGV + (h / 3) * 64, co = (na ? 640 : 256) + h * 64;
                            attn_body::attn_unit<8, false>(QK + q0 * QKVP + cq, QK + ck, QK + cv, MIX + q0 * DM + co, (int)q0, 4, (int)q0, 4, nap0, (char*)lds);
                        }
                    }
                }
            } else if ((sub == 5 || sub == 8) && (PHMASK & 64)) {
                const int Mr = need_ctx ? MT : ML;
                if (sub == 5) { pg8::Gemm g{Hb, (const bf16r*)(ws + WS_WOUT) + (size_t)l * DM * DM, Mr, DM, DM}; pg8::StaticOrder S; S.init(Mr, DM, G, bx);
                    EpiRes E{out, xctx, modl + 2 * DM, dryp}; pg8::gemm_phase<EpiRes, pg8::StaticOrder, true, true>(L, g, S, E); }
                else { pg8::Gemm g{HH, (const bf16r*)(ws + WS_WF2) + (size_t)l * DM * FFH, Mr, DM, FFH}; pg8::StaticOrder S; S.init(Mr, DM, G, bx);
                    EpiRes E{out, xctx, modl + 5 * DM, dryp}; pg8::gemm_phase<EpiRes, pg8::StaticOrder, true, true>(L, g, S, E); }
            } else if ((sub == 6 || sub == 9) && (PHMASK & 128)) {
                const int which = sub == 6 ? 0 : 1; const int Mr = need_ctx ? MT : ML;
                const float* lg = args.in[15] + (size_t)(l * 2 + which) * DM; const float* lbv = args.in[16] + (size_t)(l * 2 + which) * DM;
                const bool wantH = (which == 0) || (l + 1 < DEPTH);
                const float* mdn = which == 0 ? modl + 3 * DM : MODS + (size_t)(l + 1) * 3 * NMOD;
                for (int r = gw; r < (dryp ? 0 : Mr); r += NGW) {
                    float* xp = xrow_ptr(out, xctx, r); f32x4 v[4]; float sm = 0.f;
#pragma unroll
                    for (int j = 0; j < 4; ++j) { v[j] = *(const f32x4*)(xp + 4 * lane + 256 * j); sm += (v[j][0] + v[j][1]) + (v[j][2] + v[j][3]); }
                    const float mean = wave_sum(sm) * (1.f / DM); float s2 = 0.f;
#pragma unroll
                    for (int j = 0; j < 4; ++j) { v[j] = v[j] - mean; s2 += (v[j][0] * v[j][0] + v[j][1] * v[j][1]) + (v[j][2] * v[j][2] + v[j][3] * v[j][3]); }
                    const float rstd = 1.f / sqrtf(wave_sum(s2) * (1.f / DM) + LN_EPS);
                    const float* md = mdn + seg_of_row(r) * NMOD;
#pragma unroll
                    for (int j = 0; j < 4; ++j) { const int c = 4 * lane + 256 * j; const f32x4 y = v[j] * rstd * *(const f32x4*)(lg + c) + *(const f32x4*)(lbv + c); *(f32x4*)(xp + c) = y;
                        if (wantH) { const f32x4 sh = *(const f32x4*)(md + c), scv = *(const f32x4*)(md + DM + c); const f32x4 h = y * (scv + 1.f) + sh;
                            u32x2 w; w.x = pk_bf16(h[0], h[1]); w.y = pk_bf16(h[2], h[3]); *(u32x2*)(Hb + (size_t)r * DM + c) = w; } }
                }
            } else if (sub == 7 && (PHMASK & 256)) {
                const int Mr = need_ctx ? MT : ML;
                pg8::Gemm g{Hb, (const bf16r*)(ws + WS_WF1) + (size_t)l * FF2 * DM, Mr, FF2, DM}; pg8::StaticOrder S; S.init(Mr, FF2, G, bx);
                EpiSwiglu E{HH}; pg8::gemm_phase<EpiSwiglu, pg8::StaticOrder, true, true>(L, g, S, E);
            }
        }
        if (rep_this && !second_) { second_ = true; --ph; GRID_SEAM(); continue; }
        second_ = false;
        if (ph + 1 < args.ph_hi) { GRID_SEAM(); for (int x_ = 0; x_ < EXTRA_SYNCS; ++x_) GRID_SEAM(); }
    }
}

constexpr int N_PHASES = 2 + NSUB * DEPTH;
extern "C" void kernel_launch(void* const* d_in, const int* in_sizes, int n_in, void* d_out, int out_size, void* d_ws, size_t ws_size, hipStream_t stream) {
    static int grid = 0;
    if (grid == 0) {
        if (n_in != 17 || out_size != ML * DM || ws_size < WS_END) { fprintf(stderr, "kernel_launch: unexpected shapes (n_in %d out %d ws %zu)\n", n_in, out_size, ws_size); grid = -1; return; }
        int dev = 0, cus = 0, per_cu = 0;
        hipGetDevice(&dev); hipDeviceGetAttribute(&cus, hipDeviceAttributeMultiprocessorCount, dev);
        if (hipFuncSetAttribute((const void*)hybrid_fwd, hipFuncAttributeMaxDynamicSharedMemorySize, LDS_BYTES) != hipSuccess) { fprintf(stderr, "kernel_launch: hipFuncSetAttribute failed\n"); grid = -1; return; }
        if (hipOccupancyMaxActiveBlocksPerMultiprocessor(&per_cu, (const void*)hybrid_fwd, 512, LDS_BYTES) != hipSuccess || per_cu < 1) { fprintf(stderr, "kernel_launch: occupancy query says %d\n", per_cu); (void)hipGetLastError(); grid = -1; return; }
        grid = cus;
    }
    if (grid < 0) return;
    if (hipMemsetAsync((char*)d_ws + WS_BAR, 0, BAR_ZERO_BYTES, stream) != hipSuccess) { fprintf(stderr, "kernel_launch: memset failed\n"); return; }
    Args a{};
    for (int i = 0; i < 17; ++i) a.in[i] = (const float*)d_in[i];
    a.out = (float*)d_out; a.ws = (unsigned char*)d_ws;
#if MK_N_LAUNCHES == 1
    a.ph_lo = 0; a.ph_hi = N_PHASES;
    void* kargs[] = {&a};
    hipError_t e = hipLaunchCooperativeKernel((const void*)hybrid_fwd, dim3(grid), dim3(512), kargs, LDS_BYTES, stream);
    if (e != hipSuccess) fprintf(stderr, "cooperative launch failed: %s (grid %d)\n", hipGetErrorString(e), grid);
#else
    for (int p = 0; p < N_PHASES; ++p) { a.ph_lo = p; a.ph_hi = p + 1; hipLaunchKernelGGL(hybrid_fwd, dim3(grid), dim3(512), LDS_BYTES, stream, a); }
#endif
}
```

```cpp
#include <hip/hip_runtime.h>
#include <cstdio>
#include <cstdint>
namespace pg8 {
#define PG8_LAS __attribute__((address_space(3)))
typedef unsigned short bf16_t;
typedef short bf16x8 __attribute__((ext_vector_type(8)));
typedef float f32x4 __attribute__((ext_vector_type(4)));
typedef unsigned u32x4 __attribute__((ext_vector_type(4)));
constexpr int BM = 256, BK = 64, HALF = 128, HTB = HALF * BK * 2  , STAGE_BYTES = 8 * HTB, NXCD = 8, WGM = 8;

__host__ __device__ __forceinline__ int lds_byte(int r, int c) { const int st = (r >> 4) * 2 + (c >> 5), rr = r & 15, cc = c & 31, ob = rr * 64 + cc * 2; return st * 1024 + (ob ^ (((ob >> 9) & 1) << 5)); }
__host__ __device__ __forceinline__ void stage_rc(int b, int& R, int& C) { const int st = b / 1024, sb = b % 1024, swz = sb ^ (((sb >> 9) & 1) << 5); R = (st >> 1) * 16 + swz / 64; C = (st & 1) * 32 + (swz % 64) / 2; }
__host__ __device__ __forceinline__ int perm32(int rho) { const int n = rho >> 4, i = rho & 15; return 8 * (i >> 2) + 4 * n + (i & 3); }

struct Unit { int pm, pn, k0, nk; };
struct Gemm { const bf16_t* A; const bf16_t* Bt; int M, N, K; };

struct StaticOrder {
    int nM, nN, nwg, G, c, nkf;
    __host__ __device__ void init(int M, int N, int G_, int c_, int K_) { nM = M / BM; nN = N / BM; nwg = nM * nN; G = G_; c = c_; nkf = K_ / BK; }
    __host__ __device__ bool next(int i, Unit& u) const {
        const long L = (long)i * G + c; if (L >= nwg) return false;
        int wgid = (int)L; { const int q = nwg / NXCD, r = nwg % NXCD, xcd = wgid % NXCD, off = wgid / NXCD; wgid = (xcd < r ? xcd * (q + 1) : r * (q + 1) + (xcd - r) * q) + off; }
        const int nig = WGM * nN, gid = wgid / nig, fm = gid * WGM, gsz = (nM - fm) < WGM ? (nM - fm) : WGM;
        u.pm = fm + ((wgid % nig) % gsz); u.pn = (wgid % nig) / gsz; u.k0 = 0; u.nk = nkf; return true;
    }
    __device__ __forceinline__ void a_ready(const Unit&) const {}
    __device__ __forceinline__ void done(const Unit&) const {}
};

__device__ __forceinline__ unsigned cvt_pk_bf16(float lo, float hi) { unsigned r; asm volatile("v_cvt_pk_bf16_f32 %0, %1, %2" : "=v"(r) : "v"(lo), "v"(hi)); return r; }
typedef float f32x2 __attribute__((ext_vector_type(2)));
__device__ __forceinline__ f32x2 gelu_pk(f32x2 v) {
    const f32x2 av = __builtin_elementwise_abs(v), d = av * 0.2316418882f + 1.0f;
    f32x2 t; t.x = __builtin_amdgcn_rcpf(d.x); t.y = __builtin_amdgcn_rcpf(d.y);
    f32x2 q = t * 0.5307027145f + (-0.7265760135f); q = q * t + 0.7107068705f; q = q * t + (-0.142248368f); q = q * t + 0.127414796f; q = q * t;
    const f32x2 s = (v * v) * (-0.72134752044f);
    f32x2 e; e.x = __builtin_amdgcn_exp2f(s.x); e.y = __builtin_amdgcn_exp2f(s.y);
    const f32x2 m = v * (q * e), r = v - m;
    f32x2 o; o.x = v.x < 0.f ? m.x : r.x; o.y = v.y < 0.f ? m.y : r.y; return o;
}

template <int ACT  > struct EpiBf16 {
    static constexpr bool PERM = true, AFTER_DRAIN = false; static_assert(ACT == 0 || ACT == 1, "EpiBf16: ACT is 0 (none) or 1 (gelu_pk)");
    bf16_t* O; int ldc; const float* bias; int split_cols; size_t split_stride; float scale0;
    __device__ __forceinline__ void operator()(const f32x4 (&acc)[2][2][4][2], const Unit& u, int wr, int wc, int fr, int fq) const {
        const int row0 = u.pm * BM + wr * 64 + fr; int colt = u.pn * BM; bf16_t* base = O;
        float sc = 1.f; if (split_cols) { const int t = colt / split_cols; base += (size_t)t * split_stride; colt -= t * split_cols; if (t == 0) sc = scale0; }
        const int col0 = colt + wc * 32 + 8 * fq, bcol0 = u.pn * BM + wc * 32 + 8 * fq;
        f32x4 bv[2][2];
#pragma unroll
        for (int bj = 0; bj < 2; ++bj)
#pragma unroll
            for (int n = 0; n < 2; ++n) bv[bj][n] = bias ? *(const f32x4*)(bias + bcol0 + bj * HALF + 4 * n) : (f32x4){0.f, 0.f, 0.f, 0.f};
#pragma unroll
        for (int ai = 0; ai < 2; ++ai)
#pragma unroll
            for (int m = 0; m < 4; ++m) { bf16_t* rowp = base + (size_t)(row0 + ai * HALF + m * 16) * ldc + col0;
#pragma unroll
                for (int bj = 0; bj < 2; ++bj) { f32x4 v0 = acc[ai][bj][m][0] + bv[bj][0], v1 = acc[ai][bj][m][1] + bv[bj][1];
                    if (ACT == 1) { f32x2 a = gelu_pk((f32x2){v0[0], v0[1]}), b = gelu_pk((f32x2){v0[2], v0[3]}), c = gelu_pk((f32x2){v1[0], v1[1]}), d = gelu_pk((f32x2){v1[2], v1[3]});
                        v0 = (f32x4){a.x, a.y, b.x, b.y}; v1 = (f32x4){c.x, c.y, d.x, d.y}; }
                    v0 = v0 * sc; v1 = v1 * sc; u32x4 w; w.x = cvt_pk_bf16(v0[0], v0[1]); w.y = cvt_pk_bf16(v0[2], v0[3]); w.z = cvt_pk_bf16(v1[0], v1[1]); w.w = cvt_pk_bf16(v1[2], v1[3]);
                    *(u32x4*)(rowp + bj * HALF) = w; } }
    }
};

struct PanelStats {
    unsigned* xbuf;
    unsigned* cnt;
    unsigned* tmo;
    int ntn; float eps;
    unsigned code;
    __device__ __forceinline__ bool run(const f32x4 (&v)[2][2][4][2], const Unit& u, int wr, int wc, int fr, int fq, PG8_LAS unsigned char* lds, int wid, int lane) const {
        typedef float f32x2v __attribute__((ext_vector_type(2)));
        PG8_LAS f32x2v* P = (PG8_LAS f32x2v*)lds;
        PG8_LAS f32x2v* S = (PG8_LAS f32x2v*)(lds + 8192);
        PG8_LAS unsigned* flag = (PG8_LAS unsigned*)(lds + 8192 + 2048);
#pragma unroll
        for (int ai = 0; ai < 2; ++ai)
#pragma unroll
            for (int m = 0; m < 4; ++m) {
                float s = 0.f;
#pragma unroll
                for (int bj = 0; bj < 2; ++bj)
#pragma unroll
                    for (int n = 0; n < 2; ++n) { const f32x4 x = v[ai][bj][m][n]; s += (x[0] + x[1]) + (x[2] + x[3]); }
                s += __shfl_xor(s, 16); s += __shfl_xor(s, 32);
                const float mw = s * (1.0f / 64.0f); float q = 0.f;
#pragma unroll
                for (int bj = 0; bj < 2; ++bj)
#pragma unroll
                    for (int n = 0; n < 2; ++n) { const f32x4 d = v[ai][bj][m][n] - mw; q += (d[0] * d[0] + d[1] * d[1]) + (d[2] * d[2] + d[3] * d[3]); }
                q += __shfl_xor(q, 16); q += __shfl_xor(q, 32);
                if (fq == 0) P[(ai * HALF + wr * 64 + m * 16 + fr) * 4 + wc] = (f32x2v){mw, q};
            }
        asm volatile("s_waitcnt lgkmcnt(0)" ::: "memory"); __builtin_amdgcn_s_barrier(); asm volatile("" ::: "memory");
#if defined(BROKEN_EXCHANGE_NO_WAIT)
#warning BROKEN CONTROL BUILD: the row-statistics exchange does not wait; results are wrong by design
        if (blockIdx.x >= 64) { const long long t0_ = clock64(); while (clock64() - t0_ < 60000) __builtin_amdgcn_s_sleep(8); }
#endif
        const int row = wid * 32 + (lane & 31);
        if (lane < 32) {
            const f32x2v a = P[row * 4 + 0], b = P[row * 4 + 1], c = P[row * 4 + 2], d = P[row * 4 + 3];
            const float mt = (a.x + b.x + c.x + d.x) * 0.25f;
            const float da = a.x - mt, db = b.x - mt, dc = c.x - mt, dd = d.x - mt;
            const float m2 = (a.y + b.y) + (c.y + d.y) + 64.0f * ((da * da + db * db) + (dc * dc + dd * dd));
            unsigned long long* slot = (unsigned long long*)xbuf + ((size_t)(u.pm * BM + row) * 4 + u.pn);
            __hip_atomic_store(slot, ((unsigned long long)__float_as_uint(m2) << 32) | __float_as_uint(mt), __ATOMIC_RELAXED, __HIP_MEMORY_SCOPE_AGENT);
        }
        asm volatile("s_waitcnt vmcnt(0)" ::: "memory");
        if (lane == 0) __hip_atomic_fetch_add(cnt + 64 * u.pm, 1u, __ATOMIC_RELAXED, __HIP_MEMORY_SCOPE_AGENT);
        if (wid == 0) {
            bool dead = false; const unsigned long long t0 = __builtin_amdgcn_s_memrealtime(); const unsigned want = 8u * (unsigned)ntn;
            for (;;) {
#if defined(BROKEN_EXCHANGE_NO_WAIT)
                break;
#endif
                if ((unsigned)__builtin_amdgcn_readfirstlane(__hip_atomic_load(cnt + 64 * u.pm, __ATOMIC_RELAXED, __HIP_MEMORY_SCOPE_AGENT)) >= want) break;
                if (__builtin_amdgcn_s_memrealtime() - t0 > 2000000ull) {
                    if (lane == 0) { unsigned expect = 0u; __hip_atomic_compare_exchange_strong(tmo + 1, &expect, code | (unsigned)(u.pm & 0xff), __ATOMIC_RELAXED, __ATOMIC_RELAXED, __HIP_MEMORY_SCOPE_AGENT);
                                     __hip_atomic_store(tmo, 1u, __ATOMIC_RELAXED, __HIP_MEMORY_SCOPE_AGENT); }
                    dead = true; break; }
                __builtin_amdgcn_s_sleep(2);
            }
            __builtin_amdgcn_fence(__ATOMIC_ACQUIRE, "agent");
            if (lane == 0) flag[0] = dead ? 1u : 0u;
        }
        asm volatile("s_waitcnt vmcnt(0) lgkmcnt(0)" ::: "memory"); __builtin_amdgcn_s_barrier(); asm volatile("" ::: "memory");
        const bool bad = flag[0] != 0u;
        if (lane < 32) {
            const unsigned long long* slot = (const unsigned long long*)xbuf + (size_t)(u.pm * BM + row) * 4; float mt[4], m2[4]; float ms = 0.f;
#pragma unroll
            for (int t = 0; t < 4; ++t) { if (t < ntn) { const unsigned long long w = __hip_atomic_load(slot + t, __ATOMIC_RELAXED, __HIP_MEMORY_SCOPE_AGENT); mt[t] = __uint_as_float((unsigned)w); m2[t] = __uint_as_float((unsigned)(w >> 32)); } else { mt[t] = 0.f; m2[t] = 0.f; } ms += mt[t]; }
            const float mean = ms / (float)ntn; float q = 0.f;
#pragma unroll
            for (int t = 0; t < 4; ++t) if (t < ntn) { const float dm = mt[t] - mean; q += m2[t] + 256.0f * dm * dm; }
            S[row] = (f32x2v){mean, 1.0f / sqrtf(q / (256.0f * (float)ntn) + eps)};
        }
        asm volatile("s_waitcnt lgkmcnt(0)" ::: "memory"); __builtin_amdgcn_s_barrier(); asm volatile("" ::: "memory");
        return bad;
    }
};
struct EpiLnRes {
    static constexpr bool PERM = false, AFTER_DRAIN = true;
    const float* base; float* out; int ldc; const float* bias; PanelStats st; unsigned poison;
    __device__ __forceinline__ void fused(f32x4 (&acc)[2][2][4][2], const Unit& u, int wr, int wc, int fr, int fq, PG8_LAS unsigned char* lds, int wid, int lane) const {
        typedef float f32x2v __attribute__((ext_vector_type(2)));
        const PG8_LAS f32x2v* S = (const PG8_LAS f32x2v*)(lds + 8192);
        const int col0 = u.pn * BM + wc * 32 + 4 * fq;
#pragma unroll
        for (int bj = 0; bj < 2; ++bj)
#pragma unroll
            for (int n = 0; n < 2; ++n) { const f32x4 bv = bias ? *(const f32x4*)(bias + col0 + bj * HALF + n * 16) : (f32x4){0.f, 0.f, 0.f, 0.f};
#pragma unroll
                for (int ai = 0; ai < 2; ++ai)
#pragma unroll
                    for (int m = 0; m < 4; ++m) acc[ai][bj][m][n] += bv; }
        f32x4 pre[4][2][2];
#pragma unroll
        for (int m = 0; m < 4; ++m) { const size_t off = (size_t)(u.pm * BM + wr * 64 + m * 16 + fr) * ldc + col0;
#pragma unroll
            for (int bj = 0; bj < 2; ++bj)
#pragma unroll
                for (int n = 0; n < 2; ++n) pre[m][bj][n] = *(const f32x4*)(base + off + bj * HALF + n * 16); }
        const bool bad = st.run(acc, u, wr, wc, fr, fq, lds, wid, lane) || poison != 0u;
        const float qnan = __builtin_nanf("");
#pragma unroll
        for (int ai = 0; ai < 2; ++ai)
#pragma unroll
            for (int m = 0; m < 4; ++m) { const int r = ai * HALF + wr * 64 + m * 16 + fr; const f32x2v sr = S[r]; const size_t off = (size_t)(u.pm * BM + r) * ldc + col0;
#pragma unroll
                for (int bj = 0; bj < 2; ++bj)
#pragma unroll
                    for (int n = 0; n < 2; ++n) { const f32x4 bs = ai == 0 ? pre[m][bj][n] : *(const f32x4*)(base + off + bj * HALF + n * 16); f32x4 o = bs + (acc[ai][bj][m][n] - sr.x) * sr.y;
                        if (bad) o = (f32x4){qnan, qnan, qnan, qnan}; *(f32x4*)(out + off + bj * HALF + n * 16) = o; }
                if (m & 1) asm volatile("" ::: "memory"); }
    }
};
struct EpiLnResLn {
    static constexpr bool PERM = false, AFTER_DRAIN = true;
    const float* base; float* out; bf16_t* xn; int ldc; const float* bias; PanelStats st1, st2; unsigned poison;
    __device__ __forceinline__ void fused(f32x4 (&acc)[2][2][4][2], const Unit& u, int wr, int wc, int fr, int fq, PG8_LAS unsigned char* lds, int wid, int lane) const {
        typedef float f32x2v __attribute__((ext_vector_type(2))); typedef unsigned u32x2v __attribute__((ext_vector_type(2)));
        const PG8_LAS f32x2v* S = (const PG8_LAS f32x2v*)(lds + 8192);
        const int col0 = u.pn * BM + wc * 32 + 4 * fq;
#pragma unroll
        for (int bj = 0; bj < 2; ++bj)
#pragma unroll
            for (int n = 0; n < 2; ++n) { const f32x4 bv = bias ? *(const f32x4*)(bias + col0 + bj * HALF + n * 16) : (f32x4){0.f, 0.f, 0.f, 0.f};
#pragma unroll
                for (int ai = 0; ai < 2; ++ai)
#pragma unroll
                    for (int m = 0; m < 4; ++m) acc[ai][bj][m][n] += bv; }
        bool bad = st1.run(acc, u, wr, wc, fr, fq, lds, wid, lane) || poison != 0u;
        const float qnan = __builtin_nanf("");
#pragma unroll
        for (int ai = 0; ai < 2; ++ai)
#pragma unroll
            for (int m = 0; m < 4; ++m) { const int r = ai * HALF + wr * 64 + m * 16 + fr; const f32x2v sr = S[r]; const size_t off = (size_t)(u.pm * BM + r) * ldc + col0;
#pragma unroll
                for (int bj = 0; bj < 2; ++bj)
#pragma unroll
                    for (int n = 0; n < 2; ++n) { const f32x4 bs = *(const f32x4*)(base + off + bj * HALF + n * 16); acc[ai][bj][m][n] = bs + (acc[ai][bj][m][n] - sr.x) * sr.y; }
                asm volatile("" : "+v"(acc[ai][0][m][0]), "+v"(acc[ai][0][m][1]), "+v"(acc[ai][1][m][0]), "+v"(acc[ai][1][m][1]));
                if (m & 1) asm volatile("" ::: "memory"); }
        const bool bad1 = bad;
        bad = st2.run(acc, u, wr, wc, fr, fq, lds, wid, lane) || bad;
#pragma unroll
        for (int ai = 0; ai < 2; ++ai)
#pragma unroll
            for (int m = 0; m < 4; ++m) { const int r = ai * HALF + wr * 64 + m * 16 + fr; const f32x2v sr = S[r]; const size_t off = (size_t)(u.pm * BM + r) * ldc + col0;
#pragma unroll
                for (int bj = 0; bj < 2; ++bj)
#pragma unroll
                    for (int n = 0; n < 2; ++n) { const f32x4 x1 = acc[ai][bj][m][n]; *(f32x4*)(out + off + bj * HALF + n * 16) = bad1 ? (f32x4){qnan, qnan, qnan, qnan} : x1;
                        const f32x4 o = (x1 - sr.x) * sr.y; u32x2v w; w.x = cvt_pk_bf16(o[0], o[1]); w.y = cvt_pk_bf16(o[2], o[3]);
                        if (bad) { w.x = 0x7fc07fc0u; w.y = 0x7fc07fc0u; } *(u32x2v*)(xn + off + bj * HALF + n * 16) = w; }
                asm volatile("" ::: "memory"); }
    }
};

template <class Epi, class Sched, bool ALIGN_EPI = false, bool SP2 = false>
__device__ __forceinline__ void gemm_phase(PG8_LAS unsigned char* lds, const Gemm g, const Sched& S, const Epi& E) {
    int tid_l = threadIdx.x; asm volatile("" : "+v"(tid_l));
    const int tid = tid_l, wid = __builtin_amdgcn_readfirstlane(tid >> 6), lane = tid & 63, wr = wid >> 2, wc = wid & 3, fr = lane & 15, fq = lane >> 4;
    const int K = g.K;
    unsigned voffA[2], voffB[2];
#pragma unroll
    for (int i = 0; i < 2; ++i) { int R, C; stage_rc(tid * 16 + i * 8192, R, C); const int Rb = Epi::PERM ? ((R & ~31) + perm32(R & 31)) : R;
        voffA[i] = (unsigned)(R * K + C) * 2u; voffB[i] = (unsigned)(Rb * K + C) * 2u; }
    const size_t kstep = (size_t)(BK * 2);
    const size_t hstep = (size_t)HALF * K * 2;
    const size_t tstep = 2 * hstep;
    const unsigned ldsw = (unsigned)wid * 1024u;
    const int aoff = lds_byte(wr * 64 + fr, fq * 8), boff = lds_byte(wc * 32 + fr, fq * 8);
#define PG8_SA(b, h) (((b) * 2 + (h)) * HTB)
#define PG8_SB(b, h) ((4 + (b) * 2 + (h)) * HTB)
#define PG8_STAGE(bufoff, gbase, voff) do { _Pragma("unroll") for (int _i = 0; _i < 2; ++_i) \
        __builtin_amdgcn_global_load_lds((const unsigned*)((const char*)(gbase) + (voff)[_i]), (PG8_LAS unsigned*)(lds + (bufoff) + ldsw + _i * 8192), 16, 0, 0); } while (0)
#define PG8_LDA(dst, b, h) do { _Pragma("unroll") for (int m = 0; m < 4; ++m) _Pragma("unroll") for (int k = 0; k < 2; ++k) dst[m][k] = *(const PG8_LAS bf16x8*)(lds + PG8_SA(b, h) + aoff + m * 2048 + k * 1024); } while (0)
#define PG8_LDB(dst, b, h) do { _Pragma("unroll") for (int n = 0; n < 2; ++n) _Pragma("unroll") for (int k = 0; k < 2; ++k) dst[n][k] = *(const PG8_LAS bf16x8*)(lds + PG8_SB(b, h) + boff + n * 2048 + k * 1024); } while (0)
#define PG8_MMA(ai, bj, At, Bt) do { __builtin_amdgcn_s_setprio(1); _Pragma("unroll") for (int m = 0; m < 4; ++m) _Pragma("unroll") for (int n = 0; n < 2; ++n) _Pragma("unroll") for (int k = 0; k < 2; ++k) \
        acc[ai][bj][m][n] = __builtin_amdgcn_mfma_f32_16x16x32_bf16(Bt[n][k], At[m][k], acc[ai][bj][m][n], 0, 0, 0); __builtin_amdgcn_s_setprio(0); } while (0)
#define PG8_WAIT_V(n) asm volatile("s_waitcnt vmcnt(" #n ")" ::: "memory")
#define PG8_WAIT_L(n) asm volatile("s_waitcnt lgkmcnt(" #n ")" ::: "memory")
#define PG8_BAR __builtin_amdgcn_s_barrier()
#define PG8_SCHED __builtin_amdgcn_sched_barrier(0)
    Unit cur, nxt; int ui = 0;
    if (!S.next(0, cur)) return;
    f32x4 acc[2][2][4][2];
#pragma unroll
    for (int a = 0; a < 2; ++a)
#pragma unroll
        for (int b = 0; b < 2; ++b)
#pragma unroll
            for (int m = 0; m < 4; ++m)
#pragma unroll
                for (int n = 0; n < 2; ++n) acc[a][b][m][n] = (f32x4){0.f, 0.f, 0.f, 0.f};
    bf16x8 At[4][2], B0[2][2], B1[2][2];
    const char* cA = (const char*)g.A + (size_t)cur.pm * tstep + (size_t)cur.k0 * 2; const char* cB = (const char*)g.Bt + (size_t)cur.pn * tstep + (size_t)cur.k0 * 2;
    S.a_ready(cur);
    if constexpr (SP2) {
        PG8_STAGE(PG8_SB(0, 0), cB, voffB); PG8_STAGE(PG8_SB(0, 1), cB + hstep, voffB); PG8_STAGE(PG8_SA(0, 0), cA, voffA); PG8_STAGE(PG8_SA(0, 1), cA + hstep, voffA);
        if (wr == 1) PG8_BAR;
        PG8_WAIT_V(2); PG8_BAR;
        PG8_STAGE(PG8_SB(1, 0), cB + kstep, voffB); PG8_STAGE(PG8_SA(1, 0), cA + kstep, voffA); PG8_STAGE(PG8_SB(1, 1), cB + hstep + kstep, voffB);
        PG8_WAIT_V(6); PG8_BAR;
    } else {
        PG8_STAGE(PG8_SB(0, 0), cB, voffB); PG8_STAGE(PG8_SA(0, 0), cA, voffA); PG8_STAGE(PG8_SB(0, 1), cB + hstep, voffB); PG8_STAGE(PG8_SA(0, 1), cA + hstep, voffA);
        if (wr == 1) PG8_BAR;
        PG8_WAIT_V(4); PG8_BAR;
        PG8_STAGE(PG8_SB(1, 0), cB + kstep, voffB); PG8_STAGE(PG8_SA(1, 0), cA + kstep, voffA); PG8_STAGE(PG8_SB(1, 1), cB + hstep + kstep, voffB);
        PG8_WAIT_V(6); PG8_BAR;
    }
    for (;;) {
        const bool has_next = S.next(ui + 1, nxt);
        const char* nA = has_next ? (const char*)g.A + (size_t)nxt.pm * tstep + (size_t)nxt.k0 * 2 : cA; const char* nB = has_next ? (const char*)g.Bt + (size_t)nxt.pn * tstep + (size_t)nxt.k0 * 2 : cB;
        const int nt = cur.nk;
        for (int t = 0; t < nt; t += 2) {
            const bool last = (t == nt - 2);
            const char* a1 = cA + (size_t)(t + 1) * kstep;
            const char* a2 = last ? nA : cA + (size_t)(t + 2) * kstep; const char* b2 = last ? nB : cB + (size_t)(t + 2) * kstep;
            const char* a3 = a2 + kstep; const char* b3 = b2 + kstep;
            if (last && has_next) S.a_ready(nxt);
            if constexpr (SP2) {
            PG8_LDB(B0, 0, 0); PG8_LDB(B1, 0, 1); PG8_SCHED; PG8_LDA(At, 0, 0); PG8_STAGE(PG8_SA(1, 1), a1 + hstep, voffA);
            PG8_WAIT_V(8); PG8_WAIT_L(0); PG8_BAR; PG8_MMA(0, 0, At, B0); PG8_MMA(0, 1, At, B1); PG8_BAR; PG8_SCHED;
            PG8_LDA(At, 0, 1); PG8_STAGE(PG8_SB(0, 0), b2, voffB); PG8_STAGE(PG8_SB(0, 1), b2 + hstep, voffB); PG8_STAGE(PG8_SA(0, 0), a2, voffA);
            PG8_WAIT_V(8); PG8_WAIT_L(0); PG8_BAR; PG8_MMA(1, 0, At, B0); PG8_MMA(1, 1, At, B1); PG8_BAR; PG8_SCHED;
            PG8_LDB(B0, 1, 0); PG8_LDB(B1, 1, 1); PG8_SCHED; PG8_LDA(At, 1, 0); PG8_STAGE(PG8_SA(0, 1), a2 + hstep, voffA);
            PG8_WAIT_V(8); PG8_WAIT_L(0); PG8_BAR; PG8_MMA(0, 0, At, B0); PG8_MMA(0, 1, At, B1); PG8_BAR; PG8_SCHED;
            PG8_LDA(At, 1, 1); PG8_STAGE(PG8_SB(1, 0), b3, voffB); PG8_STAGE(PG8_SB(1, 1), b3 + hstep, voffB); PG8_STAGE(PG8_SA(1, 0), a3, voffA);
            PG8_WAIT_V(8); PG8_WAIT_L(0); PG8_BAR; PG8_MMA(1, 0, At, B0); PG8_MMA(1, 1, At, B1); PG8_BAR; PG8_SCHED;
            } else {
            PG8_LDB(B0, 0, 0); PG8_SCHED; PG8_LDA(At, 0, 0); PG8_STAGE(PG8_SA(1, 1), a1 + hstep, voffA);
            PG8_WAIT_L(8); PG8_BAR; PG8_WAIT_L(0); PG8_MMA(0, 0, At, B0); PG8_BAR; PG8_SCHED;
            PG8_LDB(B1, 0, 1); PG8_STAGE(PG8_SB(0, 0), b2, voffB);
            PG8_BAR; PG8_WAIT_L(0); PG8_MMA(0, 1, At, B1); PG8_BAR;
            PG8_LDA(At, 0, 1); PG8_STAGE(PG8_SA(0, 0), a2, voffA);
            PG8_BAR; PG8_WAIT_L(0); PG8_MMA(1, 0, At, B0); PG8_BAR; PG8_SCHED;
            PG8_STAGE(PG8_SB(0, 1), b2 + hstep, voffB);
            PG8_WAIT_V(6); PG8_BAR; PG8_MMA(1, 1, At, B1); PG8_BAR;
            PG8_LDB(B0, 1, 0); PG8_SCHED; PG8_LDA(At, 1, 0); PG8_STAGE(PG8_SA(0, 1), a2 + hstep, voffA);
            PG8_WAIT_L(8); PG8_BAR; PG8_WAIT_L(0); PG8_MMA(0, 0, At, B0); PG8_BAR; PG8_SCHED;
            PG8_LDB(B1, 1, 1); PG8_STAGE(PG8_SB(1, 0), b3, voffB);
            PG8_BAR; PG8_WAIT_L(0); PG8_MMA(0, 1, At, B1); PG8_BAR;
            PG8_LDA(At, 1, 1); PG8_STAGE(PG8_SA(1, 0), a3, voffA);
            PG8_BAR; PG8_WAIT_L(0); PG8_MMA(1, 0, At, B0); PG8_BAR; PG8_SCHED;
            PG8_STAGE(PG8_SB(1, 1), b3 + hstep, voffB);
            PG8_WAIT_V(6); PG8_BAR; PG8_MMA(1, 1, At, B1); PG8_BAR;
            }
        }
        if constexpr (ALIGN_EPI) { if (wr == 0) PG8_BAR; }
        if constexpr (!Epi::AFTER_DRAIN) { E(acc, cur, wr, wc, fr, fq); S.done(cur); }
        if (!has_next) break;
#pragma unroll
        for (int a = 0; a < 2; ++a)
#pragma unroll
            for (int b = 0; b < 2; ++b)
#pragma unroll
                for (int m = 0; m < 4; ++m)
#pragma unroll
                    for (int n = 0; n < 2; ++n) acc[a][b][m][n] = (f32x4){0.f, 0.f, 0.f, 0.f};
        cur = nxt; cA = nA; cB = nB; ++ui;
        if constexpr (ALIGN_EPI) { if (wr == 1) PG8_BAR; }
    }
    PG8_WAIT_V(0);
    if constexpr (!ALIGN_EPI) { if (wr == 0) PG8_BAR; }
    PG8_BAR;
    if constexpr (Epi::AFTER_DRAIN) { E.fused(acc, cur, wr, wc, fr, fq, lds, wid, lane); S.done(cur); }
#undef PG8_SA
#undef PG8_SB
#undef PG8_STAGE
#undef PG8_LDA
#undef PG8_LDB
#undef PG8_MMA
#undef PG8_WAIT_V
#undef PG8_WAIT_L
#undef PG8_BAR
#undef PG8_SCHED
}
}

#include <hip/hip_bf16.h>
#include <cmath>
namespace attn_body {
using bf16=__hip_bfloat16;
using bf16x8=__attribute__((ext_vector_type(8)))short;
using s16x4=__attribute__((ext_vector_type(4)))short;
using f32x16=__attribute__((ext_vector_type(16)))float;
using u32x4=__attribute__((ext_vector_type(4)))unsigned;
constexpr int D=64;
constexpr int NW=8,QBLK=32,QB=QBLK*NW,KVBLK=64;
__device__ __forceinline__ int crow(int r,int hi){return (r&3)+8*(r>>2)+4*hi;}
#define SBAR() __builtin_amdgcn_sched_barrier(0)

__device__ __forceinline__ void na_mask(f32x16&p0,f32x16&p1,int krow,int gr,int c,int hi,const __attribute__((address_space(3))) float* tab,float mhat){
  const float NEG=-INFINITY;
  asm volatile("":"+v"(hi),"+v"(c));
  int rs=gr-4; rs=rs<0?0:(rs>120?120:rs);
  const bool rowok=(unsigned)(krow-rs)<8u;
  if(!rowok){
    #pragma unroll
    for(int r=0;r<16;++r){p0[r]=NEG;p1[r]=NEG;}
  } else {
    int cs=c-8; cs=cs<0?0:(cs>48?48:cs);
    const int tb=(krow-gr+7)*31-c+15;
    #pragma unroll
    for(int r=0;r<16;++r){
      const int kv=crow(r,hi);
      const bool ok0=(unsigned)(kv-cs)<16u, ok1=(unsigned)(kv+32-cs)<16u;
      const float b0=tab[ok0?(tb+kv):0], b1=tab[ok1?(tb+kv+32):0];
      p0[r]=ok0?(b0-mhat):NEG; p1[r]=ok1?(b1-mhat):NEG;
    }
  }
}
constexpr int NSLOT=3, SLOTB=8192;
constexpr int LDS_K=0, LDS_V=NSLOT*SLOTB, LDS_WS=2*NSLOT*SLOTB, LDS_OST=LDS_WS+NW*64*4, LDS_BYTES=LDS_OST+NW*4096;
constexpr float C2=0.125f*1.4426950408889634f;
__device__ __forceinline__ void glds16(const void*gsrc,unsigned lds_dst){unsigned keep;
  asm volatile("s_mov_b32 %0, m0\n\ts_mov_b32 m0, %2\n\ts_nop 0\n\tglobal_load_lds_dwordx4 %1, off\n\ts_mov_b32 m0, %0":"=&s"(keep):"v"(gsrc),"s"(lds_dst):"memory");}
__device__ __forceinline__ float max3f(float a,float b,float c){float r;asm("v_max3_f32 %0, %1, %2, %3":"=v"(r):"v"(a),"v"(b),"v"(c));return r;}
__device__ __forceinline__ float max2f(float a,float b){float r;asm("v_max_f32_e32 %0, %1, %2":"=v"(r):"v"(a),"v"(b));return r;}
__device__ __forceinline__ float fadd_s(float a,float b){float r;asm("v_add_f32_e32 %0, %1, %2":"=v"(r):"v"(a),"v"(b));return r;}
__device__ __forceinline__ float fsub_s(float a,float b){float r;asm("v_sub_f32_e32 %0, %1, %2":"=v"(r):"v"(a),"v"(b));return r;}
typedef float f32x2_t __attribute__((ext_vector_type(2))); typedef __bf16 bf16x2_t __attribute__((ext_vector_type(2)));
__device__ __forceinline__ unsigned cvtpk_s(float lo,float hi){f32x2_t v={lo,hi};bf16x2_t b=__builtin_convertvector(v,bf16x2_t);return __builtin_bit_cast(unsigned,b);}
#define WAIT_BAR(N) asm volatile("s_waitcnt vmcnt(" #N ") lgkmcnt(0)\n\ts_barrier":::"memory")

__device__ __forceinline__ void qkt(f32x16&p0,f32x16&p1,const char*Kslot,const bf16x8*qr,const f32x16&negm,int r32,int hi){
  const char*kb=Kslot+hi*1024+r32*16;
  #pragma unroll
  for(int d0=0;d0<4;++d0){
    const bf16x8 b0=*reinterpret_cast<const bf16x8*>(kb+d0*2048);
    const bf16x8 b1=*reinterpret_cast<const bf16x8*>(kb+d0*2048+512);
    if(d0==0){p0=__builtin_amdgcn_mfma_f32_32x32x16_bf16(b0,qr[0],negm,0,0,0);p1=__builtin_amdgcn_mfma_f32_32x32x16_bf16(b1,qr[0],negm,0,0,0);}
    else{p0=__builtin_amdgcn_mfma_f32_32x32x16_bf16(b0,qr[d0],p0,0,0,0);p1=__builtin_amdgcn_mfma_f32_32x32x16_bf16(b1,qr[d0],p1,0,0,0);}}
}
typedef __attribute__((address_space(3))) const char* lds_cptr;
typedef short v4i16_t __attribute__((ext_vector_type(4)));
__device__ __forceinline__ void kload8(bf16x8*kf,lds_cptr kp){
  kf[0]=*(const __attribute__((address_space(3))) bf16x8*)(kp);      kf[1]=*(const __attribute__((address_space(3))) bf16x8*)(kp+512);
  kf[2]=*(const __attribute__((address_space(3))) bf16x8*)(kp+2048); kf[3]=*(const __attribute__((address_space(3))) bf16x8*)(kp+2560);
  kf[4]=*(const __attribute__((address_space(3))) bf16x8*)(kp+4096); kf[5]=*(const __attribute__((address_space(3))) bf16x8*)(kp+4608);
  kf[6]=*(const __attribute__((address_space(3))) bf16x8*)(kp+6144); kf[7]=*(const __attribute__((address_space(3))) bf16x8*)(kp+6656);
}
__device__ __forceinline__ void kload2(bf16x8*kf,lds_cptr kp,int j){ kf[2*j]=*(const __attribute__((address_space(3))) bf16x8*)(kp+j*2048); kf[2*j+1]=*(const __attribute__((address_space(3))) bf16x8*)(kp+j*2048+512); }
__device__ __forceinline__ s16x4 vtr(lds_cptr p){ return __builtin_bit_cast(s16x4,__builtin_amdgcn_ds_read_tr16_b64_v4i16((__attribute__((address_space(3))) v4i16_t*)p)); }
__device__ __forceinline__ float rowmax(const f32x16&p0,const f32x16&p1){
  float a=max3f(p0[0],p0[1],p1[0]),b=max3f(p0[2],p0[3],p1[1]);a=max3f(a,p1[2],p1[3]);
  #pragma unroll
  for(int r=4;r<16;r+=4){a=max3f(a,p0[r],p0[r+1]);b=max3f(b,p0[r+2],p0[r+3]);a=max3f(a,p1[r],p1[r+1]);b=max3f(b,p1[r+2],p1[r+3]);}
  const float m=max2f(a,b);
  auto rr=__builtin_amdgcn_permlane32_swap(__float_as_uint(m),__float_as_uint(m),false,false);
  return max2f(__uint_as_float(rr[0]),__uint_as_float(rr[1]));
}
__device__ __forceinline__ void pv(f32x16*o,int vb,bf16x8 pa0,bf16x8 pa1,bf16x8 pa2,bf16x8 pa3){
  #pragma unroll
  for(int d0=0;d0<2;++d0){s16x4 lo[4],hi[4];
    #pragma unroll
    for(int ks=0;ks<4;++ks){
      asm volatile("ds_read_b64_tr_b16 %0,%1 offset:%c2":"=&v"(lo[ks]):"v"(vb),"i"(d0*4096+ks*1024):"memory");
      asm volatile("ds_read_b64_tr_b16 %0,%1 offset:%c2":"=&v"(hi[ks]):"v"(vb),"i"(d0*4096+ks*1024+512):"memory");}
    asm volatile("s_waitcnt lgkmcnt(0)":::"memory");SBAR();
    #define PK(k) (bf16x8){lo[k][0],lo[k][1],lo[k][2],lo[k][3],hi[k][0],hi[k][1],hi[k][2],hi[k][3]}
    o[d0]=__builtin_amdgcn_mfma_f32_32x32x16_bf16(pa0,PK(0),o[d0],0,0,0);
    o[d0]=__builtin_amdgcn_mfma_f32_32x32x16_bf16(pa1,PK(1),o[d0],0,0,0);
    o[d0]=__builtin_amdgcn_mfma_f32_32x32x16_bf16(pa2,PK(2),o[d0],0,0,0);
    o[d0]=__builtin_amdgcn_mfma_f32_32x32x16_bf16(pa3,PK(3),o[d0],0,0,0);
    #undef PK
  }
}

#ifndef ATTN_STORE16
#define ATTN_STORE16(p,v) (*(u32x4*)(p)=(v))
#endif
struct NaP { int gr0; int r_lo; const __attribute__((address_space(3))) float* tab; };
template<int THRL,bool NA> __device__ __forceinline__ void attn_unit(const bf16*Qb,const bf16*Kc,const bf16*Vc,bf16*Ob,int kr0,int T0,int kr1,int NT,NaP nap,char*shm){
  constexpr int QP=1792,KP=1792,VP=1792,OP=1024;
  int tid_l=threadIdx.x; asm volatile("":"+v"(tid_l));
  const int tid=tid_l,lane=tid&63,r32=lane&31,hi=lane>>5; const int wid=__builtin_amdgcn_readfirstlane(tid>>6);
  const bf16*Qw=Qb+(long)(wid*QBLK)*QP;
  const unsigned lds0=(unsigned)(uintptr_t)shm;
  float*wsf=(float*)(shm+LDS_WS)+wid*64;
  const bf16*ksrc=Kc+(long)lane*KP+wid*8;
  const bf16*vsrc=Vc+(long)(16*(wid&3)+(lane>>2))*VP+(wid>>2)*32+(lane&3)*8;
  const unsigned kdst=lds0+LDS_K+wid*1024, vdst=lds0+LDS_V+wid*1024;
  #define KROW(t) ((long)(((t)<T0)?(kr0+(t)*KVBLK):(kr1+((t)-T0)*KVBLK)))
  #define DMA_K(t,slot) glds16(ksrc+KROW(t)*KP,(unsigned)__builtin_amdgcn_readfirstlane(kdst+(slot)))
  #define DMA_V(t,slot) glds16(vsrc+KROW(t)*VP,(unsigned)__builtin_amdgcn_readfirstlane(vdst+(slot)))
  const int vb0=(int)(lds0+LDS_V)+((lane>>4)&1)*32+(lane&3)*8+(4*hi+((lane&15)>>2))*64;
  const char*Kbase=shm+LDS_K; bf16x8 kf[8];
  const lds_cptr shm3=(lds_cptr)shm; const lds_cptr kp0=shm3+LDS_K+hi*1024+r32*16; const lds_cptr vp0=shm3+LDS_V+((lane>>4)&1)*32+(lane&3)*8+(4*hi+((lane&15)>>2))*64;
  DMA_K(0,0);DMA_V(0,0);DMA_K(1,SLOTB);
  bf16x8 qr[4];
  #pragma unroll
  for(int d0=0;d0<4;++d0)qr[d0]=*reinterpret_cast<const bf16x8*>(&Qw[(long)r32*QP+d0*16+hi*8]);
  float mhat=0.f,l_reg=0.f;f32x16 o[2];o[0]=f32x16{};o[1]=f32x16{};f32x16 negm=f32x16{};if(!NA)asm volatile("":"+v"(negm));
  #define CMASK(P0,P1,t) do{}while(0)
  #define NAFILL(C0,C1,t) do{ if(NA){ if((t)>=T0) na_mask(C0,C1,nap.r_lo+((t)-T0),nap.gr0+(wid>>1),(wid&1)*32+r32,hi,nap.tab,mhat); else { _Pragma("unroll") for(int r_=0;r_<16;++r_){C0[r_]=-mhat;C1[r_]=-mhat;} } } }while(0)
  bool resc=false;
  #define START(P0,P1) do{ const float rm=rowmax(P0,P1); resc=false; \
    { const float dl=rm; mhat=fadd_s(mhat,dl); \
      _Pragma("unroll") for(int r=0;r<16;++r){P0[r]=fsub_s(P0[r],dl);P1[r]=fsub_s(P1[r],dl);} \
      if(!NA){ _Pragma("unroll") for(int r=0;r<16;++r)negm[r]=-mhat; asm volatile("":"+v"(negm)); } } \
    _Pragma("unroll") for(int r=0;r<16;++r)P0[r]=__builtin_amdgcn_exp2f(P0[r]); }while(0)
  #define RESC() do{ if(resc){ asm volatile("s_waitcnt lgkmcnt(0)":::"memory"); \
      _Pragma("unroll") for(int d_=0;d_<2;++d_) _Pragma("unroll") for(int r=0;r<16;++r)o[d_][r]*=wsf[crow(r,hi)]; } }while(0)
  f32x16 pA0,pA1,pB0,pB1;
  int sl_prev=0,sl_cur=0,sl_next=SLOTB;
  #define ROT() do{sl_prev=sl_cur;sl_cur=sl_next;sl_next=(sl_next==(NSLOT-1)*SLOTB)?0:sl_next+SLOTB;}while(0)
  DMA_K(2,2*SLOTB);
  WAIT_BAR(3);
  qkt(pA0,pA1,Kbase,qr,negm,r32,hi);asm volatile("s_nop 15\n\ts_nop 7":"+v"(pA0),"+v"(pA1));CMASK(pA0,pA1,0);
  START(pA0,pA1);
  _Pragma("unroll") for(int r=0;r<16;++r)pA1[r]=__builtin_amdgcn_exp2f(pA1[r]);
  WAIT_BAR(0);
  DMA_K(3,0);DMA_V(1,SLOTB);
  ROT();
  kload8(kf,kp0+sl_cur);
  WAIT_BAR(2);
  s16x4 vlo[8],vhi[8]; u32x4 pw0,pw1,pw2,pw3;
  #define PKW(P,B) cvtpk_s(P[B],P[B+1])
  #define PAF(k) __builtin_bit_cast(bf16x8,pw##k)
  #define VFR(i) (bf16x8){vlo[i][0],vlo[i][1],vlo[i][2],vlo[i][3],vhi[i][0],vhi[i][1],vhi[i][2],vhi[i][3]}
  #define PIN(x) asm volatile("":"+v"(x))
  #define MX3(a,b,c) __builtin_fmaxf(__builtin_fmaxf((a),(b)),(c))
  #define GAPA(MF,A0,A1,A2,A3,W0,W1,PW) do{ MF; sacc+=A0; sacc+=A1; sacc+=A2; sacc+=A3; PIN(sacc); W0; W1; PIN(PW); SBAR(); }while(0)
  #define EX(v) __builtin_amdgcn_exp2f(v)
  #define GAPB(MF,X,B) do{ MF; X[B]=EX(X[B]); X[B+1]=EX(X[B+1]); X[B+2]=EX(X[B+2]); X[B+3]=EX(X[B+3]); PIN(X); SBAR(); }while(0)
  #define VRD(i) do{ vlo[i]=vtr(vp_+(((i)>>2)*4096+((i)&3)*1024)); vhi[i]=vtr(vp_+(((i)>>2)*4096+((i)&3)*1024+512)); }while(0)
  #define KRD(G,j) do{ if(G){ kload2(kf,kp0+sl_next,j); SBAR(); } }while(0)
  #define STEP(C0,C1,P0,P1,t,GK,GV,GL) do{ SBAR(); NAFILL(C0,C1,t); SBAR(); \
    const lds_cptr vp_=vp0+sl_prev; \
    VRD(0); SBAR(); float sacc=(P0[0]+P0[1]); \
    GAPA(C0=__builtin_amdgcn_mfma_f32_32x32x16_bf16(kf[0],qr[0],(NA?C0:negm),0,0,0), P0[2],P0[3],P0[4],P0[5],     pw0[0]=PKW(P0,0), pw0[1]=PKW(P0,2), pw0); \
    VRD(4); SBAR(); GAPA(C1=__builtin_amdgcn_mfma_f32_32x32x16_bf16(kf[1],qr[0],(NA?C1:negm),0,0,0), P0[6],P0[7],P0[8],P0[9],     pw0[2]=PKW(P0,4), pw0[3]=PKW(P0,6), pw0); \
    VRD(1); SBAR(); GAPA(C0=__builtin_amdgcn_mfma_f32_32x32x16_bf16(kf[2],qr[1],C0,0,0,0),   P0[10],P0[11],P0[12],P0[13], pw1[0]=PKW(P0,8), pw1[1]=PKW(P0,10), pw1); \
    VRD(5); SBAR(); GAPA(C1=__builtin_amdgcn_mfma_f32_32x32x16_bf16(kf[3],qr[1],C1,0,0,0),   P0[14],P0[15],P1[0],P1[1],   pw1[2]=PKW(P0,12),pw1[3]=PKW(P0,14), pw1); \
    VRD(2); SBAR(); GAPA(C0=__builtin_amdgcn_mfma_f32_32x32x16_bf16(kf[4],qr[2],C0,0,0,0),   P1[2],P1[3],P1[4],P1[5],     pw2[0]=PKW(P1,0), pw2[1]=PKW(P1,2), pw2); \
    VRD(6); SBAR(); GAPA(C1=__builtin_amdgcn_mfma_f32_32x32x16_bf16(kf[5],qr[2],C1,0,0,0),   P1[6],P1[7],P1[8],P1[9],     pw2[2]=PKW(P1,4), pw2[3]=PKW(P1,6), pw2); \
    VRD(3); SBAR(); GAPA(C0=__builtin_amdgcn_mfma_f32_32x32x16_bf16(kf[6],qr[3],C0,0,0,0),   P1[10],P1[11],P1[12],P1[13], pw3[0]=PKW(P1,8), pw3[1]=PKW(P1,10), pw3); \
    VRD(7); SBAR(); GAPA(C1=__builtin_amdgcn_mfma_f32_32x32x16_bf16(kf[7],qr[3],C1,0,0,0),   P1[14],P1[15],0.f,0.f,       pw3[2]=PKW(P1,12),pw3[3]=PKW(P1,14), pw3); \
    l_reg+=sacc; \
    if(GK){DMA_K((t)+3,sl_cur);} if(GV){DMA_V((t)+1,sl_next);} \
    CMASK(C0,C1,t); \
    { float a=MX3(C0[0],C0[1],C1[0]),b=MX3(C0[2],C0[3],C1[1]); a=MX3(a,C1[2],C1[3]); \
      _Pragma("unroll") for(int r=4;r<16;r+=4){a=MX3(a,C0[r],C0[r+1]);b=MX3(b,C0[r+2],C0[r+3]);a=MX3(a,C1[r],C1[r+1]);b=MX3(b,C1[r+2],C1[r+3]);} \
      float rm=__builtin_fmaxf(a,b); { auto rr=__builtin_amdgcn_permlane32_swap(__float_as_uint(rm),__float_as_uint(rm),false,false); rm=__builtin_fmaxf(__uint_as_float(rr[0]),__uint_as_float(rr[1])); } \
      resc=false; \
      if(__builtin_expect(__any(rm>(float)THRL),0)){ const float dl=__builtin_fmaxf(rm,0.f); mhat+=dl; \
        _Pragma("unroll") for(int r=0;r<16;++r){C0[r]-=dl;C1[r]-=dl;} \
        if(!NA){ _Pragma("unroll") for(int r=0;r<16;++r)negm[r]=-mhat; asm volatile("":"+v"(negm)); } \
        const float f=__builtin_amdgcn_exp2f(-dl); l_reg*=f; if(hi==0)wsf[r32]=f; resc=true; } } \
    SBAR(); \
    GAPB(o[0]=__builtin_amdgcn_mfma_f32_32x32x16_bf16(PAF(0),VFR(0),o[0],0,0,0), C0,0); \
    GAPB(o[1]=__builtin_amdgcn_mfma_f32_32x32x16_bf16(PAF(0),VFR(4),o[1],0,0,0), C0,4); \
    KRD(GL,0); GAPB(o[0]=__builtin_amdgcn_mfma_f32_32x32x16_bf16(PAF(1),VFR(1),o[0],0,0,0), C0,8); \
    KRD(GL,1); GAPB(o[1]=__builtin_amdgcn_mfma_f32_32x32x16_bf16(PAF(1),VFR(5),o[1],0,0,0), C0,12); \
    KRD(GL,2); GAPB(o[0]=__builtin_amdgcn_mfma_f32_32x32x16_bf16(PAF(2),VFR(2),o[0],0,0,0), C1,0); \
    KRD(GL,3); GAPB(o[1]=__builtin_amdgcn_mfma_f32_32x32x16_bf16(PAF(2),VFR(6),o[1],0,0,0), C1,4); \
    GAPB(o[0]=__builtin_amdgcn_mfma_f32_32x32x16_bf16(PAF(3),VFR(3),o[0],0,0,0), C1,8); \
    GAPB(o[1]=__builtin_amdgcn_mfma_f32_32x32x16_bf16(PAF(3),VFR(7),o[1],0,0,0), C1,12); \
    }while(0)
  int t=1;
  for(;t+5<NT;t+=2){
    STEP(pB0,pB1,pA0,pA1,t,true,true,true);     WAIT_BAR(2); RESC(); ROT();
    STEP(pA0,pA1,pB0,pB1,t+1,true,true,true);   WAIT_BAR(2); RESC(); ROT();
  }
  #define ENDW(tt) do{ if((tt)+3<NT){WAIT_BAR(2);} else if((tt)+2<NT){WAIT_BAR(1);} else {WAIT_BAR(0);} }while(0)
  for(;t+1<NT;t+=2){
    STEP(pB0,pB1,pA0,pA1,t,(t+3<NT),(t+1<NT),(t+1<NT));       ENDW(t);   RESC(); ROT();
    STEP(pA0,pA1,pB0,pB1,t+1,(t+4<NT),(t+2<NT),(t+2<NT));     ENDW(t+1); RESC(); ROT();
  }
  STEP(pB0,pB1,pA0,pA1,NT-1,false,false,false); RESC();
  { float sacc=pB0[0]+pB0[1]; _Pragma("unroll") for(int r=2;r<16;++r)sacc+=pB0[r]; _Pragma("unroll") for(int r=0;r<16;++r)sacc+=pB1[r]; l_reg+=sacc;
    pw0=(u32x4){PKW(pB0,0),PKW(pB0,2),PKW(pB0,4),PKW(pB0,6)};pw1=(u32x4){PKW(pB0,8),PKW(pB0,10),PKW(pB0,12),PKW(pB0,14)};pw2=(u32x4){PKW(pB1,0),PKW(pB1,2),PKW(pB1,4),PKW(pB1,6)};pw3=(u32x4){PKW(pB1,8),PKW(pB1,10),PKW(pB1,12),PKW(pB1,14)};
    SBAR(); pv(o,vb0+sl_cur,PAF(0),PAF(1),PAF(2),PAF(3)); }
  #undef PKW
  #undef PAF
  #undef VFR
  #undef PIN
  #undef MX3
  #undef GAPA
  #undef GAPB
  #undef EX
  #undef VRD
  #undef KRD
  #undef STEP
  #undef ENDW
  {auto rr=__builtin_amdgcn_permlane32_swap(__float_as_uint(l_reg),__float_as_uint(l_reg),false,false);l_reg=__uint_as_float(rr[0])+__uint_as_float(rr[1]);}
  if(hi==0)wsf[32+r32]=l_reg;asm volatile("s_waitcnt lgkmcnt(0)":::"memory");
  float rli[16];
  #pragma unroll
  for(int r=0;r<16;++r)rli[r]=__builtin_amdgcn_rcpf(wsf[32+crow(r,hi)]);
  bf16*Ow=Ob+(long)(wid*QBLK)*OP;
  { bf16*stg=(bf16*)(shm+LDS_OST)+wid*2048;
    #pragma unroll
    for(int r=0;r<16;++r){const int orow=crow(r,hi);
      #pragma unroll
      for(int d0=0;d0<2;++d0)stg[orow*64+d0*32+r32]=__float2bfloat16(o[d0][r]*rli[r]);}
    asm volatile("s_waitcnt lgkmcnt(0)":::"memory");
    #pragma unroll
    for(int i=0;i<4;++i){const int row=i*8+(lane>>3),ch=lane&7; const u32x4 v=*(const u32x4*)(stg+row*64+ch*8); ATTN_STORE16(Ow+(long)row*OP+ch*8,v);} }
  asm volatile("s_waitcnt lgkmcnt(0)\n\ts_barrier":::"memory");
  #undef DMA_K
  #undef KROW
  #undef DMA_V
  #undef CMASK
  #undef NAFILL
  #undef START
  #undef RESC
  #undef ROT
}
constexpr int ATTN_LDS_BYTES=LDS_BYTES;
#undef SBAR
#undef WAIT_BAR
}

#include <hip/hip_cooperative_groups.h>
namespace cg = cooperative_groups;

#ifndef PHMASK
#define PHMASK 0xffff
#endif
#ifndef REPEAT_MASK
#define REPEAT_MASK 0
#endif
#ifndef EXTRA_SYNCS
#define EXTRA_SYNCS 0
#endif
#ifndef MK_N_LAUNCHES
#define MK_N_LAUNCHES 1
#endif

#define GAS __attribute__((address_space(1)))
#define LAS __attribute__((address_space(3)))
typedef unsigned short bf16r;
typedef float f32x4 __attribute__((ext_vector_type(4)));
typedef float f32x2 __attribute__((ext_vector_type(2)));
typedef unsigned u32x2 __attribute__((ext_vector_type(2)));
typedef unsigned u32x4 __attribute__((ext_vector_type(4)));

constexpr int DM = 1024, NB = 2, SEQ = 8192, CTXL = 256, DEPTH = 2;
constexpr int ML = NB * SEQ;
constexpr int MC = NB * CTXL;
constexpr int MT = ML + MC;
constexpr int INW = 3072, FFH = 2816, FF2 = 5632, NMOD = 6 * DM;
constexpr float LN_EPS = 1e-6f, DN_ALPHA = 1.4142135623730951f;
constexpr float LOG2E = 1.4426950408889634f, QSCALE = 0.125f * LOG2E;
constexpr int NSUB = 10;
constexpr int NCHUNK = 132, NCHAIN = 16, NHU = NCHAIN * NCHUNK;

constexpr size_t MiB = 1u << 20;
constexpr size_t WS_MODS = 1 * MiB;
constexpr size_t WS_LB = WS_MODS + 160 * 1024;
constexpr size_t WS_ROPE = WS_LB + 8 * 1024;
constexpr size_t WS_WIN = 2 * MiB;
constexpr size_t WS_WOUT = 14 * MiB;
constexpr size_t WS_WF1 = 18 * MiB;
constexpr size_t WS_WF2 = 40 * MiB;
constexpr size_t WS_XCTX = 51 * MiB;
constexpr size_t WS_H = 53 * MiB;
constexpr size_t WS_P = 86 * MiB;
constexpr size_t ROWS2 = (size_t)MT * 2;
constexpr int QKVP = 1792;
constexpr int CGQ = 0, CGK = 384, CGV = 512, CNQ = 640, CNK = 1024, CNV = 1408;
constexpr size_t WS_QKV = WS_P;
constexpr size_t WS_NV_END = WS_QKV + ROWS2 * QKVP;
constexpr size_t WS_HQ = WS_NV_END;
constexpr size_t WS_HI = WS_HQ + ROWS2 * 256;
constexpr size_t WS_HG = WS_HI + ROWS2 * 256;
constexpr size_t WS_HF = WS_HG + ROWS2 * 256;
constexpr size_t WS_HB = WS_HF + ROWS2 * 512;
constexpr size_t WS_PEND = WS_HB + ROWS2 * 512;
constexpr size_t WS_HH = WS_P;
constexpr size_t WS_PART = 177 * MiB;
constexpr size_t WS_SST = 202 * MiB;
constexpr size_t WS_ADEC = 235 * MiB;
constexpr size_t WS_END = 236 * MiB;
static_assert(WS_PEND <= WS_SST && WS_HH + ROWS2 * FFH <= WS_SST && WS_SST + (size_t)NHU * 4096 * 4 <= WS_ADEC, "ws map");

constexpr int LDS_BYTES = 147456 + 256;
constexpr int BARST_OFF = 147456;
constexpr size_t WS_BAR = 0, BAR_ZERO_BYTES = 16384;
constexpr int NA_TAB_OFF = 90112;

struct Args { const float* in[17]; float* out; unsigned char* ws; int ph_lo, ph_hi; };

__device__ __forceinline__ unsigned pk_bf16(float lo, float hi) { f32x2 v = {lo, hi}; typedef __bf16 bf2 __attribute__((ext_vector_type(2))); bf2 b = __builtin_convertvector(v, bf2); return __builtin_bit_cast(unsigned, b); }
__device__ __forceinline__ float bf2f(bf16r v) { return __builtin_bit_cast(float, (unsigned)v << 16); }
__device__ __forceinline__ float silu_f(float x) { return x / (1.f + __expf(-x)); }
__device__ __forceinline__ float wave_sum(float v) {
#pragma unroll
    for (int o = 1; o < 64; o <<= 1) v += __shfl_xor(v, o);
    return v;
}
__device__ __forceinline__ float sum_kq4(float x) {
    auto r1 = __builtin_amdgcn_permlane16_swap(__float_as_uint(x), __float_as_uint(x), false, false); float y = __uint_as_float(r1[0]) + __uint_as_float(r1[1]);
    auto r2 = __builtin_amdgcn_permlane32_swap(__float_as_uint(y), __float_as_uint(y), false, false); return __uint_as_float(r2[0]) + __uint_as_float(r2[1]);
}
#define DPP_ADD(x, ctrl) ((x) + __uint_as_float((unsigned)__builtin_amdgcn_update_dpp(0, (int)__float_as_uint(x), (ctrl), 0xf, 0xf, false)))
__device__ __forceinline__ float sum_row16(float x) { x = DPP_ADD(x, 0xB1); x = DPP_ADD(x, 0x4E); x = DPP_ADD(x, 0x124); x = DPP_ADD(x, 0x128); return x; }
__device__ __forceinline__ int seg_of_row(int r) { return r < SEQ ? 0 : (r < ML ? 1 : 2); }
__device__ __forceinline__ float* xrow_ptr(float* out, float* xctx, int r) { return r < ML ? out + (size_t)r * DM : xctx + (size_t)(r - ML) * DM; }

struct EpiIn {
    static constexpr bool PERM = false, AFTER_DRAIN = false;
    bf16r *HQ, *HI, *HG, *QKV; float *HF, *HB;
    const float *lb, *qn, *kn; const f32x2* rope;
    __device__ __forceinline__ static void st_bf16(bf16r* p, const f32x4 v) { u32x2 w; w.x = pk_bf16(v[0], v[1]); w.y = pk_bf16(v[2], v[3]); *(u32x2*)p = w; }
    __device__ __forceinline__ void operator()(const pg8::f32x4 (&acc)[2][2][4][2], const pg8::Unit& u, int wr, int wc, int fr, int fq) const {
        const int grp = 4 * u.pn + wc;
#pragma unroll
        for (int ai = 0; ai < 2; ++ai)
#pragma unroll
            for (int m = 0; m < 4; ++m) {
                const int r = u.pm * 256 + ai * 128 + wr * 64 + m * 16 + fr;
                f32x4 v[2][2];
#pragma unroll
                for (int bj = 0; bj < 2; ++bj)
#pragma unroll
                    for (int n = 0; n < 2; ++n) { v[bj][n][0] = acc[ai][bj][m][n][0]; v[bj][n][1] = acc[ai][bj][m][n][1]; v[bj][n][2] = acc[ai][bj][m][n][2]; v[bj][n][3] = acc[ai][bj][m][n][3]; }
                if (grp < 20) {
                    const int part = grp >> 2, hc = (grp & 3) * 64;
                    if (part == 1 || part == 2) {
                        float* dst = (part == 1 ? HF : HB) + (size_t)r * 256 + hc;
                        const float* lbp = lb + (part - 1) * 256 + hc;
#pragma unroll
                        for (int bj = 0; bj < 2; ++bj)
#pragma unroll
                            for (int n = 0; n < 2; ++n) { const int d = 32 * bj + 16 * n + 4 * fq; const f32x4 l4 = *(const f32x4*)(lbp + d); f32x4 o;
#pragma unroll
                                for (int e = 0; e < 4; ++e) { const float sg = 1.f / (1.f + expf(-v[bj][n][e])); o[e] = l4[e] + (1.f - l4[e]) * sg; }
                                *(f32x4*)(dst + d) = o; }
                    } else {
                        bf16r* dst = (part == 0 ? HQ : (part == 3 ? HI : HG)) + (size_t)r * 256 + hc;
#pragma unroll
                        for (int bj = 0; bj < 2; ++bj)
#pragma unroll
                            for (int n = 0; n < 2; ++n) { const int d = 32 * bj + 16 * n + 4 * fq; f32x4 o = v[bj][n];
                                if (part != 3) {
#pragma unroll
                                    for (int e = 0; e < 4; ++e) o[e] = silu_f(o[e]); }
                                st_bf16(dst + d, o); }
                    }
                } else if (grp < 28) {
                    const bool isq = grp < 26; const int hh = isq ? grp - 20 : grp - 26;
                    const float* gn = isq ? qn : kn;
                    float ss = 0.f;
#pragma unroll
                    for (int bj = 0; bj < 2; ++bj)
#pragma unroll
                        for (int n = 0; n < 2; ++n)
#pragma unroll
                            for (int e = 0; e < 4; ++e) ss += v[bj][n][e] * v[bj][n][e];
                    ss += __shfl_xor(ss, 16); ss += __shfl_xor(ss, 32);
                    const float rn = 1.f / sqrtf(ss * (1.f / 64.f) + LN_EPS);
                    const float osc = isq ? QSCALE : 1.f;
                    bf16r* dst = QKV + (size_t)r * QKVP + (isq ? CGQ : CGK) + hh * 64;
                    const bool lat = r < ML; const int t = r & (SEQ - 1);
#pragma unroll
                    for (int bj = 0; bj < 2; ++bj) {
                        const int pos = bj ? (t & 63) : (t >> 6);
#pragma unroll
                        for (int n = 0; n < 2; ++n) { const int d = 32 * bj + 16 * n + 4 * fq; const f32x4 g4 = *(const f32x4*)(gn + d); f32x4 o;
#pragma unroll
                            for (int e = 0; e < 4; ++e) o[e] = v[bj][n][e] * rn * g4[e];
                            if (lat) {
#pragma unroll
                                for (int pp = 0; pp < 2; ++pp) { const f32x2 cs = rope[pos * 16 + 8 * n + 2 * fq + pp]; const float x1 = o[2 * pp], x2 = o[2 * pp + 1];
                                    o[2 * pp] = x1 * cs.x - x2 * cs.y; o[2 * pp + 1] = x1 * cs.y + x2 * cs.x; } }
                            o = o * osc; st_bf16(dst + d, o); }
                    }
                } else {
                    bf16r* dst; float osc = 1.f;
                    if (grp < 30) dst = QKV + (size_t)r * QKVP + CGV + (grp - 28) * 64;
                    else if (grp < 36) { dst = QKV + (size_t)r * QKVP + CNQ + (grp - 30) * 64; osc = QSCALE; }
                    else if (grp < 42) dst = QKV + (size_t)r * QKVP + CNK + (grp - 36) * 64;
                    else dst = QKV + (size_t)r * QKVP + CNV + (grp - 42) * 64;
#pragma unroll
                    for (int bj = 0; bj < 2; ++bj)
#pragma unroll
                        for (int n = 0; n < 2; ++n) { const int d = 32 * bj + 16 * n + 4 * fq; st_bf16(dst + d, v[bj][n] * osc); }
                }
            }
    }
};
struct CtxSliceOrder {
    pg8::StaticOrder so; int c, nsl, spu;
    __device__ void init(int G, int c_, int K, bool ctx) { so.init(ML, DM, G, c_, K); c = c_; spu = K / 128; nsl = ctx ? 8 * spu : 0; }
    __device__ bool next(int i, pg8::Unit& u) const {
        const bool hs = c < nsl;
        if (hs && i == 0) { const int su = c / spu, sl = c % spu; u.pm = 64 + (su >> 2); u.pn = su & 3; u.k0 = sl * 128; u.nk = 2; return true; }
        if (hs) --i;
        return so.next(i, u);
    }
    __device__ __forceinline__ void a_ready(const pg8::Unit&) const {}
    __device__ __forceinline__ void done(const pg8::Unit&) const {}
};
struct EpiRes {
    static constexpr bool PERM = false, AFTER_DRAIN = false;
    float* out; float* xctx; const float* gate; float* dry; float* part;
    __device__ __forceinline__ void operator()(const pg8::f32x4 (&acc)[2][2][4][2], const pg8::Unit& u, int wr, int wc, int fr, int fq) const {
        if (u.pm >= 64) {
            float* rp = part + ((size_t)(u.k0 >> 7) * MC + (size_t)(u.pm - 64) * 256 + wr * 64 + fr) * DM + u.pn * 256 + wc * 32 + 4 * fq;
#pragma unroll
            for (int ai = 0; ai < 2; ++ai)
#pragma unroll
                for (int m = 0; m < 4; ++m) {
#pragma unroll
                    for (int bj = 0; bj < 2; ++bj)
#pragma unroll
                        for (int n = 0; n < 2; ++n) { f32x4 a; a[0] = acc[ai][bj][m][n][0]; a[1] = acc[ai][bj][m][n][1]; a[2] = acc[ai][bj][m][n][2]; a[3] = acc[ai][bj][m][n][3]; *(f32x4*)(rp + bj * 128 + n * 16) = a; }
                    rp += (m == 3 ? 80 : 16) * DM; asm volatile("" : "+v"(rp)); }
            return;
        }
        const int sg = seg_of_row(u.pm * 256);
        const float* gp = gate + sg * NMOD + u.pn * 256 + wc * 32 + 4 * fq;
        f32x4 g4[2][2];
#pragma unroll
        for (int bj = 0; bj < 2; ++bj)
#pragma unroll
            for (int n = 0; n < 2; ++n) g4[bj][n] = *(const f32x4*)(gp + bj * 128 + n * 16);
#pragma unroll
        for (int ai = 0; ai < 2; ++ai)
#pragma unroll
            for (int m = 0; m < 4; ++m) {
                const int r = u.pm * 256 + ai * 128 + wr * 64 + m * 16 + fr;
                float* xp = xrow_ptr(out, xctx, r) + u.pn * 256 + wc * 32 + 4 * fq;
#pragma unroll
                for (int bj = 0; bj < 2; ++bj)
#pragma unroll
                    for (int n = 0; n < 2; ++n) { float* p = xp + bj * 128 + n * 16; const f32x4 x4 = *(const f32x4*)p; f32x4 a; a[0] = acc[ai][bj][m][n][0]; a[1] = acc[ai][bj][m][n][1]; a[2] = acc[ai][bj][m][n][2]; a[3] = acc[ai][bj][m][n][3];
                        float* q = dry ? dry + (size_t)(r & 8191) * DM + (p - xrow_ptr(out, xctx, r)) : p; *(f32x4*)q = x4 * DN_ALPHA + g4[bj][n] * a; }
                asm volatile("" ::: "memory");
            }
    }
};
struct EpiSwiglu {
    static constexpr bool PERM = false, AFTER_DRAIN = false;
    bf16r* HH;
    __device__ __forceinline__ void operator()(const pg8::f32x4 (&acc)[2][2][4][2], const pg8::Unit& u, int wr, int wc, int fr, int fq) const {
#pragma unroll
        for (int ai = 0; ai < 2; ++ai)
#pragma unroll
            for (int m = 0; m < 4; ++m) {
                const int r = u.pm * 256 + ai * 128 + wr * 64 + m * 16 + fr;
                bf16r* hp = HH + (size_t)r * FFH + u.pn * 128 + wc * 32 + 4 * fq;
#pragma unroll
                for (int n = 0; n < 2; ++n) { f32x4 o;
#pragma unroll
                    for (int e = 0; e < 4; ++e) o[e] = silu_f(acc[ai][0][m][n][e]) * acc[ai][1][m][n][e];
                    u32x2 w; w.x = pk_bf16(o[0], o[1]); w.y = pk_bf16(o[2], o[3]); *(u32x2*)(hp + n * 16) = w; }
            }
    }
};

__device__ __forceinline__ void transpose_item(const float* W, int K, int N, bf16r* WT, int mode, LAS float* scr, int item, int lane) {
    const int nblk = N / 32, kb = item / nblk, nb = item % nblk, k0 = 64 * kb, n0 = 32 * nb;
#pragma unroll 8
    for (int i = 0; i < 32; ++i) { const int kk = 2 * i + (lane >> 5); scr[kk * 33 + (lane & 31)] = W[(size_t)(k0 + kk) * N + n0 + (lane & 31)]; }
    asm volatile("s_waitcnt lgkmcnt(0)" ::: "memory");
    int ro = n0;
    if (mode == 1) ro = (n0 & ~255) + 128 * ((n0 & 63) >> 5) + 32 * ((n0 & 255) >> 6);
    else if (mode == 2) { const int up = n0 >= FFH, j = up ? n0 - FFH : n0; ro = 256 * (j >> 7) + 128 * up + (j & 127); }
    const int c = lane & 7;
#pragma unroll
    for (int j = 0; j < 4; ++j) { const int n = (lane >> 3) + 8 * j; const LAS float* s = scr + (8 * c) * 33 + n;
        u32x4 o; o.x = pk_bf16(s[0 * 33], s[1 * 33]); o.y = pk_bf16(s[2 * 33], s[3 * 33]); o.z = pk_bf16(s[4 * 33], s[5 * 33]); o.w = pk_bf16(s[6 * 33], s[7 * 33]);
        *(u32x4*)(WT + (size_t)(ro + n) * K + k0 + 8 * c) = o; }
    asm volatile("s_waitcnt lgkmcnt(0)" ::: "memory");
}

#define RLX_AGENT __ATOMIC_RELAXED, __HIP_MEMORY_SCOPE_AGENT
#define LDS_WAIT() asm volatile("s_waitcnt lgkmcnt(0)" ::: "memory")
#define VM_WAIT() asm volatile("s_waitcnt vmcnt(0)" ::: "memory")
__device__ __forceinline__ unsigned long long rt() { return __builtin_amdgcn_s_memrealtime(); }
#define XB_TMO      128
#define XB_XCNT(j)  (256  + 64 * (j))
#define XB_XSUB(j)  (1280 + 64 * (j))
#define XB_XGEN(j)  (2304 + 64 * (j))
#define XB_TOP      3328
#define XB_TOPGEN   3392
#define XCD_BAR_WORDS 3456
#define XB_SPIN_CAP (1u << 18)

__device__ __forceinline__ unsigned xb_ld(unsigned* p)              { return __hip_atomic_load(p, __ATOMIC_RELAXED, __HIP_MEMORY_SCOPE_AGENT); }
__device__ __forceinline__ unsigned xb_add(unsigned* p, unsigned v) { return __hip_atomic_fetch_add(p, v, __ATOMIC_RELAXED, __HIP_MEMORY_SCOPE_AGENT); }
__device__ __forceinline__ unsigned xb_xcc_id() { return (unsigned)__builtin_amdgcn_s_getreg((3 << 11) | 20) & 0xFu; }
#define XB_SPIN(cond, bar) do { unsigned _sp = 0; while (cond) { __builtin_amdgcn_s_sleep(1); \
    if ((++_sp & 255u) == 0u) { if (xb_ld(&(bar)[XB_TMO])) break; if (_sp > XB_SPIN_CAP) { atomicAdd(&(bar)[XB_TMO], 1u); break; } } } } while (0)

struct XcdBarrier {
    unsigned* bar; unsigned x;
    volatile LAS unsigned* st;
};

__device__ __forceinline__ XcdBarrier xcd_barrier_post(unsigned* bar, volatile LAS unsigned* st) {
    XcdBarrier b; b.bar = bar; b.x = xb_xcc_id(); b.st = st;
    if (threadIdx.x == 0) (void)xb_add(&bar[XB_XCNT(b.x)], 1u);
    return b;
}
__device__ __forceinline__ void xcd_barrier_complete(unsigned* bar, unsigned x, unsigned& nloc, unsigned& nx) {
    const unsigned G = gridDim.x * gridDim.y * gridDim.z;
    unsigned sum, cnt, mine, sp = 0u;
    for (;;) {
        sum = 0u; cnt = 0u; mine = 0u;
#pragma unroll
        for (unsigned j = 0; j < 16; ++j) { const unsigned c = xb_ld(&bar[XB_XCNT(j)]); sum += c; cnt += (c > 0u) ? 1u : 0u; mine = (j == x) ? c : mine; }
        if (sum == G) break;
        __builtin_amdgcn_s_sleep(1);
        if ((++sp & 255u) == 0u) { if (xb_ld(&bar[XB_TMO])) break; if (sp > XB_SPIN_CAP) { atomicAdd(&bar[XB_TMO], 1u); break; } }
    }
    nloc = mine > 0u ? mine : 1u; nx = cnt > 0u ? cnt : 1u;
}

__device__ __forceinline__ void xcd_barrier(const XcdBarrier& b) {
    asm volatile("s_waitcnt vmcnt(0)" ::: "memory");
    __syncthreads();
    if (threadIdx.x == 0) {
        unsigned* bar = b.bar;
        __builtin_amdgcn_s_waitcnt(0);
        unsigned nloc = b.st[0], nx = b.st[1];
        if (nloc == 0u) { xcd_barrier_complete(bar, b.x, nloc, nx); b.st[0] = nloc; b.st[1] = nx; }
        const unsigned old = xb_add(&bar[XB_XSUB(b.x)], 1u);
        const unsigned gen = old / nloc;
        if (old + 1u == (gen + 1u) * nloc) {
            __builtin_amdgcn_fence(__ATOMIC_RELEASE, "agent");
            asm volatile("s_waitcnt vmcnt(0)" ::: "memory");
            const unsigned og = xb_add(&bar[XB_TOP], 1u);
            const unsigned tg = og / nx;
            if (og + 1u == (tg + 1u) * nx) xb_add(&bar[XB_TOPGEN], 1u);
            else XB_SPIN(xb_ld(&bar[XB_TOPGEN]) == tg, bar);
            __builtin_amdgcn_fence(__ATOMIC_ACQUIRE, "agent");
            xb_add(&bar[XB_XGEN(b.x)], 1u);
            asm volatile("s_waitcnt vmcnt(0)" ::: "memory");
        } else {
            XB_SPIN(xb_ld(&bar[XB_XGEN(b.x)]) == gen, bar);
            __builtin_amdgcn_fence(__ATOMIC_ACQUIRE, "agent");
            asm volatile("s_waitcnt vmcnt(0)" ::: "memory");
        }
    }
    __syncthreads();
}

__global__ void __launch_bounds__(512) hybrid_fwd(Args args) {
    extern __shared__ __attribute__((aligned(16))) unsigned char lds[];
    LAS unsigned char* L = (LAS unsigned char*)lds;
    const int G = gridDim.x, bx = blockIdx.x, NGW = G * 8;
    cg::grid_group grid = cg::this_grid();
    if (threadIdx.x < 64) ((LAS unsigned*)(L + BARST_OFF))[threadIdx.x] = 0u;
    __syncthreads();
    const XcdBarrier xbar = xcd_barrier_post((unsigned*)(args.ws + WS_BAR), (volatile LAS unsigned*)(L + BARST_OFF));
    int nsync_ = 0;
#define GRID_SEAM() do { if (args.ph_lo < 0) { __syncthreads(); grid.sync(); } xcd_barrier(xbar); ++nsync_; } while (0)

    bool second_ = false;
    for (int ph = args.ph_lo; ph < args.ph_hi; ++ph) {
        int tid_l = threadIdx.x; asm volatile("" : "+v"(tid_l));
        const int tid = tid_l, lane = tid & 63, wave = __builtin_amdgcn_readfirstlane(tid >> 6), gw = bx * 8 + wave;
        const __attribute__((address_space(4))) Args* ap = (const __attribute__((address_space(4))) Args*)__builtin_amdgcn_kernarg_segment_ptr(); asm volatile("" : "+s"(ap));
        unsigned char* ws = ap->ws;
        float* out = ap->out;
        float* xctx = (float*)(ws + WS_XCTX);
        float* MODS = (float*)(ws + WS_MODS);
        float* LBT = (float*)(ws + WS_LB);
        f32x2* ROPE = (f32x2*)(ws + WS_ROPE);
        bf16r* Hb = (bf16r*)(ws + WS_H);
        bf16r* QKV = (bf16r*)(ws + WS_QKV);
        bf16r *HQ = (bf16r*)(ws + WS_HQ), *HI = (bf16r*)(ws + WS_HI), *HG = (bf16r*)(ws + WS_HG);
        float *HF = (float*)(ws + WS_HF), *HB = (float*)(ws + WS_HB);
        bf16r* HH = (bf16r*)(ws + WS_HH);
        float* SST = (float*)(ws + WS_SST); float* ADEC = (float*)(ws + WS_ADEC);
        const bool rep_this = (REPEAT_MASK != 0) && ph >= 2 && ((REPEAT_MASK >> ((ph - 2) % NSUB)) & 1);
        float* dryp = (rep_this && !second_) ? (float*)(ws + WS_SST) : nullptr;
        if (ph == 0 && (PHMASK & 1)) {
            LAS float* scr = (LAS float*)(L + wave * 16384);
            constexpr int I_IN = 16 * (INW / 32), I_OUT = 16 * (DM / 32), I_F1 = 16 * (FF2 / 32), I_F2 = (FFH / 64) * (DM / 32), I_L = I_IN + I_OUT + I_F1 + I_F2;
            for (int it = gw; it < DEPTH * I_L; it += NGW) {
                const int l = it / I_L; int r = it % I_L;
                if (r < I_IN) { transpose_item(ap->in[6] + (size_t)l * DM * INW, DM, INW, (bf16r*)(ws + WS_WIN) + (size_t)l * INW * DM, 1, scr, r, lane); continue; } r -= I_IN;
                if (r < I_OUT) { transpose_item(ap->in[12] + (size_t)l * DM * DM, DM, DM, (bf16r*)(ws + WS_WOUT) + (size_t)l * DM * DM, 0, scr, r, lane); continue; } r -= I_OUT;
                if (r < I_F1) { transpose_item(ap->in[13] + (size_t)l * DM * FF2, DM, FF2, (bf16r*)(ws + WS_WF1) + (size_t)l * FF2 * DM, 2, scr, r, lane); continue; } r -= I_F1;
                transpose_item(ap->in[14] + (size_t)l * FFH * DM, FFH, DM, (bf16r*)(ws + WS_WF2) + (size_t)l * DM * FFH, 0, scr, r, lane);
            }
            __syncthreads();
            if (bx < 192) {
                LAS float* sc = (LAS float*)L;
                LAS float* red = (LAS float*)(L + 16384);
                for (int i = tid; i < 3 * DM; i += 512) { const int s = i >> 10, k = i & 1023; const float cv = s < 2 ? ap->in[1][s * DM + k] : ap->in[3][k]; sc[i] = silu_f(cv); }
                __syncthreads();
                for (int it = bx; it < 192; it += G) {
                    const int l = it / 96, n0 = (it % 96) * 64;
                    const float* wa = ap->in[4] + (size_t)l * DM * NMOD + n0 + lane;
                    float a0 = 0.f, a1 = 0.f, a2 = 0.f;
#pragma unroll 8
                    for (int k = wave * 128; k < wave * 128 + 128; ++k) { const float w = wa[(size_t)k * NMOD]; a0 += sc[k] * w; a1 += sc[DM + k] * w; a2 += sc[2 * DM + k] * w; }
                    red[(wave * 3 + 0) * 64 + lane] = a0; red[(wave * 3 + 1) * 64 + lane] = a1; red[(wave * 3 + 2) * 64 + lane] = a2;
                    __syncthreads();
                    if (tid < 192) { const int s = tid >> 6; float sum = 0.f;
#pragma unroll
                        for (int w = 0; w < 8; ++w) sum += red[(w * 3 + s) * 64 + lane];
                        MODS[(l * 3 + s) * NMOD + n0 + lane] = sum + ap->in[5][l * NMOD + n0 + lane]; }
                    __syncthreads();
                }
            }
            if (bx == G - 1) {
                for (int i = tid; i < 128 * 16; i += 512) { const int pos = i >> 4, j = i & 15; const float invf = expf((-9.210340371976184f * (float)j) / 16.0f); const float ang = (float)pos * invf; ROPE[i] = (f32x2){cosf(ang), sinf(ang)}; }
                { const int d = tid >> 8, k = tid & 255; const float a0 = ap->in[7][d * 256 + k], a1 = ap->in[7][512 + d * 256 + k]; const float mx = fmaxf(a0, a1); const float e0 = expf(a0 - mx), e1 = expf(a1 - mx);
                  const float p1 = e1 / (e0 + e1); LBT[d * 256 + k] = 0.f; LBT[512 + d * 256 + k] = fminf(fmaxf(p1, 0.f), 1.f); }
            }
        } else if (ph == 1 && (PHMASK & 2)) {
            for (int r = gw; r < MT; r += NGW) {
                const float* src = r < ML ? ap->in[0] + (size_t)r * DM : ap->in[2] + (size_t)(r - ML) * DM;
                float* xp = xrow_ptr(out, xctx, r); const float* md = MODS + seg_of_row(r) * NMOD;
#pragma unroll
                for (int j = 0; j < 4; ++j) { const int c = 4 * lane + 256 * j; const f32x4 v = *(const f32x4*)(src + c); *(f32x4*)(xp + c) = v;
                    const f32x4 sh = *(const f32x4*)(md + c), scv = *(const f32x4*)(md + DM + c); const f32x4 h = v * (scv + 1.f) + sh;
                    u32x2 w; w.x = pk_bf16(h[0], h[1]); w.y = pk_bf16(h[2], h[3]); *(u32x2*)(Hb + (size_t)r * DM + c) = w; }
            }
        } else {
            const int l = (ph - 2) / NSUB, sub = (ph - 2) % NSUB;
            const bool need_ctx = l < DEPTH - 1;
            const float* modl = MODS + (size_t)l * 3 * NMOD;
            switch (sub) {
            case 0: if (PHMASK & 4) {
                pg8::Gemm g{Hb, (const bf16r*)(ws + WS_WIN) + (size_t)l * INW * DM, MT, INW, DM}; pg8::StaticOrder S; S.init(MT, INW, G, bx, DM);
                EpiIn E{HQ, HI, HG, QKV, HF, HB, LBT + l * 512, ap->in[9] + l * 64, ap->in[10] + l * 64, ROPE};
                pg8::gemm_phase<EpiIn, pg8::StaticOrder, true, true>(L, g, S, E);
            } break;
            case 1: if (PHMASK & 8) {
                LAS float* stf = (LAS float*)(L + wave * 2048);
                LAS float* stv = stf + 256;
                const int kq = lane >> 4, vl = lane & 15, tk = lane >> 4, k4 = (lane & 15) * 4;
                for (int u = wave * G + bx; u < NHU; u += NGW) {
                    const int chain = u / NCHUNK, c = u % NCHUNK, b = chain >> 3, h = (chain >> 1) & 3, dir = chain & 1;
                    int base, sgn;
                    if (dir == 0) { base = c < 4 ? ML + b * CTXL + 64 * c : b * SEQ + 64 * (c - 4); sgn = 1; }
                    else { base = c < 4 ? ML + b * CTXL + 255 - 64 * c : b * SEQ + SEQ - 1 - 64 * (c - 4); sgn = -1; }
                    const float* F = (dir ? HB : HF) + h * 64 + k4; const bf16r* VI = HI + h * 64 + k4;
                    f32x2 s[16][2], a[8];
#pragma unroll
                    for (int kk = 0; kk < 16; ++kk) { s[kk][0] = (f32x2){0.f, 0.f}; s[kk][1] = (f32x2){0.f, 0.f}; }
#pragma unroll
                    for (int kk = 0; kk < 8; ++kk) a[kk] = (f32x2){1.f, 1.f};
                    f32x4 rf; u32x2 rv;
                    { const size_t row = (size_t)(base + sgn * tk); rf = *(const f32x4*)(F + row * 256); rv = *(const u32x2*)(VI + row * 256); }
#pragma unroll 1
                    for (int g = 0; g < 16; ++g) {
                        *(LAS f32x4*)(stf + tk * 64 + k4) = rf;
                        { f32x4 v4; v4[0] = __builtin_bit_cast(float, rv.x << 16); v4[1] = __builtin_bit_cast(float, rv.x & 0xffff0000u); v4[2] = __builtin_bit_cast(float, rv.y << 16); v4[3] = __builtin_bit_cast(float, rv.y & 0xffff0000u);
                          *(LAS f32x4*)(stv + tk * 64 + k4) = v4; }
                        if (g + 1 < 16) { const size_t row = (size_t)(base + sgn * (4 * (g + 1) + tk)); rf = *(const f32x4*)(F + row * 256); rv = *(const u32x2*)(VI + row * 256); }
#pragma unroll
                        for (int i = 0; i < 4; ++i) {
                            f32x2 v2[2]; v2[0] = (f32x2){stv[i * 64 + vl], stv[i * 64 + vl + 16]}; v2[1] = (f32x2){stv[i * 64 + vl + 32], stv[i * 64 + vl + 48]};
#pragma unroll
                            for (int j = 0; j < 4; ++j) { const f32x4 f4 = *(const LAS f32x4*)(stf + i * 64 + 16 * kq + 4 * j);
#pragma unroll
                                for (int e = 0; e < 4; ++e) { const int kk = 4 * j + e; const f32x2 f2 = (f32x2){f4[e], f4[e]}; s[kk][0] = f2 * (s[kk][0] - v2[0]) + v2[0]; s[kk][1] = f2 * (s[kk][1] - v2[1]) + v2[1]; }
                                a[2 * j] = a[2 * j] * (f32x2){f4[0], f4[1]}; a[2 * j + 1] = a[2 * j + 1] * (f32x2){f4[2], f4[3]}; }
                        }
                    }
                    float* so = SST + (size_t)u * 4096 + lane;
#pragma unroll
                    for (int kk = 0; kk < 16; ++kk) { so[(kk * 4 + 0) * 64] = s[kk][0].x; so[(kk * 4 + 1) * 64] = s[kk][0].y; so[(kk * 4 + 2) * 64] = s[kk][1].x; so[(kk * 4 + 3) * 64] = s[kk][1].y; }
                    if (vl == 0) {
#pragma unroll
                        for (int kk = 0; kk < 8; ++kk) { ADEC[(size_t)u * 64 + 16 * kq + 2 * kk] = a[kk].x; ADEC[(size_t)u * 64 + 16 * kq + 2 * kk + 1] = a[kk].y; } }
                }
            } break;
            case 2: if (PHMASK & 16) {
                const int gt = bx * 512 + tid;
                if (gt < NCHAIN * 4096 && !dryp) {
                    const int chain = gt >> 12, e = gt & 4095, k = 16 * ((e & 63) >> 4) + (e >> 8);
                    float* sp = SST + (size_t)chain * NCHUNK * 4096 + e; const float* ap = ADEC + (size_t)chain * NCHUNK * 64 + k;
                    float s = 0.f;
#pragma unroll 12
                    for (int c = 0; c < NCHUNK; ++c) { const float loc = sp[(size_t)c * 4096], a = ap[c * 64]; sp[(size_t)c * 4096] = s; s = a * s + loc; }
                }
            } break;
            case 3: if (PHMASK & 512) {
                LAS float* stf = (LAS float*)(L + wave * 3072);
                LAS float* stq = stf + 256; LAS float* stv = stf + 512;
                LAS bf16r* ob = (LAS bf16r*)(L + 24576 + wave * 8192);
                const int kq = lane >> 4, vl = lane & 15, tk = lane >> 4, k4 = (lane & 15) * 4;
                const int nblk = need_ctx ? 132 : 128, NU2 = NB * 4 * nblk;
                const float gnorm = ap->in[8][l * 64 + lane];
                bf16r* MIXr = Hb;
                for (int u = wave * G + bx; u < NU2; u += NGW) {
                    const int j = u % nblk, bh = u / nblk, b = bh >> 2, h = bh & 3;
                    const int rbase = j < 128 ? b * SEQ + 64 * j : ML + b * CTXL + 64 * (j - 128);
#pragma unroll 1
                    for (int dir = 1; dir >= 0; --dir) {
                        const int chain = bh * 2 + dir;
                        const int c = dir ? (j < 128 ? 4 + (127 - j) : 3 - (j - 128)) : (j < 128 ? 4 + j : j - 128);
                        const float* F = (dir ? HB : HF) + h * 64 + k4; const bf16r* QI = HQ + h * 64 + k4; const bf16r* VI = HI + h * 64 + k4; const bf16r* GI = HG + h * 64 + lane;
                        const float* sp = SST + ((size_t)chain * NCHUNK + c) * 4096 + lane;
                        f32x2 s[16][2];
#pragma unroll
                        for (int kk = 0; kk < 16; ++kk) { s[kk][0] = (f32x2){sp[(kk * 4 + 0) * 64], sp[(kk * 4 + 1) * 64]}; s[kk][1] = (f32x2){sp[(kk * 4 + 2) * 64], sp[(kk * 4 + 3) * 64]}; }
                        f32x4 rf; u32x2 rq, rv; bf16r rg[4];
                        { const size_t row = (size_t)(rbase + (dir ? 63 - tk : tk)); rf = *(const f32x4*)(F + row * 256); rq = *(const u32x2*)(QI + row * 256); rv = *(const u32x2*)(VI + row * 256); }
#pragma unroll
                        for (int i = 0; i < 4; ++i) rg[i] = GI[(size_t)(rbase + (dir ? 63 - i : i)) * 256];
#pragma unroll 1
                        for (int g = 0; g < 16; ++g) {
                            *(LAS f32x4*)(stf + tk * 64 + k4) = rf;
                            { f32x4 q4; q4[0] = __builtin_bit_cast(float, rq.x << 16); q4[1] = __builtin_bit_cast(float, rq.x & 0xffff0000u); q4[2] = __builtin_bit_cast(float, rq.y << 16); q4[3] = __builtin_bit_cast(float, rq.y & 0xffff0000u); *(LAS f32x4*)(stq + tk * 64 + k4) = q4; }
                            { f32x4 v4; v4[0] = __builtin_bit_cast(float, rv.x << 16); v4[1] = __builtin_bit_cast(float, rv.x & 0xffff0000u); v4[2] = __builtin_bit_cast(float, rv.y << 16); v4[3] = __builtin_bit_cast(float, rv.y & 0xffff0000u); *(LAS f32x4*)(stv + tk * 64 + k4) = v4; }
                            float gt4[4];
#pragma unroll
                            for (int i = 0; i < 4; ++i) gt4[i] = bf2f(rg[i]);
                            if (g + 1 < 16) { const int t1 = 4 * (g + 1); const size_t row = (size_t)(rbase + (dir ? 63 - (t1 + tk) : t1 + tk)); rf = *(const f32x4*)(F + row * 256); rq = *(const u32x2*)(QI + row * 256); rv = *(const u32x2*)(VI + row * 256);
#pragma unroll
                                for (int i = 0; i < 4; ++i) rg[i] = GI[(size_t)(rbase + (dir ? 63 - (t1 + i) : t1 + i)) * 256]; }
#pragma unroll
                            for (int i = 0; i < 4; ++i) {
                                f32x2 v2[2]; v2[0] = (f32x2){stv[i * 64 + vl], stv[i * 64 + vl + 16]}; v2[1] = (f32x2){stv[i * 64 + vl + 32], stv[i * 64 + vl + 48]};
                                f32x2 oa[2]; oa[0] = (f32x2){0.f, 0.f}; oa[1] = (f32x2){0.f, 0.f};
#pragma unroll
                                for (int jj = 0; jj < 4; ++jj) { const f32x4 f4 = *(const LAS f32x4*)(stf + i * 64 + 16 * kq + 4 * jj), q4 = *(const LAS f32x4*)(stq + i * 64 + 16 * kq + 4 * jj);
#pragma unroll
                                    for (int e = 0; e < 4; ++e) { const int kk = 4 * jj + e; const f32x2 f2 = (f32x2){f4[e], f4[e]}, q2 = (f32x2){q4[e], q4[e]};
                                        s[kk][0] = f2 * (s[kk][0] - v2[0]) + v2[0]; s[kk][1] = f2 * (s[kk][1] - v2[1]) + v2[1]; oa[0] = s[kk][0] * q2 + oa[0]; oa[1] = s[kk][1] * q2 + oa[1]; } }
                                float o[4] = {oa[0].x, oa[0].y, oa[1].x, oa[1].y};
#pragma unroll
                                for (int ii = 0; ii < 4; ++ii) o[ii] = sum_kq4(o[ii]);
                                const int ro = dir ? 63 - (4 * g + i) : 4 * g + i;
                                if (dir) { const float mine = kq == 0 ? o[0] : (kq == 1 ? o[1] : (kq == 2 ? o[2] : o[3])); ob[ro * 64 + lane] = (bf16r)(pk_bf16(mine, 0.f) & 0xffffu); }
                                else {
                                    float ss = 0.f;
#pragma unroll
                                    for (int ii = 0; ii < 4; ++ii) { o[ii] += bf2f(ob[ro * 64 + vl + 16 * ii]); ss += o[ii] * o[ii]; }
                                    ss = sum_row16(ss);
                                    const float mine = kq == 0 ? o[0] : (kq == 1 ? o[1] : (kq == 2 ? o[2] : o[3]));
                                    const float y = mine * (1.f / sqrtf(ss * (1.f / 64.f) + LN_EPS)) * gnorm * gt4[i];
                                    MIXr[(size_t)(rbase + ro) * DM + h * 64 + lane] = (bf16r)(pk_bf16(y, 0.f) & 0xffffu);
                                }
                            }
                        }
                    }
                }
            } break;
            case 4: if (PHMASK & 32) {
                using attn_body::bf16;
                bf16* MIX = (bf16*)Hb; const bf16* QK = (const bf16*)QKV;
                const attn_body::NaP nap0{0, 0, (const LAS float*)(L + NA_TAB_OFF)};
                for (int id = bx; id < 384; id += G) {
                    const int b = id / 192, rem = id % 192, h = rem >> 5, qb = rem & 31, kvh = h / 3; const long q0 = (long)b * SEQ + 256 * qb;
                    attn_body::attn_unit<8, false>(QK + q0 * QKVP + CGQ + h * 64, QK + CGK + kvh * 64, QK + CGV + kvh * 64, MIX + q0 * DM + 256 + h * 64,
                                                   b * SEQ, 128, ML + b * CTXL, 132, nap0, (char*)lds);
                }
                const int hl = G >> 1, li = bx - hl, nl = G - hl;
                if (li >= 0) {
#ifndef NA_REPEAT
#define NA_REPEAT 1
#endif
                    for (int rp_ = 0; rp_ < NA_REPEAT; ++rp_)
                    for (int id = li; id < 384; id += nl) {
                        const int b = id / 192, rem = id % 192, h = rem >> 5, qb = rem & 31; const long q0 = (long)b * SEQ + 256 * qb;
                        const int gr0 = 4 * qb, lo = gr0 - 4 < 0 ? 0 : gr0 - 4; int rs3 = gr0 - 1; rs3 = rs3 < 0 ? 0 : (rs3 > 120 ? 120 : rs3);
                        const int cnt = rs3 + 7 - lo + 1, ntl = cnt == 8 ? 8 : 12;
                        __syncthreads();
                        { int t_ = tid; asm volatile("" : "+v"(t_)); if (t_ < 465) ((LAS float*)(L + NA_TAB_OFF))[t_] = ap->in[11][(size_t)(l * 6 + h) * 465 + t_] * LOG2E; }
                        __syncthreads();
                        const attn_body::NaP nap{gr0, lo, (const LAS float*)(L + NA_TAB_OFF)};
                        attn_body::attn_unit<8, true>(QK + q0 * QKVP + CNQ + h * 64, QK + CNK + h * 64, QK + CNV + h * 64, MIX + q0 * DM + 640 + h * 64,
                                                      ML + b * CTXL, 4, b * SEQ + 64 * lo, 4 + ntl, nap, (char*)lds);
                    }
                    if (need_ctx) {
                        for (int id = li; id < 24; id += nl) {
                            const int na = id / 12, rem = id % 12, b = rem / 6, h = rem % 6; const long q0 = (long)ML + b * CTXL;
                            const int cq = na ? CNQ + h * 64 : CGQ + h * 64, ck = na ? CNK + h * 64 : CGK + (h / 3) * 64, cv = na ? CNV + h * 64 : CGV + (h / 3) * 64, co = (na ? 640 : 256) + h * 64;
                            attn_body::attn_unit<8, false>(QK + q0 * QKVP + cq, QK + ck, QK + cv, MIX + q0 * DM + co, (int)q0, 4, (int)q0, 4, nap0, (char*)lds);
                        }
                    }
                }
            } break;
            case 5: case 8: if (PHMASK & 64) {
                const int Kd = sub == 5 ? DM : FFH;
                CtxSliceOrder S; S.init(G, bx, Kd, need_ctx);
                EpiRes E{out, xctx, modl + (sub == 5 ? 2 : 5) * DM, dryp, (float*)(ws + WS_PART)};
                if (sub == 5) { pg8::Gemm g{Hb, (const bf16r*)(ws + WS_WOUT) + (size_t)l * DM * DM, MT, DM, DM}; pg8::gemm_phase<EpiRes, CtxSliceOrder, true, true>(L, g, S, E); }
                else { pg8::Gemm g{HH, (const bf16r*)(ws + WS_WF2) + (size_t)l * DM * FFH, MT, DM, FFH}; pg8::gemm_phase<EpiRes, CtxSliceOrder, true, true>(L, g, S, E); }
            } break;
            case 6: case 9: if (PHMASK & 128) {
                const int which = sub == 6 ? 0 : 1; const int Mr = need_ctx ? MT : ML;
                const float* lg = ap->in[15] + (size_t)(l * 2 + which) * DM; const float* lbv = ap->in[16] + (size_t)(l * 2 + which) * DM;
                const bool wantH = (which == 0) || (l + 1 < DEPTH);
                const float* mdn = which == 0 ? modl + 3 * DM : MODS + (size_t)(l + 1) * 3 * NMOD;
                const int nslc = (which == 0 ? DM : FFH) / 128; const float* gctx = modl + (which == 0 ? 2 : 5) * DM + 2 * NMOD; const float* PART = (const float*)(ws + WS_PART);
                for (int r = gw; r < (dryp ? 0 : Mr); r += NGW) {
                    float* xp = xrow_ptr(out, xctx, r); f32x4 v[4]; float sm = 0.f;
#pragma unroll
                    for (int j = 0; j < 4; ++j) v[j] = *(const f32x4*)(xp + 4 * lane + 256 * j);
                    if (r >= ML) {
#pragma unroll
                        for (int j = 0; j < 4; ++j) { const int c = 4 * lane + 256 * j; f32x4 a = (f32x4){0.f, 0.f, 0.f, 0.f};
                            for (int sl = 0; sl < nslc; ++sl) a += *(const f32x4*)(PART + ((size_t)sl * MC + (r - ML)) * DM + c);
                            v[j] = v[j] * DN_ALPHA + *(const f32x4*)(gctx + c) * a; }
                    }
#pragma unroll
                    for (int j = 0; j < 4; ++j) sm += (v[j][0] + v[j][1]) + (v[j][2] + v[j][3]);
                    const float mean = wave_sum(sm) * (1.f / DM); float s2 = 0.f;
#pragma unroll
                    for (int j = 0; j < 4; ++j) { v[j] = v[j] - mean; s2 += (v[j][0] * v[j][0] + v[j][1] * v[j][1]) + (v[j][2] * v[j][2] + v[j][3] * v[j][3]); }
                    const float rstd = 1.f / sqrtf(wave_sum(s2) * (1.f / DM) + LN_EPS);
                    const float* md = mdn + seg_of_row(r) * NMOD;
#pragma unroll
                    for (int j = 0; j < 4; ++j) { const int c = 4 * lane + 256 * j; const f32x4 y = v[j] * rstd * *(const f32x4*)(lg + c) + *(const f32x4*)(lbv + c); *(f32x4*)(xp + c) = y;
                        if (wantH) { const f32x4 sh = *(const f32x4*)(md + c), scv = *(const f32x4*)(md + DM + c); const f32x4 h = y * (scv + 1.f) + sh;
                            u32x2 w; w.x = pk_bf16(h[0], h[1]); w.y = pk_bf16(h[2], h[3]); *(u32x2*)(Hb + (size_t)r * DM + c) = w; } }
                }
            } break;
            default: if (PHMASK & 256) {
                const int Mr = need_ctx ? MT : ML;
                pg8::Gemm g{Hb, (const bf16r*)(ws + WS_WF1) + (size_t)l * FF2 * DM, Mr, FF2, DM}; pg8::StaticOrder S; S.init(Mr, FF2, G, bx, DM);
                EpiSwiglu E{HH}; pg8::gemm_phase<EpiSwiglu, pg8::StaticOrder, true, true>(L, g, S, E);
            } break;
            }
        }
        if (rep_this && !second_) { second_ = true; --ph; GRID_SEAM(); continue; }
        second_ = false;
        if (ph + 1 < args.ph_hi) { GRID_SEAM(); for (int x_ = 0; x_ < EXTRA_SYNCS; ++x_) GRID_SEAM(); }
    }
}

constexpr int N_PHASES = 2 + NSUB * DEPTH;
extern "C" void kernel_launch(void* const* d_in, const int* in_sizes, int n_in, void* d_out, int out_size, void* d_ws, size_t ws_size, hipStream_t stream) {
    static int grid = 0;
    if (grid == 0) {
        if (n_in != 17 || out_size != ML * DM || ws_size < WS_END) { fprintf(stderr, "kernel_launch: unexpected shapes (n_in %d out %d ws %zu)\n", n_in, out_size, ws_size); grid = -1; return; }
        int dev = 0, cus = 0, per_cu = 0;
        hipGetDevice(&dev); hipDeviceGetAttribute(&cus, hipDeviceAttributeMultiprocessorCount, dev);
        if (hipFuncSetAttribute((const void*)hybrid_fwd, hipFuncAttributeMaxDynamicSharedMemorySize, LDS_BYTES) != hipSuccess) { fprintf(stderr, "kernel_launch: hipFuncSetAttribute failed\n"); grid = -1; return; }
        if (hipOccupancyMaxActiveBlocksPerMultiprocessor(&per_cu, (const void*)hybrid_fwd, 512, LDS_BYTES) != hipSuccess || per_cu < 1) { fprintf(stderr, "kernel_launch: occupancy query says %d\n", per_cu); (void)hipGetLastError(); grid = -1; return; }
        grid = cus;
    }
    if (grid < 0) return;
    if (hipMemsetAsync((char*)d_ws + WS_BAR, 0, BAR_ZERO_BYTES, stream) != hipSuccess) { fprintf(stderr, "kernel_launch: memset failed\n"); return; }
    Args a{};
    for (int i = 0; i < 17; ++i) a.in[i] = (const float*)d_in[i];
    a.out = (float*)d_out; a.ws = (unsigned char*)d_ws;
#if MK_N_LAUNCHES == 1
    a.ph_lo = 0; a.ph_hi = N_PHASES;
    void* kargs[] = {&a};
    hipError_t e = hipLaunchCooperativeKernel((const void*)hybrid_fwd, dim3(grid), dim3(512), kargs, LDS_BYTES, stream);
    if (e != hipSuccess) fprintf(stderr, "cooperative launch failed: %s (grid %d)\n", hipGetErrorString(e), grid);
#else
    for (int p = 0; p < N_PHASES; ++p) { a.ph_lo = p; a.ph_hi = p + 1; hipLaunchKernelGGL(hybrid_fwd, dim3(grid), dim3(512), LDS_BYTES, stream, a); }
#endif
}
```
